# Optimizing an MI355X kernel written in HIP

```python
import math
import jax, jax.numpy as jnp
from jax import lax
import numpy as np

D_MODEL = 1024
BATCH = 16
SEQ = 2048
DEPTH = 1

HEAD_DIM = 64
N_FOX_HEADS = D_MODEL // 128
N_DIFF_HEADS = D_MODEL // 256
DIFF_V_DIM = 2 * HEAD_DIM
FOX_WIDTH = N_FOX_HEADS * HEAD_DIM
DIFF_QK_WIDTH = N_DIFF_HEADS * 2 * HEAD_DIM
DIFF_WIDTH = N_DIFF_HEADS * DIFF_V_DIM
MIX_WIDTH = FOX_WIDTH + DIFF_WIDTH
FOX_Q0 = 0
FOX_K0 = FOX_Q0 + FOX_WIDTH
FOX_V0 = FOX_K0 + FOX_WIDTH
FOX_F0 = FOX_V0 + FOX_WIDTH
DIFF_Q0 = FOX_F0 + N_FOX_HEADS
DIFF_K0 = DIFF_Q0 + DIFF_QK_WIDTH
DIFF_V0 = DIFF_K0 + DIFF_QK_WIDTH
IN_WIDTH = DIFF_V0 + DIFF_WIDTH

BLOCK_Q = 128
NUM_BUCKETS = 32
MAX_DISTANCE = 128
N_EXPERTS = 32
TOP_K = 4
D_FF = D_MODEL
SWIGLU_ALPHA = 1.702
SWIGLU_LIMIT = 7.0
MOE_BLOCK = 256
PLE_DIM = 256
NORM_EPS = 1e-6
NEG_INF = -1e30

kernel_name = 'hybrid_fox_diffattn_moe_ple'


def rms_norm(x, g):
    xf = x.astype(jnp.float32)
    y = xf * lax.rsqrt(jnp.mean(xf * xf, axis=-1, keepdims=True) + NORM_EPS)
    return (y * g.astype(jnp.float32)).astype(x.dtype)


def causal_mask(q0, q1):
    qpos = jnp.arange(q0, q1, dtype=jnp.int32)
    kpos = jnp.arange(q1, dtype=jnp.int32)
    return kpos[None, :] <= qpos[:, None], qpos[:, None] - kpos[None, :]


def t5_bucket(rel):
    n = jnp.maximum(rel, 0)
    max_exact = NUM_BUCKETS // 2
    nf = jnp.maximum(n, 1).astype(jnp.float32)
    large = max_exact + (jnp.log(nf / max_exact) / math.log(MAX_DISTANCE / max_exact)
                         * (NUM_BUCKETS - max_exact)).astype(jnp.int32)
    large = jnp.minimum(large, NUM_BUCKETS - 1)
    return jnp.where(n < max_exact, n, large)


def fox_attention(q, k, v, logf):
    seq = q.shape[2]
    scale = HEAD_DIM ** -0.5
    c = jnp.cumsum(logf, axis=-1)
    outs = []
    for blk in range(seq // BLOCK_Q):
        q0, q1 = blk * BLOCK_Q, (blk + 1) * BLOCK_Q
        mask, _ = causal_mask(q0, q1)
        s = jnp.einsum('bhqd,bhkd->bhqk', q[:, :, q0:q1], k[:, :, :q1]).astype(jnp.float32) * scale
        s = s + c[:, :, q0:q1, None] - c[:, :, None, :q1]
        s = jnp.where(mask, s, NEG_INF)
        pr = jax.nn.softmax(s, axis=-1).astype(v.dtype)
        outs.append(jnp.einsum('bhqk,bhkd->bhqd', pr, v[:, :, :q1]))
    return jnp.concatenate(outs, axis=2)


def diff_attention(q1, q2, k1, k2, v, rel_table, lam):
    seq = q1.shape[2]
    scale = HEAD_DIM ** -0.5
    outs = []
    for blk in range(seq // BLOCK_Q):
        q0, qe = blk * BLOCK_Q, (blk + 1) * BLOCK_Q
        mask, rel = causal_mask(q0, qe)
        bias = jnp.take(rel_table, t5_bucket(rel), axis=0).astype(jnp.float32)
        bias = jnp.transpose(bias, (2, 0, 1))[None]
        s1 = jnp.einsum('bhqd,bhkd->bhqk', q1[:, :, q0:qe], k1[:, :, :qe]).astype(jnp.float32) * scale + bias
        s2 = jnp.einsum('bhqd,bhkd->bhqk', q2[:, :, q0:qe], k2[:, :, :qe]).astype(jnp.float32) * scale + bias
        a1 = jax.nn.softmax(jnp.where(mask, s1, NEG_INF), axis=-1)
        a2 = jax.nn.softmax(jnp.where(mask, s2, NEG_INF), axis=-1)
        pr = (a1 - lam * a2).astype(v.dtype)
        outs.append(jnp.einsum('bhqk,bhkd->bhqd', pr, v[:, :, :qe]))
    return jnp.concatenate(outs, axis=2)


def clamped_swiglu(h):
    x_glu = jnp.minimum(h[..., ::2], SWIGLU_LIMIT)
    x_lin = jnp.clip(h[..., 1::2], -SWIGLU_LIMIT, SWIGLU_LIMIT)
    return x_glu * jax.nn.sigmoid(SWIGLU_ALPHA * x_glu) * (x_lin + 1.0)


def moe(xm, w_router, b_router, w1, b1, w2, b2):
    bsz, seq, d = xm.shape
    n_tok = bsz * seq
    xs = xm.reshape(n_tok, d)
    logits = (xs @ w_router + b_router).astype(jnp.float32)
    top_v, top_i = lax.top_k(logits, TOP_K)
    gates = jax.nn.softmax(top_v, axis=-1)
    m = n_tok * TOP_K
    e_flat = top_i.reshape(m)
    g_flat = gates.reshape(m)
    tok_flat = jnp.broadcast_to(jnp.arange(n_tok, dtype=jnp.int32)[:, None], (n_tok, TOP_K)).reshape(m)
    order = jnp.argsort(e_flat, stable=True)
    e_sorted = e_flat[order]
    counts = jnp.bincount(e_flat, length=N_EXPERTS)
    starts = jnp.cumsum(counts) - counts
    padded = ((counts + MOE_BLOCK - 1) // MOE_BLOCK) * MOE_BLOCK
    pad_ends = jnp.cumsum(padded)
    pad_starts = pad_ends - padded
    dest = pad_starts[e_sorted] + (jnp.arange(m, dtype=jnp.int32) - starts[e_sorted])
    n_blocks = (m + N_EXPERTS * MOE_BLOCK + MOE_BLOCK - 1) // MOE_BLOCK
    p_rows = n_blocks * MOE_BLOCK
    buf_tok = jnp.zeros((p_rows,), jnp.int32).at[dest].set(tok_flat[order])
    buf_gate = jnp.zeros((p_rows,), jnp.float32).at[dest].set(g_flat[order])
    block_start = jnp.arange(n_blocks, dtype=jnp.int32) * MOE_BLOCK
    block_expert = jnp.minimum(jnp.searchsorted(pad_ends, block_start, side='right'), N_EXPERTS - 1)

    def block_fn(args):
        tok, e = args
        xb = xs[tok]
        hb = clamped_swiglu(xb @ w1[e] + b1[e])
        return hb @ w2[e] + b2[e]

    outs = lax.map(block_fn, (buf_tok.reshape(n_blocks, MOE_BLOCK), block_expert))
    outs = outs.reshape(p_rows, d) * buf_gate[:, None].astype(outs.dtype)
    y = jnp.zeros((n_tok, d), outs.dtype).at[buf_tok].add(outs)
    return y.reshape(bsz, seq, d).astype(xm.dtype)


def setup_inputs(seed: int = 0) -> dict:
    key = jax.random.key(seed)
    ks = jax.random.split(key, 26)
    f32 = jnp.float32
    nrm = lambda k, shape, s: jax.random.normal(k, shape, f32) * s
    gain = lambda k, shape: 1.0 + 0.02 * jax.random.normal(k, shape, f32)
    return {
        'x': nrm(ks[0], (BATCH, SEQ, D_MODEL), 1.0),
        'p': nrm(ks[1], (DEPTH, BATCH, SEQ, PLE_DIM), 1.0),
        'rel_bias': nrm(ks[2], (NUM_BUCKETS, N_DIFF_HEADS), 0.3),
        'g_attn': gain(ks[3], (DEPTH, D_MODEL)),
        'w_in': nrm(ks[4], (DEPTH, D_MODEL, IN_WIDTH), D_MODEL ** -0.5),
        'b_f': 3.0 + 0.5 * jax.random.normal(ks[5], (DEPTH, N_FOX_HEADS), f32),
        'g_fox_q': gain(ks[6], (DEPTH, HEAD_DIM)),
        'g_fox_k': gain(ks[7], (DEPTH, HEAD_DIM)),
        'g_diff_q': gain(ks[8], (DEPTH, HEAD_DIM)),
        'g_diff_k': gain(ks[9], (DEPTH, HEAD_DIM)),
        'lambda_q1': nrm(ks[10], (DEPTH, HEAD_DIM), 0.1),
        'lambda_k1': nrm(ks[11], (DEPTH, HEAD_DIM), 0.1),
        'lambda_q2': nrm(ks[12], (DEPTH, HEAD_DIM), 0.1),
        'lambda_k2': nrm(ks[13], (DEPTH, HEAD_DIM), 0.1),
        'g_subln': gain(ks[14], (DEPTH, DIFF_V_DIM)),
        'w_out': nrm(ks[15], (DEPTH, MIX_WIDTH, D_MODEL), MIX_WIDTH ** -0.5),
        'g_mlp': gain(ks[16], (DEPTH, D_MODEL)),
        'w_router': nrm(ks[17], (DEPTH, D_MODEL, N_EXPERTS), D_MODEL ** -0.5),
        'b_router': nrm(ks[18], (DEPTH, N_EXPERTS), 0.01),
        'w1': nrm(ks[19], (DEPTH, N_EXPERTS, D_MODEL, 2 * D_FF), D_MODEL ** -0.5),
        'b1': nrm(ks[20], (DEPTH, N_EXPERTS, 2 * D_FF), 0.01),
        'w2': nrm(ks[21], (DEPTH, N_EXPERTS, D_FF, D_MODEL), D_FF ** -0.5),
        'b2': nrm(ks[22], (DEPTH, N_EXPERTS, D_MODEL), 0.01),
        'g_ple': gain(ks[23], (DEPTH, D_MODEL)),
        'w_ple_gate': nrm(ks[24], (DEPTH, D_MODEL, D_MODEL), D_MODEL ** -0.5),
        'w_ple_proj': nrm(ks[25], (DEPTH, PLE_DIM, D_MODEL), PLE_DIM ** -0.5),
    }


def reference(x, p, rel_bias, g_attn, w_in, b_f, g_fox_q, g_fox_k, g_diff_q, g_diff_k,
              lambda_q1, lambda_k1, lambda_q2, lambda_k2, g_subln, w_out, g_mlp,
              w_router, b_router, w1, b1, w2, b2, g_ple, w_ple_gate, w_ple_proj):
    bsz, seq, _ = x.shape
    to_heads = lambda t, nh, hd: t.reshape(bsz, seq, nh, hd).transpose(0, 2, 1, 3)
    h = x
    for i in range(DEPTH):
        a = rms_norm(h, g_attn[i])
        proj = a @ w_in[i]
        fq = rms_norm(to_heads(proj[..., FOX_Q0:FOX_K0], N_FOX_HEADS, HEAD_DIM), g_fox_q[i])
        fk = rms_norm(to_heads(proj[..., FOX_K0:FOX_V0], N_FOX_HEADS, HEAD_DIM), g_fox_k[i])
        fv = to_heads(proj[..., FOX_V0:FOX_F0], N_FOX_HEADS, HEAD_DIM)
        f_logit = (proj[..., FOX_F0:DIFF_Q0] + b_f[i]).astype(jnp.float32)
        logf = jnp.transpose(jax.nn.log_sigmoid(f_logit), (0, 2, 1))
        fox_out = fox_attention(fq, fk, fv, logf)
        fox_out = fox_out.transpose(0, 2, 1, 3).reshape(bsz, seq, FOX_WIDTH)
        dq = proj[..., DIFF_Q0:DIFF_K0].reshape(bsz, seq, N_DIFF_HEADS, 2, HEAD_DIM)
        dk = proj[..., DIFF_K0:DIFF_V0].reshape(bsz, seq, N_DIFF_HEADS, 2, HEAD_DIM)
        dq = rms_norm(dq, g_diff_q[i]).transpose(0, 2, 3, 1, 4)
        dk = rms_norm(dk, g_diff_k[i]).transpose(0, 2, 3, 1, 4)
        dv = to_heads(proj[..., DIFF_V0:IN_WIDTH], N_DIFF_HEADS, DIFF_V_DIM)
        lam_init = 0.8 - 0.6 * math.exp(-0.3 * i)
        lam = (jnp.exp(jnp.sum(lambda_q1[i].astype(jnp.float32) * lambda_k1[i].astype(jnp.float32)))
               - jnp.exp(jnp.sum(lambda_q2[i].astype(jnp.float32) * lambda_k2[i].astype(jnp.float32)))
               + lam_init)
        diff_out = diff_attention(dq[:, :, 0], dq[:, :, 1], dk[:, :, 0], dk[:, :, 1], dv, rel_bias, lam)
        diff_out = rms_norm(diff_out, g_subln[i]) * (1.0 - lam_init)
        diff_out = diff_out.transpose(0, 2, 1, 3).reshape(bsz, seq, DIFF_WIDTH)
        mixed = jnp.concatenate([fox_out, diff_out.astype(fox_out.dtype)], axis=-1)
        h = h + mixed @ w_out[i]
        h = h + moe(rms_norm(h, g_mlp[i]), w_router[i], b_router[i], w1[i], b1[i], w2[i], b2[i])
        gate = jax.nn.sigmoid(rms_norm(h, g_ple[i]) @ w_ple_gate[i])
        h = h + gate * (p[i] @ w_ple_proj[i])
    return h
```

```cpp
#include <hip/hip_runtime.h>
#include <cstdio>
#include <cstdint>

namespace pg8 {
#define PG8_LAS __attribute__((address_space(3)))
typedef unsigned short bf16_t;
typedef short bf16x8 __attribute__((ext_vector_type(8)));
typedef float f32x4 __attribute__((ext_vector_type(4)));
typedef float f32x2 __attribute__((ext_vector_type(2)));
typedef unsigned u32x4 __attribute__((ext_vector_type(4)));
typedef unsigned u32x2 __attribute__((ext_vector_type(2)));
constexpr int BM = 256, BK = 64, HALF = 128, HTB = HALF * BK * 2  , STAGE_BYTES = 8 * HTB, NXCD = 8, WGM = 8;

__host__ __device__ __forceinline__ int lds_byte(int r, int c) { const int st = (r >> 4) * 2 + (c >> 5), rr = r & 15, cc = c & 31, ob = rr * 64 + cc * 2; return st * 1024 + (ob ^ (((ob >> 9) & 1) << 5)); }
__host__ __device__ __forceinline__ void stage_rc(int b, int& R, int& C) { const int st = b / 1024, sb = b % 1024, swz = sb ^ (((sb >> 9) & 1) << 5); R = (st >> 1) * 16 + swz / 64; C = (st & 1) * 32 + (swz % 64) / 2; }
__host__ __device__ __forceinline__ int perm32(int rho) { const int n = rho >> 4, i = rho & 15; return 8 * (i >> 2) + 4 * n + (i & 3); }

struct Unit { int pm, pn, e, lr0, ui; };
struct Gemm { const bf16_t* A; int K; };

__device__ __forceinline__ bool order_tile(long L, int nM, int nN, int& pm, int& pn) {
    const int nwg = nM * nN; if (L >= nwg) return false;
    int wgid = (int)L; { const int q = nwg / NXCD, r = nwg % NXCD, xcd = wgid % NXCD, off = wgid / NXCD; wgid = (xcd < r ? xcd * (q + 1) : r * (q + 1) + (xcd - r) * q) + off; }
    const int nig = WGM * nN, gid = wgid / nig, fm = gid * WGM, gsz = (nM - fm) < WGM ? (nM - fm) : WGM;
    pm = fm + ((wgid % nig) % gsz); pn = (wgid % nig) / gsz; return true;
}

typedef float f32x2_t __attribute__((ext_vector_type(2))); typedef __bf16 bf16x2_t __attribute__((ext_vector_type(2)));
__device__ __forceinline__ unsigned cvt_pk_bf16(float lo, float hi) { f32x2_t v = {lo, hi}; bf16x2_t b = __builtin_convertvector(v, bf16x2_t); return __builtin_bit_cast(unsigned, b); }

template <class Epi, class Sched>
__device__ __forceinline__ void gemm_phase(PG8_LAS unsigned char* lds, const Gemm g, const Sched& S, const Epi& E) {
    int tid = threadIdx.x; asm volatile("" : "+v"(tid));
    const int wid = __builtin_amdgcn_readfirstlane(tid >> 6), lane = tid & 63, wr = wid >> 2, wc = wid & 3, fr = lane & 15, fq = lane >> 4;
    const int K = g.K, nt = K / BK;
    unsigned voffB[2]; int aR[2], aC[2];
#pragma unroll
    for (int i = 0; i < 2; ++i) { int R, C; stage_rc(tid * 16 + i * 8192, R, C); const int Rb = Epi::PERM ? ((R & ~31) + perm32(R & 31)) : R;
        aR[i] = R; aC[i] = C; voffB[i] = (unsigned)(Rb * K + C) * 2u; }
    const size_t kstep = (size_t)(BK * 2);
    const size_t hstep = (size_t)HALF * K * 2;
    const unsigned ldsw = (unsigned)wid * 1024u;
    const int aoff = lds_byte(wr * 64 + fr, fq * 8), boff = lds_byte(wc * 32 + fr, fq * 8);
#define PG8_SA(b, h) (((b) * 2 + (h)) * HTB)
#define PG8_SB(b, h) ((4 + (b) * 2 + (h)) * HTB)
#define PG8_STAGE(bufoff, gbase, voff) do { _Pragma("unroll") for (int _i = 0; _i < 2; ++_i) \
        __builtin_amdgcn_global_load_lds((const unsigned*)((const char*)(gbase) + (voff)[_i]), (PG8_LAS unsigned*)(lds + (bufoff) + ldsw + _i * 8192), 16, 0, 0); } while (0)
#define PG8_LDA(dst, b, h) do { _Pragma("unroll") for (int m = 0; m < 4; ++m) _Pragma("unroll") for (int k = 0; k < 2; ++k) dst[m][k] = *(const PG8_LAS bf16x8*)(lds + PG8_SA(b, h) + aoff + m * 2048 + k * 1024); } while (0)
#define PG8_LDB(dst, b, h) do { _Pragma("unroll") for (int n = 0; n < 2; ++n) _Pragma("unroll") for (int k = 0; k < 2; ++k) dst[n][k] = *(const PG8_LAS bf16x8*)(lds + PG8_SB(b, h) + boff + n * 2048 + k * 1024); } while (0)
#define PG8_MMA(ai, bj, At, Bt) do { __builtin_amdgcn_s_setprio(1); _Pragma("unroll") for (int m = 0; m < 4; ++m) _Pragma("unroll") for (int n = 0; n < 2; ++n) _Pragma("unroll") for (int k = 0; k < 2; ++k) \
        acc[ai][bj][m][n] = __builtin_amdgcn_mfma_f32_16x16x32_bf16(Bt[n][k], At[m][k], acc[ai][bj][m][n], 0, 0, 0); __builtin_amdgcn_s_setprio(0); } while (0)
#define PG8_WAIT_V(n) asm volatile("s_waitcnt vmcnt(" #n ")" ::: "memory")
#define PG8_WAIT_L(n) asm volatile("s_waitcnt lgkmcnt(" #n ")" ::: "memory")
#define PG8_BAR __builtin_amdgcn_s_barrier()
#define PG8_SCHED __builtin_amdgcn_sched_barrier(0)
    Unit cur, nxt; int ui = 0;
    if (!S.next(0, cur)) return;
    f32x4 acc[2][2][4][2];
#pragma unroll
    for (int a = 0; a < 2; ++a)
#pragma unroll
        for (int b = 0; b < 2; ++b)
#pragma unroll
            for (int m = 0; m < 4; ++m)
#pragma unroll
                for (int n = 0; n < 2; ++n) acc[a][b][m][n] = (f32x4){0.f, 0.f, 0.f, 0.f};
    bf16x8 At[4][2], B0[2][2], B1[2][2];
    constexpr bool GA = Sched::GATHER;
    constexpr int H1 = GA ? 1 : 0;
    const size_t HS = GA ? (size_t)0 : hstep;
    const char* cA = GA ? (const char*)g.A : (const char*)g.A + S.aoff_uniform(cur);
    const char* cB = S.bptr(cur);
    unsigned aoC[2][2], aoN[2][2];
    if constexpr (GA) S.aoffs(cur, aR, aC, aoC);
    else {
#pragma unroll
        for (int i = 0; i < 2; ++i) aoC[0][i] = (unsigned)(aR[i] * K + aC[i]) * 2u; }
    PG8_STAGE(PG8_SB(0, 0), cB, voffB); PG8_STAGE(PG8_SB(0, 1), cB + hstep, voffB); PG8_STAGE(PG8_SA(0, 0), cA, aoC[0]); PG8_STAGE(PG8_SA(0, 1), cA + HS, aoC[H1]);
    if (wr == 1) PG8_BAR;
    PG8_WAIT_V(2); PG8_BAR;
    PG8_STAGE(PG8_SB(1, 0), cB + kstep, voffB); PG8_STAGE(PG8_SA(1, 0), cA + kstep, aoC[0]); PG8_STAGE(PG8_SB(1, 1), cB + hstep + kstep, voffB);
    PG8_WAIT_V(6); PG8_BAR;
    for (;;) {
        const bool has_next = S.next(ui + 1, nxt);
        const char* nB = has_next ? S.bptr(nxt) : cB;
        const char* nA = GA ? cA : (has_next ? (const char*)g.A + S.aoff_uniform(nxt) : cA);
        if constexpr (GA) {
            if (has_next) S.aoffs(nxt, aR, aC, aoN);
            else {
#pragma unroll
                for (int h = 0; h < 2; ++h)
#pragma unroll
                    for (int i = 0; i < 2; ++i) aoN[h][i] = aoC[h][i]; } }
#pragma unroll 1
        for (int t = 0; t < nt; t += 2) {
            const bool last = (t == nt - 2);
            const char* a1 = cA + (size_t)(t + 1) * kstep;
            const char* a2 = last ? nA : cA + (size_t)(t + 2) * kstep; const char* b2 = last ? nB : cB + (size_t)(t + 2) * kstep;
            const char* a3 = a2 + kstep; const char* b3 = b2 + kstep;
            unsigned ao2[2][2];
            if constexpr (GA) {
#pragma unroll
                for (int h = 0; h < 2; ++h)
#pragma unroll
                    for (int i = 0; i < 2; ++i) ao2[h][i] = last ? aoN[h][i] : aoC[h][i];
            } else {
#pragma unroll
                for (int i = 0; i < 2; ++i) ao2[0][i] = aoC[0][i]; }
            PG8_LDB(B0, 0, 0); PG8_LDB(B1, 0, 1); PG8_SCHED; PG8_LDA(At, 0, 0); PG8_STAGE(PG8_SA(1, 1), a1 + HS, aoC[H1]);
            PG8_WAIT_V(8); PG8_WAIT_L(0); PG8_BAR; PG8_MMA(0, 0, At, B0); PG8_MMA(0, 1, At, B1); PG8_BAR; PG8_SCHED;
            PG8_LDA(At, 0, 1); PG8_STAGE(PG8_SB(0, 0), b2, voffB); PG8_STAGE(PG8_SB(0, 1), b2 + hstep, voffB); PG8_STAGE(PG8_SA(0, 0), a2, ao2[0]);
            PG8_WAIT_V(8); PG8_WAIT_L(0); PG8_BAR; PG8_MMA(1, 0, At, B0); PG8_MMA(1, 1, At, B1); PG8_BAR; PG8_SCHED;
            PG8_LDB(B0, 1, 0); PG8_LDB(B1, 1, 1); PG8_SCHED; PG8_LDA(At, 1, 0); PG8_STAGE(PG8_SA(0, 1), a2 + HS, ao2[H1]);
            PG8_WAIT_V(8); PG8_WAIT_L(0); PG8_BAR; PG8_MMA(0, 0, At, B0); PG8_MMA(0, 1, At, B1); PG8_BAR; PG8_SCHED;
            PG8_LDA(At, 1, 1); PG8_STAGE(PG8_SB(1, 0), b3, voffB); PG8_STAGE(PG8_SB(1, 1), b3 + hstep, voffB); PG8_STAGE(PG8_SA(1, 0), a3, ao2[0]);
            PG8_WAIT_V(8); PG8_WAIT_L(0); PG8_BAR; PG8_MMA(1, 0, At, B0); PG8_MMA(1, 1, At, B1); PG8_BAR; PG8_SCHED;
        }
        if (wr == 0) PG8_BAR;
        { int l2 = lane; asm volatile("" : "+v"(l2)); E(acc, cur, wr, wc, l2 & 15, l2 >> 4); }
        if (!has_next) break;
#pragma unroll
        for (int a = 0; a < 2; ++a)
#pragma unroll
            for (int b = 0; b < 2; ++b)
#pragma unroll
                for (int m = 0; m < 4; ++m)
#pragma unroll
                    for (int n = 0; n < 2; ++n) acc[a][b][m][n] = (f32x4){0.f, 0.f, 0.f, 0.f};
        cur = nxt; cB = nB; cA = nA; ++ui;
        if constexpr (GA) {
#pragma unroll
            for (int h = 0; h < 2; ++h)
#pragma unroll
                for (int i = 0; i < 2; ++i) aoC[h][i] = aoN[h][i]; }
        if (wr == 1) PG8_BAR;
    }
    PG8_WAIT_V(0);
    PG8_BAR;
#undef PG8_SA
#undef PG8_SB
#undef PG8_STAGE
#undef PG8_LDA
#undef PG8_LDB
#undef PG8_MMA
#undef PG8_WAIT_V
#undef PG8_WAIT_L
#undef PG8_BAR
#undef PG8_SCHED
}
}

constexpr int NWAVES = 8;
constexpr int BATCH = 16, SEQ = 2048, D = 1024, NTOK = BATCH * SEQ;
constexpr int INW = 3080, NPROJ = 3072;
constexpr int NE = 32, TOPK = 4, FF = 1024, PLE = 256;
constexpr int HD = 64, NFOX = 8, NDIFF = 4;
constexpr int CQF = 0, CKF = 512, CVF = 1024, CQD = 1536, CKD = 2048, CVD = 2560;
constexpr float EPS = 1e-6f;
constexpr float LOG2E = 1.4426950408889634f;
constexpr float C2 = 0.125f * LOG2E;
constexpr int MAXTILES = 544;
constexpr int ECAP = NTOK;

constexpr size_t MiB = 1u << 20;
constexpr size_t WS_CTL = 0, CTL_ZERO_BYTES = 1 * MiB;
constexpr size_t WS_WRH = 1 * MiB, WS_WRL = WS_WRH + 65536, WS_B1P = WS_WRL + 65536;
constexpr size_t WS_LF = 2 * MiB, WS_CS = 3 * MiB;
constexpr size_t WS_TP = 4 * MiB, WS_RS3 = 4 * MiB + 512 * 1024;
constexpr size_t WS_TOKE = 5 * MiB, WS_GATEE = 9 * MiB, WS_RSE = 13 * MiB;
constexpr size_t WS_WIN = 17 * MiB, WS_WOUT = 23 * MiB, WS_WG = 25 * MiB, WS_WP = 27 * MiB;
constexpr size_t WS_W1 = 28 * MiB, WS_W2 = 156 * MiB;
constexpr size_t WS_PB = 220 * MiB, WS_PP = 236 * MiB;
constexpr size_t WS_PROJ = 300 * MiB, WS_MIXED = 492 * MiB, WS_A0 = 556 * MiB;
constexpr size_t WS_Y = WS_PROJ;
constexpr size_t WS_OD = WS_A0;
constexpr size_t WS_HB = 620 * MiB;
constexpr size_t WS_A3 = WS_HB;
constexpr size_t WS_END = 892 * MiB;
constexpr int CW_TMO = 0, CW_BAR = 4096, CW_CNT = 8192;

constexpr int RING_OFF = 0, RING_BYTES = 131072;
constexpr int TOKL_OFF = RING_BYTES, TOKL_BYTES = 18 * 1024;
constexpr int TILEE_OFF = TOKL_OFF + TOKL_BYTES, TILEE_BYTES = 2304;
constexpr int MISC_OFF = TILEE_OFF + TILEE_BYTES;
constexpr int LDS_BYTES = MISC_OFF + 256;
static_assert(LDS_BYTES <= 160 * 1024, "LDS");

#define GAS __attribute__((address_space(1)))
#define LAS __attribute__((address_space(3)))
typedef unsigned short bf16;
typedef unsigned v4u __attribute__((ext_vector_type(4)));
typedef float f32x4 __attribute__((ext_vector_type(4)));
typedef short bf16x8 __attribute__((ext_vector_type(8)));
typedef GAS unsigned gu32;
typedef GAS unsigned long long gu64;
#define RLX_AGENT __ATOMIC_RELAXED, __HIP_MEMORY_SCOPE_AGENT
#define LDS_WAIT() asm volatile("s_waitcnt lgkmcnt(0)" ::: "memory")
#define VM_WAIT() asm volatile("s_waitcnt vmcnt(0)" ::: "memory")
__device__ __forceinline__ unsigned long long rt() { return __builtin_amdgcn_s_memrealtime(); }
__device__ __forceinline__ unsigned f2bf(float f) { unsigned u = __builtin_bit_cast(unsigned, f); return (u + 0x7fffu + ((u >> 16) & 1u)) >> 16; }
__device__ __forceinline__ unsigned pk2(float lo, float hi) { return f2bf(lo) | (f2bf(hi) << 16); }
#define XB_TMO      128
#define XB_XCNT(j)  (256  + 64 * (j))
#define XB_XSUB(j)  (1280 + 64 * (j))
#define XB_XGEN(j)  (2304 + 64 * (j))
#define XB_TOP      3328
#define XB_TOPGEN   3392
#define XCD_BAR_WORDS 3456
#define XB_SPIN_CAP (1u << 18)

__device__ __forceinline__ unsigned xb_ld(unsigned* p)              { return __hip_atomic_load(p, __ATOMIC_RELAXED, __HIP_MEMORY_SCOPE_AGENT); }
__device__ __forceinline__ unsigned xb_add(unsigned* p, unsigned v) { return __hip_atomic_fetch_add(p, v, __ATOMIC_RELAXED, __HIP_MEMORY_SCOPE_AGENT); }
__device__ __forceinline__ unsigned xb_xcc_id() { return (unsigned)__builtin_amdgcn_s_getreg((3 << 11) | 20) & 0xFu; }
#define XB_SPIN(cond, bar) do { unsigned _sp = 0; while (cond) { __builtin_amdgcn_s_sleep(1); \
    if ((++_sp & 255u) == 0u) { if (xb_ld(&(bar)[XB_TMO])) break; if (_sp > XB_SPIN_CAP) { atomicAdd(&(bar)[XB_TMO], 1u); break; } } } } while (0)

struct XcdBarrier {
    unsigned* bar; unsigned x;
    volatile LAS unsigned* st;
};

__device__ __forceinline__ XcdBarrier xcd_barrier_post(unsigned* bar, volatile LAS unsigned* st) {
    XcdBarrier b; b.bar = bar; b.x = xb_xcc_id(); b.st = st;
    if (threadIdx.x == 0) (void)xb_add(&bar[XB_XCNT(b.x)], 1u);
    return b;
}
__device__ __forceinline__ void xcd_barrier_complete(unsigned* bar, unsigned x, unsigned& nloc, unsigned& nx) {
    const unsigned G = gridDim.x * gridDim.y * gridDim.z;
    unsigned sum, cnt, mine, sp = 0u;
    for (;;) {
        sum = 0u; cnt = 0u; mine = 0u;
#pragma unroll
        for (unsigned j = 0; j < 16; ++j) { const unsigned c = xb_ld(&bar[XB_XCNT(j)]); sum += c; cnt += (c > 0u) ? 1u : 0u; mine = (j == x) ? c : mine; }
        if (sum == G) break;
        __builtin_amdgcn_s_sleep(1);
        if ((++sp & 255u) == 0u) { if (xb_ld(&bar[XB_TMO])) break; if (sp > XB_SPIN_CAP) { atomicAdd(&bar[XB_TMO], 1u); break; } }
    }
    nloc = mine > 0u ? mine : 1u; nx = cnt > 0u ? cnt : 1u;
}

__device__ __forceinline__ void xcd_barrier(const XcdBarrier& b) {
    asm volatile("s_waitcnt vmcnt(0)" ::: "memory");
    __syncthreads();
    if (threadIdx.x == 0) {
        unsigned* bar = b.bar;
        __builtin_amdgcn_s_waitcnt(0);
        unsigned nloc = b.st[0], nx = b.st[1];
        if (nloc == 0u) { xcd_barrier_complete(bar, b.x, nloc, nx); b.st[0] = nloc; b.st[1] = nx; }
        const unsigned old = xb_add(&bar[XB_XSUB(b.x)], 1u);
        const unsigned gen = old / nloc;
        if (old + 1u == (gen + 1u) * nloc) {
            __builtin_amdgcn_fence(__ATOMIC_RELEASE, "agent");
            asm volatile("s_waitcnt vmcnt(0)" ::: "memory");
            const unsigned og = xb_add(&bar[XB_TOP], 1u);
            const unsigned tg = og / nx;
            if (og + 1u == (tg + 1u) * nx) xb_add(&bar[XB_TOPGEN], 1u);
            else XB_SPIN(xb_ld(&bar[XB_TOPGEN]) == tg, bar);
            __builtin_amdgcn_fence(__ATOMIC_ACQUIRE, "agent");
            xb_add(&bar[XB_XGEN(b.x)], 1u);
            asm volatile("s_waitcnt vmcnt(0)" ::: "memory");
        } else {
            XB_SPIN(xb_ld(&bar[XB_XGEN(b.x)]) == gen, bar);
            __builtin_amdgcn_fence(__ATOMIC_ACQUIRE, "agent");
            asm volatile("s_waitcnt vmcnt(0)" ::: "memory");
        }
    }
    __syncthreads();
}

typedef float f32x16 __attribute__((ext_vector_type(16)));
typedef short s16x4 __attribute__((ext_vector_type(4)));
typedef unsigned u32x2v __attribute__((ext_vector_type(2)));
struct Args { const float* in[26]; float* out; unsigned char* ws; int ph_lo, ph_hi; };
#define KARG ((const __attribute__((address_space(4))) Args*)__builtin_amdgcn_kernarg_segment_ptr())
#define FRESH(F) do { int t_ = threadIdx.x; asm volatile("" : "+v"(t_)); (F).tid = t_; (F).lane = t_ & 63; (F).wave = __builtin_amdgcn_readfirstlane(t_ >> 6); } while (0)
struct Frame {
    LAS unsigned char* lds;
    volatile LAS unsigned* MISC;
    gu32* ctl;
    int tid, lane, wave;
    int vcu, G;
    unsigned char* ws;
    float* out;
};
__device__ __forceinline__ float wave_sum(float v) {
#pragma unroll
    for (int o = 1; o < 64; o <<= 1) v += __shfl_xor(v, o);
    return v;
}
__device__ __forceinline__ float bf2f(unsigned short b) { return __builtin_bit_cast(float, (unsigned)b << 16); }
__device__ __forceinline__ float bflo(unsigned w) { return __builtin_bit_cast(float, w << 16); }
__device__ __forceinline__ float bfhi(unsigned w) { return __builtin_bit_cast(float, w & 0xffff0000u); }
__device__ __forceinline__ int crow(int r, int hi) { return (r & 3) + 8 * (r >> 2) + 4 * hi; }

struct SchedC {
    static constexpr bool GATHER = false;
    int nM, nN, G, c, K; const char* Bt;
    __device__ __forceinline__ size_t aoff_uniform(const pg8::Unit& u) const { return (size_t)u.pm * 256 * K * 2; }
    __device__ __forceinline__ bool next(int i, pg8::Unit& u) const { u.e = 0; u.lr0 = 0; u.ui = i; return pg8::order_tile((long)i * G + c, nM, nN, u.pm, u.pn); }
    __device__ __forceinline__ const char* bptr(const pg8::Unit& u) const { return Bt + (size_t)u.pn * 256 * K * 2; }
    __device__ __forceinline__ void aoffs(const pg8::Unit& u, const int (&aR)[2], const int (&aC)[2], unsigned (&ao)[2][2]) const {
#pragma unroll
        for (int h = 0; h < 2; ++h)
#pragma unroll
            for (int i = 0; i < 2; ++i) ao[h][i] = (unsigned)((u.pm * 256 + h * 128 + aR[i]) * K + aC[i]) * 2u; }
};
__device__ __forceinline__ LAS unsigned short* lds_tileE(LAS unsigned char* lds) { return (LAS unsigned short*)(lds + TILEE_OFF); }
__device__ __forceinline__ LAS int* lds_tstart(LAS unsigned char* lds) { return (LAS int*)(lds + TILEE_OFF + 1152); }
__device__ __forceinline__ LAS int* lds_cnt(LAS unsigned char* lds) { return (LAS int*)(lds + TILEE_OFF + 1152 + 144); }
template <bool GATHER_, int NN, int NROWS_B  >
struct SchedM {
    static constexpr bool GATHER = GATHER_;
    __device__ __forceinline__ size_t aoff_uniform(const pg8::Unit& u) const { return (size_t)u.pm * 256 * 1024 * 2; }
    int G, c; const char* Bt; LAS unsigned char* lds; int ntile;
    __device__ __forceinline__ bool next(int i, pg8::Unit& u) const {
        if (GATHER && i >= 18) return false;
        if (!pg8::order_tile((long)i * G + c, ntile, NN, u.pm, u.pn)) return false;
        u.e = lds_tileE(lds)[u.pm]; u.lr0 = (u.pm - lds_tstart(lds)[u.e]) * 256; u.ui = i; return true; }
    __device__ __forceinline__ const char* bptr(const pg8::Unit& u) const { return Bt + ((size_t)u.e * NROWS_B + (size_t)u.pn * 256) * 1024 * 2; }
    __device__ __forceinline__ void aoffs(const pg8::Unit& u, const int (&aR)[2], const int (&aC)[2], unsigned (&ao)[2][2]) const {
        const LAS int* tk = (const LAS int*)(lds + TOKL_OFF) + u.ui * 256;
#pragma unroll
        for (int h = 0; h < 2; ++h)
#pragma unroll
            for (int i = 0; i < 2; ++i) {
                if (GATHER) ao[h][i] = (unsigned)(tk[h * 128 + aR[i]] * 1024 + aC[i]) * 2u;
                else ao[h][i] = (unsigned)((u.pm * 256 + h * 128 + aR[i]) * 1024 + aC[i]) * 2u; }
    }
};

using pg8::Unit; using pg8::cvt_pk_bf16; using pg8::HALF; using pg8::BM;
struct EpiBf16P {
    static constexpr bool PERM = true;
    bf16* O; int ldc;
    __device__ __forceinline__ void operator()(const f32x4 (&acc)[2][2][4][2], const Unit& u, int wr, int wc, int fr, int fq) const {
        const int row0 = u.pm * BM + wr * 64 + fr, col0 = u.pn * BM + wc * 32 + 8 * fq;
#pragma unroll
        for (int ai = 0; ai < 2; ++ai)
#pragma unroll
            for (int m = 0; m < 4; ++m) { bf16* rowp = O + (size_t)(row0 + ai * HALF + m * 16) * ldc + col0;
#pragma unroll
                for (int bj = 0; bj < 2; ++bj) { const f32x4 v0 = acc[ai][bj][m][0], v1 = acc[ai][bj][m][1];
                    v4u w; w.x = cvt_pk_bf16(v0[0], v0[1]); w.y = cvt_pk_bf16(v0[2], v0[3]); w.z = cvt_pk_bf16(v1[0], v1[1]); w.w = cvt_pk_bf16(v1[2], v1[3]);
                    *(v4u*)(rowp + bj * HALF) = w; }
                __builtin_amdgcn_sched_barrier(0); }
    }
};
struct EpiProj {
    static constexpr bool PERM = true;
    bf16* O; const float *gqf, *gkf, *gqd, *gkd;
    __device__ __forceinline__ void operator()(const f32x4 (&acc)[2][2][4][2], const Unit& u, int wr, int wc, int fr, int fq) const {
        const int seg = u.pn >> 1;
        const float* g = seg == 0 ? gqf : seg == 1 ? gkf : seg == 3 ? gqd : seg == 4 ? gkd : nullptr;
        const float sc = (seg == 0 || seg == 3) ? C2 : 1.0f;
        f32x4 gv[2][2];
#pragma unroll
        for (int bj = 0; bj < 2; ++bj)
#pragma unroll
            for (int n = 0; n < 2; ++n) gv[bj][n] = g ? *(const f32x4*)(g + 32 * bj + 8 * fq + 4 * n) : (f32x4){1.f, 1.f, 1.f, 1.f};
        const int row0 = u.pm * BM + wr * 64 + fr, col0 = u.pn * BM + 64 * wc + 8 * fq;
#pragma unroll
        for (int ai = 0; ai < 2; ++ai)
#pragma unroll
            for (int m = 0; m < 4; ++m) {
                float r = 1.0f;
                if (g) { float ss = 0.f;
#pragma unroll
                    for (int bj = 0; bj < 2; ++bj)
#pragma unroll
                        for (int n = 0; n < 2; ++n) { const f32x4 x = acc[ai][bj][m][n]; ss += (x[0] * x[0] + x[1] * x[1]) + (x[2] * x[2] + x[3] * x[3]); }
                    ss += __shfl_xor(ss, 16); ss += __shfl_xor(ss, 32);
                    r = __builtin_amdgcn_rsqf(ss * (1.0f / 64.0f) + EPS) * sc; }
                bf16* rowp = O + (size_t)(row0 + ai * HALF + m * 16) * NPROJ + col0;
#pragma unroll
                for (int bj = 0; bj < 2; ++bj) { const f32x4 v0 = acc[ai][bj][m][0] * gv[bj][0] * r, v1 = acc[ai][bj][m][1] * gv[bj][1] * r;
                    v4u w; w.x = cvt_pk_bf16(v0[0], v0[1]); w.y = cvt_pk_bf16(v0[2], v0[3]); w.z = cvt_pk_bf16(v1[0], v1[1]); w.w = cvt_pk_bf16(v1[2], v1[3]);
                    *(v4u*)(rowp + 32 * bj) = w; }
                __builtin_amdgcn_sched_barrier(0); }
    }
};
struct EpiRes {
    static constexpr bool PERM = false;
    const float* base; float* out;
    __device__ __forceinline__ void operator()(const f32x4 (&acc)[2][2][4][2], const Unit& u, int wr, int wc, int fr, int fq) const {
        const int row0 = u.pm * BM + wr * 64 + fr, col0 = u.pn * BM + wc * 32 + 4 * fq;
#pragma unroll
        for (int ai = 0; ai < 2; ++ai)
#pragma unroll
            for (int m = 0; m < 4; ++m) { const size_t off = (size_t)(row0 + ai * HALF + m * 16) * D + col0;
#pragma unroll
                for (int bj = 0; bj < 2; ++bj)
#pragma unroll
                    for (int n = 0; n < 2; ++n) *(f32x4*)(out + off + bj * HALF + n * 16) = *(const f32x4*)(base + off + bj * HALF + n * 16) + acc[ai][bj][m][n]; }
    }
};
struct EpiSwiglu {
    static constexpr bool PERM = true;
    bf16* HB; const float* b1p; const float* rsE; LAS unsigned char* lds;
    __device__ __forceinline__ void operator()(const f32x4 (&acc)[2][2][4][2], const Unit& u, int wr, int wc, int fr, int fq) const {
        const int cnt = lds_cnt(lds)[u.e];
        const float* bp = b1p + (size_t)u.e * 2048 + u.pn * 256 + wc * 32 + 8 * fq;
        f32x4 bv[2][2];
#pragma unroll
        for (int bj = 0; bj < 2; ++bj)
#pragma unroll
            for (int n = 0; n < 2; ++n) bv[bj][n] = *(const f32x4*)(bp + bj * HALF + 4 * n);
        const int col0 = u.pn * 128 + wc * 32 + 8 * fq;
#pragma unroll
        for (int ai = 0; ai < 2; ++ai)
#pragma unroll
            for (int m = 0; m < 4; ++m) { const int lrow = ai * HALF + wr * 64 + m * 16 + fr; const int lr = u.lr0 + lrow;
                const float rs = lr < cnt ? rsE[(size_t)u.e * ECAP + lr] : 0.f;
                float o[8];
#pragma unroll
                for (int n = 0; n < 2; ++n)
#pragma unroll
                    for (int i = 0; i < 4; ++i) { float gl = acc[ai][0][m][n][i] * rs + bv[0][n][i], li = acc[ai][1][m][n][i] * rs + bv[1][n][i];
                        gl = fminf(gl, 7.0f); li = fminf(fmaxf(li, -7.0f), 7.0f);
                        const float sg = __builtin_amdgcn_rcpf(1.0f + __builtin_amdgcn_exp2f(gl * (-1.702f * LOG2E)));
                        o[4 * n + i] = gl * sg * (li + 1.0f); }
                v4u w; w.x = cvt_pk_bf16(o[0], o[1]); w.y = cvt_pk_bf16(o[2], o[3]); w.z = cvt_pk_bf16(o[4], o[5]); w.w = cvt_pk_bf16(o[6], o[7]);
                *(v4u*)(HB + (size_t)(u.pm * 256 + lrow) * FF + col0) = w; }
    }
};
struct EpiY {
    static constexpr bool PERM = true;
    bf16* Y; const float* b2; const float* gateE; LAS unsigned char* lds;
    __device__ __forceinline__ void operator()(const f32x4 (&acc)[2][2][4][2], const Unit& u, int wr, int wc, int fr, int fq) const {
        const int cnt = lds_cnt(lds)[u.e];
        const float* bp = b2 + (size_t)u.e * D + u.pn * 256 + wc * 32 + 8 * fq;
        f32x4 bv[2][2];
#pragma unroll
        for (int bj = 0; bj < 2; ++bj)
#pragma unroll
            for (int n = 0; n < 2; ++n) bv[bj][n] = *(const f32x4*)(bp + bj * HALF + 4 * n);
        const int col0 = u.pn * 256 + wc * 32 + 8 * fq;
#pragma unroll
        for (int ai = 0; ai < 2; ++ai)
#pragma unroll
            for (int m = 0; m < 4; ++m) { const int lrow = ai * HALF + wr * 64 + m * 16 + fr; const int lr = u.lr0 + lrow;
                const float gt = lr < cnt ? gateE[(size_t)u.e * ECAP + lr] : 0.f;
                bf16* rowp = Y + (size_t)(u.pm * 256 + lrow) * D + col0;
#pragma unroll
                for (int bj = 0; bj < 2; ++bj) { const f32x4 v0 = (acc[ai][bj][m][0] + bv[bj][0]) * gt, v1 = (acc[ai][bj][m][1] + bv[bj][1]) * gt;
                    v4u w; w.x = cvt_pk_bf16(v0[0], v0[1]); w.y = cvt_pk_bf16(v0[2], v0[3]); w.z = cvt_pk_bf16(v1[0], v1[1]); w.w = cvt_pk_bf16(v1[2], v1[3]);
                    *(v4u*)(rowp + bj * HALF) = w; } }
    }
};
struct EpiFinal {
    static constexpr bool PERM = false;
    float* out; const bf16* PP; const float* rs3;
    __device__ __forceinline__ void operator()(const f32x4 (&acc)[2][2][4][2], const Unit& u, int wr, int wc, int fr, int fq) const {
        const int row0 = u.pm * BM + wr * 64 + fr, col0 = u.pn * BM + wc * 32 + 4 * fq;
#pragma unroll
        for (int ai = 0; ai < 2; ++ai)
#pragma unroll
            for (int m = 0; m < 4; ++m) { const int row = row0 + ai * HALF + m * 16; const size_t off = (size_t)row * D + col0; const float rs = rs3[row];
#pragma unroll
                for (int bj = 0; bj < 2; ++bj)
#pragma unroll
                    for (int n = 0; n < 2; ++n) { const f32x4 h2 = *(const f32x4*)(out + off + bj * HALF + n * 16); const u32x2v pw = *(const u32x2v*)(PP + off + bj * HALF + n * 16);
                        const f32x4 a = acc[ai][bj][m][n] * rs; f32x4 o;
                        const float pv[4] = {bflo(pw.x), bfhi(pw.x), bflo(pw.y), bfhi(pw.y)};
#pragma unroll
                        for (int i = 0; i < 4; ++i) o[i] = h2[i] + __builtin_amdgcn_rcpf(1.0f + __builtin_amdgcn_exp2f(-LOG2E * a[i])) * pv[i];
                        *(f32x4*)(out + off + bj * HALF + n * 16) = o; } }
    }
};

__device__ __forceinline__ int dest_row(int mode, int nn) {
    if (mode == 1) { const int c = nn & 255; return (nn & ~255) + 128 * ((c >> 5) & 1) + 32 * (c >> 6) + (c & 31); }
    if (mode == 2) { const int o = nn >> 1; return 256 * (o >> 7) + (o & 127) + 128 * (nn & 1); }
    return nn;
}
__device__ __forceinline__ void tr_item(const float* W, int ldw, int k0, int n0src, int n0, int mode, bf16* WT, int Kdim, LAS float* scr, int lane) {
    float v[32];
#pragma unroll
    for (int i = 0; i < 32; ++i) { const int kk = 2 * i + (lane >> 5); v[i] = W[(size_t)(k0 + kk) * ldw + n0src + (lane & 31)]; }
#pragma unroll
    for (int i = 0; i < 32; ++i) { const int kk = 2 * i + (lane >> 5); scr[kk * 33 + (lane & 31)] = v[i]; }
    LDS_WAIT(); asm volatile("" ::: "memory");
    const int c = lane & 7;
#pragma unroll
    for (int j = 0; j < 4; ++j) { const int n = (lane >> 3) + 8 * j; const LAS float* s = scr + (8 * c) * 33 + n;
        v4u o; o.x = pk2(s[0 * 33], s[1 * 33]); o.y = pk2(s[2 * 33], s[3 * 33]); o.z = pk2(s[4 * 33], s[5 * 33]); o.w = pk2(s[6 * 33], s[7 * 33]);
        *(GAS v4u*)(WT + (size_t)dest_row(mode, n0 + n) * Kdim + k0 + 8 * c) = o; }
    LDS_WAIT(); asm volatile("" ::: "memory");
}
__device__ __forceinline__ float log_sigmoid(float z) { return fminf(z, 0.f) - log1pf(expf(-fabsf(z))); }

__device__ __forceinline__ void p0_prologue(Frame& F) {
    const float* x = KARG->in[0]; const float* p = KARG->in[1]; const float* g_attn = KARG->in[3]; const float* w_in = KARG->in[4]; const float* b_f = KARG->in[5];
    const float* w_out = KARG->in[15]; const float* g_mlp = KARG->in[16]; const float* w_router = KARG->in[17]; const float* w1 = KARG->in[19]; const float* b1 = KARG->in[20];
    const float* w2 = KARG->in[21]; const float* w_pg = KARG->in[24]; const float* w_pp = KARG->in[25];
    unsigned char* ws = F.ws;
    const int gw = F.vcu * NWAVES + F.wave, NGW = F.G * NWAVES;
    const int gt = F.vcu * (NWAVES * 64) + F.tid, NGT = F.G * NWAVES * 64;
    { LAS float* wf = (LAS float*)(F.lds + RING_OFF);
      for (int i = F.tid; i < 8192; i += NWAVES * 64) { const int k = i >> 3, h = i & 7; wf[i] = g_attn[k] * w_in[(size_t)k * INW + 1536 + h]; }
      __syncthreads();
      f32x4 gv[4];
#pragma unroll
      for (int j = 0; j < 4; ++j) gv[j] = *(const f32x4*)(g_attn + 256 * j + 4 * F.lane);
      bf16* A0 = (bf16*)(ws + WS_A0); float* LF = (float*)(ws + WS_LF);
      for (int m = gw; m < NTOK; m += NGW) {
          const GAS f32x4* xr = (const GAS f32x4*)(x + (size_t)m * D) + F.lane;
          f32x4 v[4]; float ss = 0.f;
#pragma unroll
          for (int j = 0; j < 4; ++j) { v[j] = xr[64 * j]; ss += (v[j].x * v[j].x + v[j].y * v[j].y) + (v[j].z * v[j].z + v[j].w * v[j].w); }
          const float rs = 1.0f / sqrtf(wave_sum(ss) * (1.0f / D) + EPS);
          GAS unsigned long long* o8 = (GAS unsigned long long*)(A0 + (size_t)m * D) + F.lane;
          float fa[8];
#pragma unroll
          for (int h = 0; h < 8; ++h) fa[h] = 0.f;
#pragma unroll
          for (int j = 0; j < 4; ++j) {
              const f32x4 y = v[j] * gv[j] * rs;
              o8[64 * j] = (unsigned long long)pk2(y.x, y.y) | ((unsigned long long)pk2(y.z, y.w) << 32);
#pragma unroll
              for (int i = 0; i < 4; ++i) { const LAS f32x4* wp = (const LAS f32x4*)(wf + (256 * j + 4 * F.lane + i) * 8); const f32x4 wa = wp[0], wb = wp[1]; const float xv = v[j][i];
                  fa[0] += xv * wa.x; fa[1] += xv * wa.y; fa[2] += xv * wa.z; fa[3] += xv * wa.w; fa[4] += xv * wb.x; fa[5] += xv * wb.y; fa[6] += xv * wb.z; fa[7] += xv * wb.w; }
          }
          float mine = 0.f;
#pragma unroll
          for (int h = 0; h < 8; ++h) { const float t = wave_sum(fa[h]); if (F.lane == h) mine = t; }
          if (F.lane < 8) LF[(size_t)m * 8 + F.lane] = log_sigmoid(mine * rs + b_f[F.lane]);
      }
      __syncthreads();
    }
    { bf16* wrH = (bf16*)(ws + WS_WRH); bf16* wrL = (bf16*)(ws + WS_WRL); float* b1p = (float*)(ws + WS_B1P);
      for (int i = gt; i < NE * D; i += NGT) { const int e = i >> 10, k = i & 1023; const float w = g_mlp[k] * w_router[(size_t)k * NE + e]; const unsigned hb = f2bf(w);
          wrH[i] = (bf16)hb; wrL[i] = (bf16)f2bf(w - __builtin_bit_cast(float, hb << 16)); }
      for (int i = gt; i < NE * 2048; i += NGT) { const int e = i >> 11, r = i & 2047, pn = r >> 8, rho = r & 255; const int o = 128 * pn + (rho & 127); b1p[i] = b1[(size_t)e * 2048 + 2 * o + (rho >> 7)]; }
      bf16* PB = (bf16*)(ws + WS_PB);
      for (int i = gt; i < NTOK * PLE / 8; i += NGT) { const f32x4 a = *(const f32x4*)(p + (size_t)i * 8), b = *(const f32x4*)(p + (size_t)i * 8 + 4);
          v4u o; o.x = pk2(a.x, a.y); o.y = pk2(a.z, a.w); o.z = pk2(b.x, b.y); o.w = pk2(b.z, b.w); *(GAS v4u*)(PB + (size_t)i * 8) = o; }
    }
    { LAS float* scr = (LAS float*)(F.lds + RING_OFF + F.wave * 16384);
      constexpr int I_W1 = NE * 16 * 64, I_W2 = NE * 16 * 32, I_IN = 16 * 96, I_O = 16 * 32, I_G = 16 * 32, I_P = 4 * 32;
      constexpr int NITEMS = I_W1 + I_W2 + I_IN + I_O + I_G + I_P;
      for (int it = gw; it < NITEMS; it += NGW) {
          int r = it;
          if (r < I_W1) { const int e = r >> 10, q = r & 1023, kb = q >> 6, nb = q & 63;
              tr_item(w1 + (size_t)e * D * 2048, 2048, 64 * kb, 32 * nb, 32 * nb, 2, (bf16*)(ws + WS_W1) + (size_t)e * 2048 * D, D, scr, F.lane); continue; } r -= I_W1;
          if (r < I_W2) { const int e = r >> 9, q = r & 511, kb = q >> 5, nb = q & 31;
              tr_item(w2 + (size_t)e * FF * D, D, 64 * kb, 32 * nb, 32 * nb, 0, (bf16*)(ws + WS_W2) + (size_t)e * D * FF, FF, scr, F.lane); continue; } r -= I_W2;
          if (r < I_IN) { const int kb = r / 96, nb = r % 96; const int P0 = 32 * nb;
              tr_item(w_in, INW, 64 * kb, P0 + (P0 >= 1536 ? 8 : 0), P0, 1, (bf16*)(ws + WS_WIN), D, scr, F.lane); continue; } r -= I_IN;
          if (r < I_O) { const int kb = r >> 5, nb = r & 31; tr_item(w_out, D, 64 * kb, 32 * nb, 32 * nb, 0, (bf16*)(ws + WS_WOUT), D, scr, F.lane); continue; } r -= I_O;
          if (r < I_G) { const int kb = r >> 5, nb = r & 31; tr_item(w_pg, D, 64 * kb, 32 * nb, 32 * nb, 0, (bf16*)(ws + WS_WG), D, scr, F.lane); continue; } r -= I_G;
          { const int kb = r >> 5, nb = r & 31; tr_item(w_pp, D, 64 * kb, 32 * nb, 32 * nb, 0, (bf16*)(ws + WS_WP), PLE, scr, F.lane); }
      }
    }
}

__device__ __forceinline__ void p1_scan(Frame& F) {
    const float* LF = (const float*)(F.ws + WS_LF); float* CS = (float*)(F.ws + WS_CS);
    LAS float* sc = (LAS float*)(F.lds + RING_OFF);
    for (int seq = F.vcu; seq < BATCH * NFOX; seq += F.G) {
        const int b = seq >> 3, h = seq & 7;
        float v[4];
#pragma unroll
        for (int i = 0; i < 4; ++i) v[i] = LF[((size_t)b * SEQ + 4 * F.tid + i) * 8 + h];
        v[1] += v[0]; v[2] += v[1]; v[3] += v[2];
        float incl = v[3];
#pragma unroll
        for (int o = 1; o < 64; o <<= 1) { const float t = __shfl_up(incl, o); if (F.lane >= o) incl += t; }
        if (F.lane == 63) sc[F.wave] = incl;
        __syncthreads();
        float off = incl - v[3];
        for (int w = 0; w < F.wave; ++w) off += sc[w];
        f32x4 o; o.x = -(off + v[0]) * LOG2E; o.y = -(off + v[1]) * LOG2E; o.z = -(off + v[2]) * LOG2E; o.w = -(off + v[3]) * LOG2E;
        *(f32x4*)(CS + (size_t)seq * SEQ + 4 * F.tid) = o;
        __syncthreads();
    }
}

constexpr int AT_K = 0, AT_V = 18432, AT_WS = 55296, AT_TAB = 56320;
template <int DV, int MODE>
__device__ __forceinline__ void attn_simple(LAS unsigned char* lds, const bf16* Qb, const bf16* Kb, const bf16* Vb, int q0, f32x16 (&o)[DV / 32]) {
    int tid = threadIdx.x; asm volatile("" : "+v"(tid));
    const int lane = tid & 63, r32 = lane & 31, hi = lane >> 5; const int wid = __builtin_amdgcn_readfirstlane(tid >> 6);
    LAS float* wsf = (LAS float*)(lds + AT_WS) + wid * 32;
    const LAS float* tab = (const LAS float*)(lds + AT_TAB);
    const int NT = (q0 + 256) / 64; const int qabs = q0 + 32 * wid + r32;
    bf16x8 qr[4];
#pragma unroll
    for (int d0 = 0; d0 < 4; ++d0) qr[d0] = *(const bf16x8*)(Qb + (size_t)qabs * NPROJ + 16 * d0 + 8 * hi);
    const int skv = tid >> 3, sch = tid & 7;
    v4u kreg, vreg[DV / 64];
    kreg = *(const v4u*)(Kb + (size_t)skv * NPROJ + 8 * sch);
#pragma unroll
    for (int c = 0; c < DV / 64; ++c) vreg[c] = *(const v4u*)(Vb + (size_t)skv * NPROJ + 64 * c + 8 * sch);
    float m = -INFINITY, l = 0.f;
#pragma unroll
    for (int d0 = 0; d0 < DV / 32; ++d0) o[d0] = f32x16{};
    for (int t = 0; t < NT; ++t) {
        const int buf = t & 1; const int k0 = 64 * t;
        LAS unsigned char* Ks = lds + AT_K + buf * 9216; LAS unsigned char* Vt = lds + AT_V + buf * (DV * 144);
        *(LAS v4u*)(Ks + skv * 144 + sch * 16) = kreg;
#pragma unroll
        for (int c = 0; c < DV / 64; ++c) { const unsigned wv[4] = {vreg[c].x, vreg[c].y, vreg[c].z, vreg[c].w};
#pragma unroll
            for (int i = 0; i < 8; ++i) *(LAS unsigned short*)(Vt + (64 * c + 8 * sch + i) * 144 + skv * 2) = (unsigned short)(wv[i >> 1] >> (16 * (i & 1))); }
        __syncthreads();
        if (t + 1 < NT) { kreg = *(const v4u*)(Kb + (size_t)(k0 + 64 + skv) * NPROJ + 8 * sch);
#pragma unroll
            for (int c = 0; c < DV / 64; ++c) vreg[c] = *(const v4u*)(Vb + (size_t)(k0 + 64 + skv) * NPROJ + 64 * c + 8 * sch); }
        f32x16 p0, p1;
        if (MODE == 0) { const LAS float* tb = tab + k0 + 4 * hi;
#pragma unroll
            for (int g = 0; g < 4; ++g) { const f32x4 a = *(const LAS f32x4*)(tb + 8 * g), b = *(const LAS f32x4*)(tb + 32 + 8 * g);
                p0[4 * g] = a.x; p0[4 * g + 1] = a.y; p0[4 * g + 2] = a.z; p0[4 * g + 3] = a.w; p1[4 * g] = b.x; p1[4 * g + 1] = b.y; p1[4 * g + 2] = b.z; p1[4 * g + 3] = b.w; }
        } else { const LAS float* tb = tab + (k0 - qabs + 2047) + 4 * hi;
#pragma unroll
            for (int r = 0; r < 16; ++r) { p0[r] = tb[(r & 3) + 8 * (r >> 2)]; p1[r] = tb[32 + (r & 3) + 8 * (r >> 2)]; } }
#pragma unroll
        for (int d0 = 0; d0 < 4; ++d0) {
            const bf16x8 a0 = *(const LAS bf16x8*)(Ks + r32 * 144 + (16 * d0 + 8 * hi) * 2), a1 = *(const LAS bf16x8*)(Ks + (32 + r32) * 144 + (16 * d0 + 8 * hi) * 2);
            p0 = __builtin_amdgcn_mfma_f32_32x32x16_bf16(a0, qr[d0], p0, 0, 0, 0); p1 = __builtin_amdgcn_mfma_f32_32x32x16_bf16(a1, qr[d0], p1, 0, 0, 0); }
        if (t >= NT - 4) {
#pragma unroll
            for (int r = 0; r < 16; ++r) { const int kv = k0 + crow(r, hi); if (kv > qabs) p0[r] = -INFINITY; if (kv + 32 > qabs) p1[r] = -INFINITY; } }
        float mx = fmaxf(p0[0], p1[0]);
#pragma unroll
        for (int r = 1; r < 16; ++r) mx = fmaxf(mx, fmaxf(p0[r], p1[r]));
        mx = fmaxf(mx, __shfl_xor(mx, 32));
        const float mnew = fmaxf(m, mx); const float f = __builtin_amdgcn_exp2f(m - mnew); m = mnew;
        float ls = 0.f;
#pragma unroll
        for (int r = 0; r < 16; ++r) { p0[r] = __builtin_amdgcn_exp2f(p0[r] - m); p1[r] = __builtin_amdgcn_exp2f(p1[r] - m); ls += p0[r] + p1[r]; }
        l = l * f + ls;
        if (hi == 0) wsf[r32] = f;
        asm volatile("s_waitcnt lgkmcnt(0)" ::: "memory");
#pragma unroll
        for (int r = 0; r < 16; ++r) { const float fr_ = wsf[crow(r, hi)];
#pragma unroll
            for (int d0 = 0; d0 < DV / 32; ++d0) o[d0][r] *= fr_; }
        v4u pw[4];
        pw[0] = (v4u){cvt_pk_bf16(p0[0], p0[1]), cvt_pk_bf16(p0[2], p0[3]), cvt_pk_bf16(p0[4], p0[5]), cvt_pk_bf16(p0[6], p0[7])};
        pw[1] = (v4u){cvt_pk_bf16(p0[8], p0[9]), cvt_pk_bf16(p0[10], p0[11]), cvt_pk_bf16(p0[12], p0[13]), cvt_pk_bf16(p0[14], p0[15])};
        pw[2] = (v4u){cvt_pk_bf16(p1[0], p1[1]), cvt_pk_bf16(p1[2], p1[3]), cvt_pk_bf16(p1[4], p1[5]), cvt_pk_bf16(p1[6], p1[7])};
        pw[3] = (v4u){cvt_pk_bf16(p1[8], p1[9]), cvt_pk_bf16(p1[10], p1[11]), cvt_pk_bf16(p1[12], p1[13]), cvt_pk_bf16(p1[14], p1[15])};
#pragma unroll
        for (int s = 0; s < 4; ++s)
#pragma unroll
            for (int d0 = 0; d0 < DV / 32; ++d0) { const LAS unsigned char* vb = Vt + (32 * d0 + r32) * 144 + (16 * s + 4 * hi) * 2;
                const s16x4 lo = *(const LAS s16x4*)vb, hh = *(const LAS s16x4*)(vb + 16);
                const bf16x8 vf = (bf16x8){lo[0], lo[1], lo[2], lo[3], hh[0], hh[1], hh[2], hh[3]};
                o[d0] = __builtin_amdgcn_mfma_f32_32x32x16_bf16(__builtin_bit_cast(bf16x8, pw[s]), vf, o[d0], 0, 0, 0); }
        asm volatile("s_waitcnt lgkmcnt(0)" ::: "memory");
    }
    l += __shfl_xor(l, 32);
    if (hi == 0) wsf[r32] = 1.0f / l;
    asm volatile("s_waitcnt lgkmcnt(0)" ::: "memory");
#pragma unroll
    for (int r = 0; r < 16; ++r) { const float fr_ = wsf[crow(r, hi)];
#pragma unroll
        for (int d0 = 0; d0 < DV / 32; ++d0) o[d0][r] *= fr_; }
    asm volatile("s_waitcnt lgkmcnt(0)" ::: "memory");
    __syncthreads();
}
__device__ __forceinline__ int t5_bucket(int n) {
    if (n < 16) return n;
    int b = 16;
    b += (n >= 19); b += (n >= 21); b += (n >= 24); b += (n >= 27); b += (n >= 31); b += (n >= 35); b += (n >= 40); b += (n >= 46);
    b += (n >= 52); b += (n >= 59); b += (n >= 67); b += (n >= 77); b += (n >= 87); b += (n >= 99); b += (n >= 113);
    return b;
}
__device__ __forceinline__ void p2_attention(Frame& F) {
    const bf16* PROJ = (const bf16*)(F.ws + WS_PROJ); bf16* MIXED = (bf16*)(F.ws + WS_MIXED); float* OD = (float*)(F.ws + WS_OD); const float* CS = (const float*)(F.ws + WS_CS);
    const float* rel_bias = KARG->in[2]; const float* g_subln = KARG->in[14];
    const int lane = F.lane, r32 = lane & 31, hi = lane >> 5, wid = F.wave;
    LAS float* tab = (LAS float*)(F.lds + AT_TAB);
    for (int pi = F.vcu; pi < 128 * 4; pi += F.G) {
        const int bh = pi >> 2, s = pi & 3, b = bh >> 3, h = bh & 7;
        for (int half = 0; half < 2; ++half) {
            const int qb = half ? 7 - s : s, q0 = qb * 256;
            __syncthreads();
            for (int i = F.tid; i < q0 + 256; i += NWAVES * 64) tab[i] = CS[(size_t)bh * SEQ + i];
            __syncthreads();
            const bf16* base = PROJ + (size_t)b * SEQ * NPROJ;
            f32x16 o[2];
            attn_simple<64, 0>(F.lds, base + CQF + h * 64, base + CKF + h * 64, base + CVF + h * 64, q0, o);
            bf16* Ob = MIXED + ((size_t)b * SEQ + q0 + 32 * wid) * D + h * 64;
#pragma unroll
            for (int r = 0; r < 16; ++r)
#pragma unroll
                for (int d0 = 0; d0 < 2; ++d0) Ob[(size_t)crow(r, hi) * D + 32 * d0 + r32] = (bf16)f2bf(o[d0][r]);
        }
    }
    float lam;
    { const float a = KARG->in[10][lane] * KARG->in[11][lane], c = KARG->in[12][lane] * KARG->in[13][lane]; lam = expf(wave_sum(a)) - expf(wave_sum(c)) + 0.2f; }
    for (int pi = F.vcu; pi < 64 * 4; pi += F.G) {
        const int bh = pi >> 2, s = pi & 3, b = bh >> 2, h = bh & 3;
        __syncthreads();
        for (int i = F.tid; i < 2304; i += NWAVES * 64) { const int dist = 2047 - i; tab[i] = rel_bias[t5_bucket(dist > 0 ? dist : 0) * NDIFF + h] * LOG2E; }
        __syncthreads();
        for (int half = 0; half < 2; ++half) {
            const int qb = half ? 7 - s : s, q0 = qb * 256;
            const bf16* base = PROJ + (size_t)b * SEQ * NPROJ;
            float* Od = OD + ((size_t)b * SEQ + q0 + 32 * wid) * 512 + h * 128;
            f32x16 o[4];
            attn_simple<128, 1>(F.lds, base + CQD + h * 128, base + CKD + h * 128, base + CVD + h * 128, q0, o);
#pragma unroll
            for (int r = 0; r < 16; ++r)
#pragma unroll
                for (int d0 = 0; d0 < 4; ++d0) Od[(size_t)crow(r, hi) * 512 + 32 * d0 + r32] = o[d0][r];
            attn_simple<128, 1>(F.lds, base + CQD + h * 128 + 64, base + CKD + h * 128 + 64, base + CVD + h * 128, q0, o);
            float gs[4];
#pragma unroll
            for (int d0 = 0; d0 < 4; ++d0) gs[d0] = g_subln[32 * d0 + r32] * 0.8f;
            bf16* Ob = MIXED + ((size_t)b * SEQ + q0 + 32 * wid) * D + 512 + h * 128;
#pragma unroll
            for (int r = 0; r < 16; ++r) { float dv[4]; float ss = 0.f;
#pragma unroll
                for (int d0 = 0; d0 < 4; ++d0) { dv[d0] = Od[(size_t)crow(r, hi) * 512 + 32 * d0 + r32] - lam * o[d0][r]; ss += dv[d0] * dv[d0]; }
#pragma unroll
                for (int x = 1; x < 32; x <<= 1) ss += __shfl_xor(ss, x);
                const float rq = 1.0f / sqrtf(ss * (1.0f / 128.0f) + EPS);
#pragma unroll
                for (int d0 = 0; d0 < 4; ++d0) Ob[(size_t)crow(r, hi) * D + 32 * d0 + r32] = (bf16)f2bf(dv[d0] * rq * gs[d0]); }
        }
    }
}

__device__ __forceinline__ void p4_router(Frame& F) {
    const float* h1 = F.out; const float* g_mlp = KARG->in[16]; const float* b_router = KARG->in[18];
    const bf16* wrH = (const bf16*)(F.ws + WS_WRH); const bf16* wrL = (const bf16*)(F.ws + WS_WRL);
    bf16* A0 = (bf16*)(F.ws + WS_A0);
    int* tokE = (int*)(F.ws + WS_TOKE); float* gateE = (float*)(F.ws + WS_GATEE); float* rsE = (float*)(F.ws + WS_RSE); int* tp = (int*)(F.ws + WS_TP);
    const int lane = F.lane, r16 = lane & 15, kq = lane >> 4;
    LAS float* lg = (LAS float*)(F.lds + F.wave * 2560);
    LAS unsigned* hist = (LAS unsigned*)(F.lds + 32768); LAS unsigned* baseL = hist + 32;
    for (int g0 = F.vcu; g0 < NTOK / 128; g0 += F.G) {
        const int R0 = (g0 * NWAVES + F.wave) * 16; const int row = R0 + r16;
        if (F.tid < 32) hist[F.tid] = 0u;
        __syncthreads();
        f32x4 acc0 = {0.f, 0.f, 0.f, 0.f}, acc1 = {0.f, 0.f, 0.f, 0.f}; float ss = 0.f;
        const float* xr = h1 + (size_t)row * D + 8 * kq;
#pragma unroll 2
        for (int s = 0; s < 32; ++s) {
            const int k = 32 * s + 8 * kq;
            const f32x4 xa = *(const f32x4*)(xr + 32 * s), xb = *(const f32x4*)(xr + 32 * s + 4);
            const f32x4 ga = *(const f32x4*)(g_mlp + k), gb = *(const f32x4*)(g_mlp + k + 4);
            ss += (xa.x * xa.x + xa.y * xa.y) + (xa.z * xa.z + xa.w * xa.w) + (xb.x * xb.x + xb.y * xb.y) + (xb.z * xb.z + xb.w * xb.w);
            { v4u o; o.x = pk2(xa.x * ga.x, xa.y * ga.y); o.y = pk2(xa.z * ga.z, xa.w * ga.w); o.z = pk2(xb.x * gb.x, xb.y * gb.y); o.w = pk2(xb.z * gb.z, xb.w * gb.w);
              *(GAS v4u*)(A0 + (size_t)row * D + k) = o; }
            const float xv[8] = {xa.x, xa.y, xa.z, xa.w, xb.x, xb.y, xb.z, xb.w};
            unsigned hb[8], lb[8];
#pragma unroll
            for (int j = 0; j < 8; ++j) { hb[j] = f2bf(xv[j]); lb[j] = f2bf(xv[j] - __builtin_bit_cast(float, hb[j] << 16)); }
            const v4u ah = {hb[0] | (hb[1] << 16), hb[2] | (hb[3] << 16), hb[4] | (hb[5] << 16), hb[6] | (hb[7] << 16)};
            const v4u al = {lb[0] | (lb[1] << 16), lb[2] | (lb[3] << 16), lb[4] | (lb[5] << 16), lb[6] | (lb[7] << 16)};
            const bf16x8 Ah = __builtin_bit_cast(bf16x8, ah), Al = __builtin_bit_cast(bf16x8, al);
            const bf16x8 Bh0 = *(const bf16x8*)(wrH + (size_t)r16 * D + k), Bl0 = *(const bf16x8*)(wrL + (size_t)r16 * D + k);
            const bf16x8 Bh1 = *(const bf16x8*)(wrH + (size_t)(16 + r16) * D + k), Bl1 = *(const bf16x8*)(wrL + (size_t)(16 + r16) * D + k);
            acc0 = __builtin_amdgcn_mfma_f32_16x16x32_bf16(Ah, Bh0, acc0, 0, 0, 0); acc0 = __builtin_amdgcn_mfma_f32_16x16x32_bf16(Ah, Bl0, acc0, 0, 0, 0); acc0 = __builtin_amdgcn_mfma_f32_16x16x32_bf16(Al, Bh0, acc0, 0, 0, 0);
            acc1 = __builtin_amdgcn_mfma_f32_16x16x32_bf16(Ah, Bh1, acc1, 0, 0, 0); acc1 = __builtin_amdgcn_mfma_f32_16x16x32_bf16(Ah, Bl1, acc1, 0, 0, 0); acc1 = __builtin_amdgcn_mfma_f32_16x16x32_bf16(Al, Bh1, acc1, 0, 0, 0);
        }
        ss += __shfl_xor(ss, 16); ss += __shfl_xor(ss, 32);
        const float rs = 1.0f / sqrtf(ss * (1.0f / D) + EPS);
#pragma unroll
        for (int i = 0; i < 4; ++i) { lg[(4 * kq + i) * 33 + r16] = acc0[i]; lg[(4 * kq + i) * 33 + 16 + r16] = acc1[i]; }
        if (kq == 0) lg[16 * 33 + r16] = rs;
        asm volatile("s_waitcnt lgkmcnt(0)" ::: "memory");
        int se[4] = {0, 0, 0, 0}; float sg[4] = {0.f, 0.f, 0.f, 0.f}; unsigned rk[4] = {0u, 0u, 0u, 0u}; float myrs = 0.f;
        if (lane < 16) {
            myrs = lg[16 * 33 + lane];
            float v[32];
#pragma unroll
            for (int e = 0; e < 32; ++e) v[e] = lg[lane * 33 + e] * myrs + b_router[e];
            float sv[4];
#pragma unroll
            for (int k = 0; k < 4; ++k) { float best = v[0]; int bi = 0;
#pragma unroll
                for (int e = 1; e < 32; ++e) { const bool gt = v[e] > best; best = gt ? v[e] : best; bi = gt ? e : bi; }
                sv[k] = best; se[k] = bi;
#pragma unroll
                for (int e = 0; e < 32; ++e) v[e] = (e == bi) ? -INFINITY : v[e]; }
            float den = 0.f;
#pragma unroll
            for (int k = 0; k < 4; ++k) { sg[k] = expf(sv[k] - sv[0]); den += sg[k]; }
            const float inv = 1.0f / den;
#pragma unroll
            for (int k = 0; k < 4; ++k) { sg[k] *= inv; rk[k] = __hip_atomic_fetch_add(hist + se[k], 1u, __ATOMIC_RELAXED, __HIP_MEMORY_SCOPE_WORKGROUP); }
        }
        __syncthreads();
        if (F.tid < 32) { const unsigned c = hist[F.tid]; baseL[F.tid] = c ? __hip_atomic_fetch_add((unsigned*)(F.ctl + CW_CNT + 64 * F.tid), c, __ATOMIC_RELAXED, __HIP_MEMORY_SCOPE_AGENT) : 0u; }
        __syncthreads();
        if (lane < 16) {
            const int trow = R0 + lane;
#pragma unroll
            for (int k = 0; k < 4; ++k) { const unsigned pos = baseL[se[k]] + rk[k]; const size_t ix = (size_t)se[k] * ECAP + pos;
                tokE[ix] = trow; gateE[ix] = sg[k]; rsE[ix] = myrs; tp[(size_t)trow * 4 + k] = se[k] * 32768 + (int)pos; }
        }
        __syncthreads();
    }
}
__device__ __forceinline__ int moe_tables(Frame& F) {
    LAS int* ts = lds_tstart(F.lds); LAS int* cn = lds_cnt(F.lds); LAS unsigned short* te = lds_tileE(F.lds);
    __syncthreads();
    if (F.tid < 64) {
        const int c = F.tid < 32 ? (int)__hip_atomic_load((unsigned*)(F.ctl + CW_CNT + 64 * F.tid), __ATOMIC_RELAXED, __HIP_MEMORY_SCOPE_AGENT) : 0;
        const int nt = (c + 255) >> 8; int incl = nt;
#pragma unroll
        for (int o = 1; o < 32; o <<= 1) { const int t = __shfl_up(incl, o); if (F.lane >= o) incl += t; }
        if (F.tid < 32) { cn[F.tid] = c; ts[F.tid] = incl - nt; if (F.tid == 31) ts[32] = incl; }
    }
    __syncthreads();
    const int total = ts[32];
    for (int t = F.tid; t < total; t += NWAVES * 64) { int e = 0;
#pragma unroll
        for (int j = 1; j < 32; ++j) e += (t >= ts[j]) ? 1 : 0;
        te[t] = (unsigned short)e; }
    __syncthreads();
    return total;
}
__device__ __forceinline__ void p7_combine(Frame& F) {
    const bf16* Y = (const bf16*)(F.ws + WS_Y); const int* tp = (const int*)(F.ws + WS_TP); bf16* A3 = (bf16*)(F.ws + WS_A3); float* rs3 = (float*)(F.ws + WS_RS3);
    const float* g_ple = KARG->in[23]; float* h = F.out;
    LAS int* ts = lds_tstart(F.lds);
    const int gw = F.vcu * NWAVES + F.wave, NGW = F.G * NWAVES;
    f32x4 gv[4];
#pragma unroll
    for (int j = 0; j < 4; ++j) gv[j] = *(const f32x4*)(g_ple + 256 * j + 4 * F.lane);
    for (int m = gw; m < NTOK; m += NGW) {
        GAS f32x4* hr = (GAS f32x4*)(h + (size_t)m * D) + F.lane;
        f32x4 v[4];
#pragma unroll
        for (int j = 0; j < 4; ++j) v[j] = hr[64 * j];
#pragma unroll
        for (int k = 0; k < 4; ++k) { const int t = tp[(size_t)m * 4 + k]; const int e = t >> 15, pos = t & 32767; const size_t yr = (size_t)ts[e] * 256 + pos;
            const GAS u32x2v* yp = (const GAS u32x2v*)(Y + yr * D) + F.lane;
#pragma unroll
            for (int j = 0; j < 4; ++j) { const u32x2v w = yp[64 * j]; v[j].x += bflo(w.x); v[j].y += bfhi(w.x); v[j].z += bflo(w.y); v[j].w += bfhi(w.y); } }
        float ss = 0.f;
        GAS unsigned long long* o8 = (GAS unsigned long long*)(A3 + (size_t)m * D) + F.lane;
#pragma unroll
        for (int j = 0; j < 4; ++j) { hr[64 * j] = v[j]; ss += (v[j].x * v[j].x + v[j].y * v[j].y) + (v[j].z * v[j].z + v[j].w * v[j].w);
            const f32x4 y = v[j] * gv[j]; o8[64 * j] = (unsigned long long)pk2(y.x, y.y) | ((unsigned long long)pk2(y.z, y.w) << 32); }
        ss = wave_sum(ss);
        if (F.lane == 0) rs3[m] = 1.0f / sqrtf(ss * (1.0f / D) + EPS);
    }
}

__global__ void __launch_bounds__(NWAVES * 64, 2) fwd_kernel(Args args) {
    extern __shared__ __attribute__((aligned(16))) unsigned char lds[];
    Frame F;
    F.lds = (LAS unsigned char*)lds;
    F.MISC = (volatile LAS unsigned*)(F.lds + MISC_OFF);
    FRESH(F);
    F.G = gridDim.x; { const int bx = blockIdx.x; F.vcu = (F.G % 8 == 0) ? (bx % 8) * (F.G / 8) + bx / 8 : bx; }
    F.ws = KARG->ws; F.ctl = (gu32*)(KARG->ws + WS_CTL); F.out = KARG->out;
    unsigned char* ws = KARG->ws;
    if (F.tid < 64) ((LAS unsigned*)(F.lds + MISC_OFF))[F.tid] = 0u;
    __syncthreads();
    XcdBarrier bar = xcd_barrier_post((unsigned*)(F.ctl + CW_BAR), F.MISC + 8);
    const int lo = KARG->ph_lo, hi = KARG->ph_hi;
#ifndef PHMASK
#define PHMASK 0x1ff
#endif
#define IN(k) (((PHMASK >> (k)) & 1) && lo <= (k) && (k) < hi)
#define BOTH(k) (IN(k) && IN((k) + 1))
#define GRID_BAR() xcd_barrier(bar)

    if (IN(0)) { FRESH(F); p0_prologue(F); if (BOTH(0)) GRID_BAR(); }

    if (IN(1)) {
        FRESH(F); p1_scan(F);
        { pg8::Gemm g{(const bf16*)(ws + WS_A0), D}; SchedC S{NTOK / 256, NPROJ / 256, F.G, (int)blockIdx.x, D, (const char*)(ws + WS_WIN)};
          EpiProj E{(bf16*)(ws + WS_PROJ), KARG->in[6], KARG->in[7], KARG->in[8], KARG->in[9]};
          pg8::gemm_phase<EpiProj, SchedC>(F.lds + RING_OFF, g, S, E); }
        { pg8::Gemm g{(const bf16*)(ws + WS_PB), PLE}; SchedC S{NTOK / 256, D / 256, F.G, (int)blockIdx.x, PLE, (const char*)(ws + WS_WP)};
          EpiBf16P E{(bf16*)(ws + WS_PP), D};
          pg8::gemm_phase<EpiBf16P, SchedC>(F.lds + RING_OFF, g, S, E); }
        if (BOTH(1)) GRID_BAR();
    }

    if (IN(2)) { FRESH(F); p2_attention(F); if (BOTH(2)) GRID_BAR(); }

    if (IN(3)) {
        pg8::Gemm g{(const bf16*)(ws + WS_MIXED), D}; SchedC S{NTOK / 256, D / 256, F.G, (int)blockIdx.x, D, (const char*)(ws + WS_WOUT)};
        EpiRes E{KARG->in[0], F.out};
        pg8::gemm_phase<EpiRes, SchedC>(F.lds + RING_OFF, g, S, E);
        if (BOTH(3)) GRID_BAR();
    }

    if (IN(4)) { FRESH(F); p4_router(F); if (BOTH(4)) GRID_BAR(); }

    if (IN(5)) {
        FRESH(F); const int ntile = moe_tables(F);
        typedef SchedM<true, 8, 2048> S1;
        S1 S{F.G, (int)blockIdx.x, (const char*)(ws + WS_W1), F.lds, ntile};
        { const int* tokE = (const int*)(ws + WS_TOKE); LAS int* tk = (LAS int*)(F.lds + TOKL_OFF); pg8::Unit u;
          for (int i = 0; i < 18 && S.next(i, u); ++i) if (F.tid < 256) { const int lr = u.lr0 + F.tid; tk[i * 256 + F.tid] = lr < lds_cnt(F.lds)[u.e] ? tokE[(size_t)u.e * ECAP + lr] : 0; }
          __syncthreads(); }
        pg8::Gemm g{(const bf16*)(ws + WS_A0), D};
        EpiSwiglu E{(bf16*)(ws + WS_HB), (const float*)(ws + WS_B1P), (const float*)(ws + WS_RSE), F.lds};
        pg8::gemm_phase<EpiSwiglu, S1>(F.lds + RING_OFF, g, S, E);
        if (BOTH(5)) GRID_BAR();
    }

    if (IN(6)) {
        FRESH(F); const int ntile = moe_tables(F);
        typedef SchedM<false, 4, 1024> S2;
        S2 S{F.G, (int)blockIdx.x, (const char*)(ws + WS_W2), F.lds, ntile};
        pg8::Gemm g{(const bf16*)(ws + WS_HB), FF};
        EpiY E{(bf16*)(ws + WS_Y), KARG->in[22], (const float*)(ws + WS_GATEE), F.lds};
        pg8::gemm_phase<EpiY, S2>(F.lds + RING_OFF, g, S, E);
        if (BOTH(6)) GRID_BAR();
    }

    if (IN(7)) { FRESH(F); (void)moe_tables(F); p7_combine(F); if (BOTH(7)) GRID_BAR(); }

    if (IN(8)) {
        pg8::Gemm g{(const bf16*)(ws + WS_A3), D}; SchedC S{NTOK / 256, D / 256, F.G, (int)blockIdx.x, D, (const char*)(ws + WS_WG)};
        EpiFinal E{F.out, (const bf16*)(ws + WS_PP), (const float*)(ws + WS_RS3)};
        pg8::gemm_phase<EpiFinal, SchedC>(F.lds + RING_OFF, g, S, E);
    }
#undef IN
#undef BOTH
#undef GRID_BAR
}

#ifndef MK_N_LAUNCHES
#define MK_N_LAUNCHES 9
#endif
extern "C" void kernel_launch(void* const* d_in, const int* in_sizes, int n_in, void* d_out, int out_size, void* d_ws, size_t ws_size, hipStream_t stream) {
    static int grid = 0;
    if (grid == 0) {
        if (n_in != 26 || in_sizes[0] != NTOK * D || out_size != NTOK * D || ws_size < WS_END) {
            fprintf(stderr, "kernel_launch: unexpected shapes (n_in %d, in0 %d, out %d, ws %zu need %zu); nothing launched\n", n_in, n_in > 0 ? in_sizes[0] : -1, out_size, ws_size, (size_t)WS_END); grid = -1; return; }
        int dev = 0, cus = 0, per_cu = 0;
        if (hipGetDevice(&dev) != hipSuccess || hipDeviceGetAttribute(&cus, hipDeviceAttributeMultiprocessorCount, dev) != hipSuccess) { grid = -1; return; }
        if (hipFuncSetAttribute((const void*)fwd_kernel, hipFuncAttributeMaxDynamicSharedMemorySize, LDS_BYTES) != hipSuccess) { fprintf(stderr, "kernel_launch: hipFuncSetAttribute failed\n"); grid = -1; return; }
        if (hipOccupancyMaxActiveBlocksPerMultiprocessor(&per_cu, (const void*)fwd_kernel, NWAVES * 64, LDS_BYTES) != hipSuccess || per_cu < 1)
            fprintf(stderr, "kernel_launch: note: occupancy query reports %d workgroups per CU\n", per_cu);
        (void)hipGetLastError();
        grid = cus;
        if (grid != 256) fprintf(stderr, "kernel_launch: note: %d CUs (tuned for 256)\n", grid);
    }
    if (grid < 0) return;
    if (hipMemsetAsync((char*)d_ws + WS_CTL, 0, CTL_ZERO_BYTES, stream) != hipSuccess) { fprintf(stderr, "kernel_launch: memset failed\n"); return; }
    Args a{};
    for (int i = 0; i < 26; ++i) a.in[i] = (const float*)d_in[i];
    a.out = (float*)d_out; a.ws = (unsigned char*)d_ws;
#if MK_N_LAUNCHES == 1
    a.ph_lo = 0; a.ph_hi = 9;
    hipLaunchKernelGGL(fwd_kernel, dim3(grid), dim3(NWAVES * 64), LDS_BYTES, stream, a);
#else
    for (int ph = 0; ph < 9; ++ph) { a.ph_lo = ph; a.ph_hi = ph + 1; hipLaunchKernelGGL(fwd_kernel, dim3(grid), dim3(NWAVES * 64), LDS_BYTES, stream, a); }
#endif
    const hipError_t le = hipPeekAtLastError();
    if (le != hipSuccess) fprintf(stderr, "kernel_launch: launch failed: %s\n", hipGetErrorName(le));
}
```

```cpp
#include <hip/hip_runtime.h>
#include <cstdio>
#include <cstdint>

namespace pg8 {
#define PG8_LAS __attribute__((address_space(3)))
typedef unsigned short bf16_t;
typedef short bf16x8 __attribute__((ext_vector_type(8)));
typedef float f32x4 __attribute__((ext_vector_type(4)));
typedef float f32x2 __attribute__((ext_vector_type(2)));
typedef unsigned u32x4 __attribute__((ext_vector_type(4)));
typedef unsigned u32x2 __attribute__((ext_vector_type(2)));
constexpr int BM = 256, BK = 64, HALF = 128, HTB = HALF * BK * 2  , STAGE_BYTES = 8 * HTB, NXCD = 8, WGM = 8;

__host__ __device__ __forceinline__ int lds_byte(int r, int c) { const int st = (r >> 4) * 2 + (c >> 5), rr = r & 15, cc = c & 31, ob = rr * 64 + cc * 2; return st * 1024 + (ob ^ (((ob >> 9) & 1) << 5)); }
__host__ __device__ __forceinline__ void stage_rc(int b, int& R, int& C) { const int st = b / 1024, sb = b % 1024, swz = sb ^ (((sb >> 9) & 1) << 5); R = (st >> 1) * 16 + swz / 64; C = (st & 1) * 32 + (swz % 64) / 2; }
__host__ __device__ __forceinline__ int perm32(int rho) { const int n = rho >> 4, i = rho & 15; return 8 * (i >> 2) + 4 * n + (i & 3); }

struct Unit { int pm, pn, e, lr0, ui; };
struct Gemm { const bf16_t* A; int K; };

__device__ __forceinline__ bool order_tile(long L, int nM, int nN, int& pm, int& pn) {
    const int nwg = nM * nN; if (L >= nwg) return false;
    int wgid = (int)L; { const int q = nwg / NXCD, r = nwg % NXCD, xcd = wgid % NXCD, off = wgid / NXCD; wgid = (xcd < r ? xcd * (q + 1) : r * (q + 1) + (xcd - r) * q) + off; }
    const int nig = WGM * nN, gid = wgid / nig, fm = gid * WGM, gsz = (nM - fm) < WGM ? (nM - fm) : WGM;
    pm = fm + ((wgid % nig) % gsz); pn = (wgid % nig) / gsz; return true;
}

typedef float f32x2_t __attribute__((ext_vector_type(2))); typedef __bf16 bf16x2_t __attribute__((ext_vector_type(2)));
__device__ __forceinline__ unsigned cvt_pk_bf16(float lo, float hi) { f32x2_t v = {lo, hi}; bf16x2_t b = __builtin_convertvector(v, bf16x2_t); return __builtin_bit_cast(unsigned, b); }

typedef int v8i __attribute__((ext_vector_type(8))); typedef int v4i __attribute__((ext_vector_type(4)));
__device__ __forceinline__ v8i cat8(bf16x8 a, bf16x8 b) { return __builtin_shufflevector(__builtin_bit_cast(v4i, a), __builtin_bit_cast(v4i, b), 0, 1, 2, 3, 4, 5, 6, 7); }
template <class Epi, class Sched, bool F8 = false>
__device__ __forceinline__ void gemm_phase(PG8_LAS unsigned char* lds, const Gemm g, const Sched& S, const Epi& E) {
    int tid = threadIdx.x; asm volatile("" : "+v"(tid));
    const int wid = __builtin_amdgcn_readfirstlane(tid >> 6), lane = tid & 63, wr = wid >> 2, wc = wid & 3, fr = lane & 15, fq = lane >> 4;
    const int K = g.K, nt = K / BK;
    unsigned voffB[2]; int aR[2], aC[2];
#pragma unroll
    for (int i = 0; i < 2; ++i) { int R, C; stage_rc(tid * 16 + i * 8192, R, C); const int Rb = Epi::PERM ? ((R & ~31) + perm32(R & 31)) : R;
        aR[i] = R; aC[i] = C; voffB[i] = (unsigned)(Rb * K + C) * 2u; }
    const size_t kstep = (size_t)(BK * 2);
    const size_t hstep = (size_t)HALF * K * 2;
    const unsigned ldsw = (unsigned)wid * 1024u;
    const int aoff = lds_byte(wr * 64 + fr, fq * 8), boff = lds_byte(wc * 32 + fr, fq * 8);
#define PG8_SA(b, h) (((b) * 2 + (h)) * HTB)
#define PG8_SB(b, h) ((4 + (b) * 2 + (h)) * HTB)
#define PG8_STAGE(bufoff, gbase, voff) do { _Pragma("unroll") for (int _i = 0; _i < 2; ++_i) \
        __builtin_amdgcn_global_load_lds((const unsigned*)((const char*)(gbase) + (voff)[_i]), (PG8_LAS unsigned*)(lds + (bufoff) + ldsw + _i * 8192), 16, 0, 0); } while (0)
#define PG8_LDA(dst, b, h) do { if constexpr (F8) { _Pragma("unroll") for (int m = 0; m < 4; ++m) dst##8[m] = cat8(*(const PG8_LAS bf16x8*)(lds + PG8_SA(b, h) + aoff + m * 2048), *(const PG8_LAS bf16x8*)(lds + PG8_SA(b, h) + aoff + m * 2048 + 1024)); } \
        else { _Pragma("unroll") for (int m = 0; m < 4; ++m) _Pragma("unroll") for (int k = 0; k < 2; ++k) dst[m][k] = *(const PG8_LAS bf16x8*)(lds + PG8_SA(b, h) + aoff + m * 2048 + k * 1024); } } while (0)
#define PG8_LDB(dst, b, h) do { if constexpr (F8) { _Pragma("unroll") for (int n = 0; n < 2; ++n) dst##8[n] = cat8(*(const PG8_LAS bf16x8*)(lds + PG8_SB(b, h) + boff + n * 2048), *(const PG8_LAS bf16x8*)(lds + PG8_SB(b, h) + boff + n * 2048 + 1024)); } \
        else { _Pragma("unroll") for (int n = 0; n < 2; ++n) _Pragma("unroll") for (int k = 0; k < 2; ++k) dst[n][k] = *(const PG8_LAS bf16x8*)(lds + PG8_SB(b, h) + boff + n * 2048 + k * 1024); } } while (0)
#define PG8_MMA(ai, bj, At, Bt) do { __builtin_amdgcn_s_setprio(1); \
        if constexpr (F8) { _Pragma("unroll") for (int m = 0; m < 4; ++m) _Pragma("unroll") for (int n = 0; n < 2; ++n) \
            asm volatile("v_mfma_scale_f32_16x16x128_f8f6f4 %0, %1, %2, %0, %3, %4 op_sel_hi:[0,0,0]" : "+v"(acc[ai][bj][m][n]) : "v"(Bt##8[n]), "v"(At##8[m]), "v"(scW)  , "v"(scX)); } \
        else { _Pragma("unroll") for (int m = 0; m < 4; ++m) _Pragma("unroll") for (int n = 0; n < 2; ++n) _Pragma("unroll") for (int k = 0; k < 2; ++k) \
            acc[ai][bj][m][n] = __builtin_amdgcn_mfma_f32_16x16x32_bf16(Bt[n][k], At[m][k], acc[ai][bj][m][n], 0, 0, 0); } \
        __builtin_amdgcn_s_setprio(0); } while (0)
#define PG8_WAIT_V(n) asm volatile("s_waitcnt vmcnt(" #n ")" ::: "memory")
#define PG8_WAIT_L(n) asm volatile("s_waitcnt lgkmcnt(" #n ")" ::: "memory")
#define PG8_BAR __builtin_amdgcn_s_barrier()
#define PG8_SCHED __builtin_amdgcn_sched_barrier(0)
    Unit cur, nxt; int ui = 0;
    if (!S.next(0, cur)) return;
    f32x4 acc[2][2][4][2];
#pragma unroll
    for (int a = 0; a < 2; ++a)
#pragma unroll
        for (int b = 0; b < 2; ++b)
#pragma unroll
            for (int m = 0; m < 4; ++m)
#pragma unroll
                for (int n = 0; n < 2; ++n) acc[a][b][m][n] = (f32x4){0.f, 0.f, 0.f, 0.f};
    const int scW = 0x7A7A7A7A, scX = 0x7F7F7F7F;
    bf16x8 At[4][2], B0[2][2], B1[2][2]; v8i At8[4], B08[2], B18[2];
    constexpr bool GA = Sched::GATHER;
    constexpr int H1 = GA ? 1 : 0;
    const size_t HS = GA ? (size_t)0 : hstep;
    const char* cA = GA ? (const char*)g.A : (const char*)g.A + S.aoff_uniform(cur);
    const char* cB = S.bptr(cur);
    unsigned aoC[2][2], aoN[2][2];
    if constexpr (GA) S.aoffs(cur, aR, aC, aoC);
    else {
#pragma unroll
        for (int i = 0; i < 2; ++i) aoC[0][i] = (unsigned)(aR[i] * K + aC[i]) * 2u; }
    PG8_STAGE(PG8_SB(0, 0), cB, voffB); PG8_STAGE(PG8_SB(0, 1), cB + hstep, voffB); PG8_STAGE(PG8_SA(0, 0), cA, aoC[0]); PG8_STAGE(PG8_SA(0, 1), cA + HS, aoC[H1]);
    if (wr == 1) PG8_BAR;
    PG8_WAIT_V(2); PG8_BAR;
    PG8_STAGE(PG8_SB(1, 0), cB + kstep, voffB); PG8_STAGE(PG8_SA(1, 0), cA + kstep, aoC[0]); PG8_STAGE(PG8_SB(1, 1), cB + hstep + kstep, voffB);
    PG8_WAIT_V(6); PG8_BAR;
    for (;;) {
        if constexpr (Epi::PREFETCH) E.prefetch(cur, lds + 152064 + (ui & 1) * 2048, wid, lane);
        const bool has_next = S.next(ui + 1, nxt);
        const char* nB = has_next ? S.bptr(nxt) : cB;
        const char* nA = GA ? cA : (has_next ? (const char*)g.A + S.aoff_uniform(nxt) : cA);
        if constexpr (GA) {
            if (has_next) S.aoffs(nxt, aR, aC, aoN);
            else {
#pragma unroll
                for (int h = 0; h < 2; ++h)
#pragma unroll
                    for (int i = 0; i < 2; ++i) aoN[h][i] = aoC[h][i]; } }
#pragma unroll 1
        for (int t = 0; t < nt; t += 2) {
            const bool last = (t == nt - 2);
            const char* a1 = cA + (size_t)(t + 1) * kstep;
            const char* a2 = last ? nA : cA + (size_t)(t + 2) * kstep; const char* b2 = last ? nB : cB + (size_t)(t + 2) * kstep;
            const char* a3 = a2 + kstep; const char* b3 = b2 + kstep;
            unsigned ao2[2][2];
            if constexpr (GA) {
#pragma unroll
                for (int h = 0; h < 2; ++h)
#pragma unroll
                    for (int i = 0; i < 2; ++i) ao2[h][i] = last ? aoN[h][i] : aoC[h][i];
            } else {
#pragma unroll
                for (int i = 0; i < 2; ++i) ao2[0][i] = aoC[0][i]; }
            PG8_LDB(B0, 0, 0); PG8_LDB(B1, 0, 1); PG8_SCHED; PG8_LDA(At, 0, 0); PG8_STAGE(PG8_SA(1, 1), a1 + HS, aoC[H1]);
            PG8_WAIT_V(8); PG8_WAIT_L(0); PG8_BAR; PG8_MMA(0, 0, At, B0); PG8_MMA(0, 1, At, B1); PG8_BAR; PG8_SCHED;
            PG8_LDA(At, 0, 1); PG8_STAGE(PG8_SB(0, 0), b2, voffB); PG8_STAGE(PG8_SB(0, 1), b2 + hstep, voffB); PG8_STAGE(PG8_SA(0, 0), a2, ao2[0]);
            PG8_WAIT_V(8); PG8_WAIT_L(0); PG8_BAR; PG8_MMA(1, 0, At, B0); PG8_MMA(1, 1, At, B1); PG8_BAR; PG8_SCHED;
            PG8_LDB(B0, 1, 0); PG8_LDB(B1, 1, 1); PG8_SCHED; PG8_LDA(At, 1, 0); PG8_STAGE(PG8_SA(0, 1), a2 + HS, ao2[H1]);
            PG8_WAIT_V(8); PG8_WAIT_L(0); PG8_BAR; PG8_MMA(0, 0, At, B0); PG8_MMA(0, 1, At, B1); PG8_BAR; PG8_SCHED;
            PG8_LDA(At, 1, 1); PG8_STAGE(PG8_SB(1, 0), b3, voffB); PG8_STAGE(PG8_SB(1, 1), b3 + hstep, voffB); PG8_STAGE(PG8_SA(1, 0), a3, ao2[0]);
            PG8_WAIT_V(8); PG8_WAIT_L(0); PG8_BAR; PG8_MMA(1, 0, At, B0); PG8_MMA(1, 1, At, B1); PG8_BAR; PG8_SCHED;
        }
        if (wr == 0) PG8_BAR;
        if constexpr (F8) asm volatile("s_nop 15\n\ts_nop 15" ::: "memory");
        { int l2 = lane; asm volatile("" : "+v"(l2)); if constexpr (Epi::PREFETCH) E(acc, cur, wr, wc, l2 & 15, l2 >> 4, lds + 152064 + (ui & 1) * 2048); else E(acc, cur, wr, wc, l2 & 15, l2 >> 4); }
        if (!has_next) break;
#pragma unroll
        for (int a = 0; a < 2; ++a)
#pragma unroll
            for (int b = 0; b < 2; ++b)
#pragma unroll
                for (int m = 0; m < 4; ++m)
#pragma unroll
                    for (int n = 0; n < 2; ++n) acc[a][b][m][n] = (f32x4){0.f, 0.f, 0.f, 0.f};
        cur = nxt; cB = nB; cA = nA; ++ui;
        if constexpr (GA) {
#pragma unroll
            for (int h = 0; h < 2; ++h)
#pragma unroll
                for (int i = 0; i < 2; ++i) aoC[h][i] = aoN[h][i]; }
        if (wr == 1) PG8_BAR;
    }
    PG8_WAIT_V(0);
    PG8_BAR;
#undef PG8_SA
#undef PG8_SB
#undef PG8_STAGE
#undef PG8_LDA
#undef PG8_LDB
#undef PG8_MMA
#undef PG8_WAIT_V
#undef PG8_WAIT_L
#undef PG8_BAR
#undef PG8_SCHED
}
}

constexpr int NWAVES = 8;
constexpr int BATCH = 16, SEQ = 2048, D = 1024, NTOK = BATCH * SEQ;
constexpr int INW = 3080, NPROJ = 3072;
constexpr int NE = 32, TOPK = 4, FF = 1024, PLE = 256;
constexpr int HD = 64, NFOX = 8, NDIFF = 4;
constexpr int CQF = 0, CKF = 512, CVF = 1024, CQD = 1536, CKD = 2048, CVD = 2560;
constexpr float EPS = 1e-6f;
constexpr float LOG2E = 1.4426950408889634f;
constexpr float C2 = 0.125f * LOG2E;
constexpr int MAXTILES = 544;
constexpr int ECAP = NTOK;

constexpr size_t MiB = 1u << 20;
constexpr size_t WS_CTL = 0, CTL_ZERO_BYTES = 1 * MiB;
constexpr size_t WS_WRH = 1 * MiB, WS_WRL = WS_WRH + 65536, WS_B1P = WS_WRL + 65536;
constexpr size_t WS_LF = 2 * MiB, WS_CS = 3 * MiB;
constexpr size_t WS_TP = 4 * MiB, WS_RS3 = 4 * MiB + 512 * 1024;
constexpr size_t WS_TOKE = 5 * MiB, WS_GATEE = 9 * MiB, WS_RSE = 13 * MiB;
constexpr size_t WS_WIN = 17 * MiB, WS_WOUT = 23 * MiB, WS_WG = 25 * MiB, WS_WP = 27 * MiB;
constexpr size_t WS_W1 = 28 * MiB, WS_W2 = 156 * MiB;
constexpr size_t WS_PB = 220 * MiB, WS_PP = 236 * MiB;
constexpr size_t WS_PROJ = 300 * MiB, WS_MIXED = 492 * MiB, WS_A0 = 556 * MiB;
constexpr size_t WS_Y = WS_PROJ;
constexpr size_t WS_HB = 620 * MiB;
constexpr size_t WS_A3 = WS_HB;
constexpr size_t WS_H1B = 756 * MiB, WS_H2B = 820 * MiB;
constexpr size_t WS_END = 892 * MiB;
constexpr int CW_TMO = 0, CW_BAR = 4096, CW_CNT = 8192;

constexpr int RING_OFF = 0, RING_BYTES = 131072;
constexpr int TOKL_OFF = RING_BYTES, TOKL_BYTES = 18 * 1024;
constexpr int TILEE_OFF = TOKL_OFF + TOKL_BYTES, TILEE_BYTES = 2304;
constexpr int MISC_OFF = TILEE_OFF + TILEE_BYTES;
constexpr int EPI_OFF = MISC_OFF + 256, EPI_BYTES = 4096;
constexpr int LDS_BYTES = EPI_OFF + EPI_BYTES;
static_assert(EPI_OFF == 152064, "gemm_phase addresses the epilogue prefetch buffers at this offset");
static_assert(LDS_BYTES <= 160 * 1024, "LDS");

#define GAS __attribute__((address_space(1)))
#define LAS __attribute__((address_space(3)))
typedef unsigned short bf16;
typedef unsigned v4u __attribute__((ext_vector_type(4)));
typedef float f32x4 __attribute__((ext_vector_type(4)));
typedef short bf16x8 __attribute__((ext_vector_type(8)));
typedef GAS unsigned gu32;
typedef GAS unsigned long long gu64;
#define RLX_AGENT __ATOMIC_RELAXED, __HIP_MEMORY_SCOPE_AGENT
#define LDS_WAIT() asm volatile("s_waitcnt lgkmcnt(0)" ::: "memory")
#define VM_WAIT() asm volatile("s_waitcnt vmcnt(0)" ::: "memory")
__device__ __forceinline__ unsigned long long rt() { return __builtin_amdgcn_s_memrealtime(); }
__device__ __forceinline__ unsigned f2bf(float f) { unsigned u = __builtin_bit_cast(unsigned, f); return (u + 0x7fffu + ((u >> 16) & 1u)) >> 16; }
__device__ __forceinline__ unsigned pk2(float lo, float hi) { return f2bf(lo) | (f2bf(hi) << 16); }
#define XB_TMO      128
#define XB_XCNT(j)  (256  + 64 * (j))
#define XB_XSUB(j)  (1280 + 64 * (j))
#define XB_XGEN(j)  (2304 + 64 * (j))
#define XB_TOP      3328
#define XB_TOPGEN   3392
#define XCD_BAR_WORDS 3456
#define XB_SPIN_CAP (1u << 18)

__device__ __forceinline__ unsigned xb_ld(unsigned* p)              { return __hip_atomic_load(p, __ATOMIC_RELAXED, __HIP_MEMORY_SCOPE_AGENT); }
__device__ __forceinline__ unsigned xb_add(unsigned* p, unsigned v) { return __hip_atomic_fetch_add(p, v, __ATOMIC_RELAXED, __HIP_MEMORY_SCOPE_AGENT); }
__device__ __forceinline__ unsigned xb_xcc_id() { return (unsigned)__builtin_amdgcn_s_getreg((3 << 11) | 20) & 0xFu; }
#define XB_SPIN(cond, bar) do { unsigned _sp = 0; while (cond) { __builtin_amdgcn_s_sleep(1); \
    if ((++_sp & 255u) == 0u) { if (xb_ld(&(bar)[XB_TMO])) break; if (_sp > XB_SPIN_CAP) { atomicAdd(&(bar)[XB_TMO], 1u); break; } } } } while (0)

struct XcdBarrier {
    unsigned* bar; unsigned x;
    volatile LAS unsigned* st;
};

__device__ __forceinline__ XcdBarrier xcd_barrier_post(unsigned* bar, volatile LAS unsigned* st) {
    XcdBarrier b; b.bar = bar; b.x = xb_xcc_id(); b.st = st;
    if (threadIdx.x == 0) (void)xb_add(&bar[XB_XCNT(b.x)], 1u);
    return b;
}
__device__ __forceinline__ void xcd_barrier_complete(unsigned* bar, unsigned x, unsigned& nloc, unsigned& nx) {
    const unsigned G = gridDim.x * gridDim.y * gridDim.z;
    unsigned sum, cnt, mine, sp = 0u;
    for (;;) {
        sum = 0u; cnt = 0u; mine = 0u;
#pragma unroll
        for (unsigned j = 0; j < 16; ++j) { const unsigned c = xb_ld(&bar[XB_XCNT(j)]); sum += c; cnt += (c > 0u) ? 1u : 0u; mine = (j == x) ? c : mine; }
        if (sum == G) break;
        __builtin_amdgcn_s_sleep(1);
        if ((++sp & 255u) == 0u) { if (xb_ld(&bar[XB_TMO])) break; if (sp > XB_SPIN_CAP) { atomicAdd(&bar[XB_TMO], 1u); break; } }
    }
    nloc = mine > 0u ? mine : 1u; nx = cnt > 0u ? cnt : 1u;
}

__device__ __forceinline__ void xcd_barrier(const XcdBarrier& b) {
    asm volatile("s_waitcnt vmcnt(0)" ::: "memory");
    __syncthreads();
    if (threadIdx.x == 0) {
        unsigned* bar = b.bar;
        __builtin_amdgcn_s_waitcnt(0);
        unsigned nloc = b.st[0], nx = b.st[1];
        if (nloc == 0u) { xcd_barrier_complete(bar, b.x, nloc, nx); b.st[0] = nloc; b.st[1] = nx; }
        const unsigned old = xb_add(&bar[XB_XSUB(b.x)], 1u);
        const unsigned gen = old / nloc;
        if (old + 1u == (gen + 1u) * nloc) {
            __builtin_amdgcn_fence(__ATOMIC_RELEASE, "agent");
            asm volatile("s_waitcnt vmcnt(0)" ::: "memory");
            const unsigned og = xb_add(&bar[XB_TOP], 1u);
            const unsigned tg = og / nx;
            if (og + 1u == (tg + 1u) * nx) xb_add(&bar[XB_TOPGEN], 1u);
            else XB_SPIN(xb_ld(&bar[XB_TOPGEN]) == tg, bar);
            __builtin_amdgcn_fence(__ATOMIC_ACQUIRE, "agent");
            xb_add(&bar[XB_XGEN(b.x)], 1u);
            asm volatile("s_waitcnt vmcnt(0)" ::: "memory");
        } else {
            XB_SPIN(xb_ld(&bar[XB_XGEN(b.x)]) == gen, bar);
            __builtin_amdgcn_fence(__ATOMIC_ACQUIRE, "agent");
            asm volatile("s_waitcnt vmcnt(0)" ::: "memory");
        }
    }
    __syncthreads();
}

namespace attn_body {
using bf16x8=__attribute__((ext_vector_type(8)))short;
using s16x4=__attribute__((ext_vector_type(4)))short;
using f32x16=__attribute__((ext_vector_type(16)))float;
using f32x4a=__attribute__((ext_vector_type(4)))float;
using u32x4=__attribute__((ext_vector_type(4)))unsigned;
constexpr int PQ=3072;
constexpr int NW=8,QBLK=32,QB=QBLK*NW,KVBLK=64;
__device__ __forceinline__ int crow(int r,int hi){return (r&3)+8*(r>>2)+4*hi;}
#define SBAR() __builtin_amdgcn_sched_barrier(0)
__device__ __forceinline__ void cmask(f32x16&p0,f32x16&p1,int jb,int qrel,int hi){
  const float NEG=-INFINITY; int kb=64*jb+4*hi;
  #pragma unroll
  for(int r=0;r<16;++r){int kv=kb+(r&3)+8*(r>>2); if(kv>qrel)p0[r]=NEG; if(kv+32>qrel)p1[r]=NEG;}
}
constexpr int NSLOT=3, SLOTB=8192;
constexpr int LDS_K=0, LDS_V=NSLOT*SLOTB, LDS_WS=2*NSLOT*SLOTB, LDS_OST=LDS_WS+NW*64*4, LDS_BYTES=LDS_OST+NW*4096;
constexpr int LDS_TAB=86016, LDS_ZERO=LDS_TAB+32768;
__device__ __forceinline__ void glds16(const void*gsrc,unsigned lds_dst){unsigned keep;
  asm volatile("s_mov_b32 %0, m0\n\ts_mov_b32 m0, %2\n\ts_nop 0\n\tglobal_load_lds_dwordx4 %1, off\n\ts_mov_b32 m0, %0":"=&s"(keep):"v"(gsrc),"s"(lds_dst):"memory");}
typedef float f32x2_t __attribute__((ext_vector_type(2))); typedef __bf16 bf16x2_t __attribute__((ext_vector_type(2)));
__device__ __forceinline__ unsigned cvtpk_s(float lo,float hi){f32x2_t v={lo,hi};bf16x2_t b=__builtin_convertvector(v,bf16x2_t);return __builtin_bit_cast(unsigned,b);}
#define WAIT_BAR(N) asm volatile("s_waitcnt vmcnt(" #N ") lgkmcnt(0)\n\ts_barrier":::"memory")
typedef __attribute__((address_space(3))) const char* lds_cptr;
typedef short v4i16_t __attribute__((ext_vector_type(4)));
__device__ __forceinline__ void kload8(bf16x8*kf,lds_cptr kp){
  kf[0]=*(const __attribute__((address_space(3))) bf16x8*)(kp);      kf[1]=*(const __attribute__((address_space(3))) bf16x8*)(kp+512);
  kf[2]=*(const __attribute__((address_space(3))) bf16x8*)(kp+2048); kf[3]=*(const __attribute__((address_space(3))) bf16x8*)(kp+2560);
  kf[4]=*(const __attribute__((address_space(3))) bf16x8*)(kp+4096); kf[5]=*(const __attribute__((address_space(3))) bf16x8*)(kp+4608);
  kf[6]=*(const __attribute__((address_space(3))) bf16x8*)(kp+6144); kf[7]=*(const __attribute__((address_space(3))) bf16x8*)(kp+6656);
}
__device__ __forceinline__ void kload2(bf16x8*kf,lds_cptr kp,int j){ kf[2*j]=*(const __attribute__((address_space(3))) bf16x8*)(kp+j*2048); kf[2*j+1]=*(const __attribute__((address_space(3))) bf16x8*)(kp+j*2048+512); }
__device__ __forceinline__ s16x4 vtr(lds_cptr p){ return __builtin_bit_cast(s16x4,__builtin_amdgcn_ds_read_tr16_b64_v4i16((__attribute__((address_space(3))) v4i16_t*)p)); }
__device__ __forceinline__ void pv(f32x16*o,int vb,bf16x8 pa0,bf16x8 pa1,bf16x8 pa2,bf16x8 pa3){
  #pragma unroll
  for(int d0=0;d0<2;++d0){s16x4 lo[4],hi[4];
    #pragma unroll
    for(int ks=0;ks<4;++ks){
      asm volatile("ds_read_b64_tr_b16 %0,%1 offset:%c2":"=&v"(lo[ks]):"v"(vb),"i"(d0*4096+ks*1024):"memory");
      asm volatile("ds_read_b64_tr_b16 %0,%1 offset:%c2":"=&v"(hi[ks]):"v"(vb),"i"(d0*4096+ks*1024+512):"memory");}
    asm volatile("s_waitcnt lgkmcnt(0)":::"memory");SBAR();
    #define PK(k) (bf16x8){lo[k][0],lo[k][1],lo[k][2],lo[k][3],hi[k][0],hi[k][1],hi[k][2],hi[k][3]}
    o[d0]=__builtin_amdgcn_mfma_f32_32x32x16_bf16(pa0,PK(0),o[d0],0,0,0);
    o[d0]=__builtin_amdgcn_mfma_f32_32x32x16_bf16(pa1,PK(1),o[d0],0,0,0);
    o[d0]=__builtin_amdgcn_mfma_f32_32x32x16_bf16(pa2,PK(2),o[d0],0,0,0);
    o[d0]=__builtin_amdgcn_mfma_f32_32x32x16_bf16(pa3,PK(3),o[d0],0,0,0);
    #undef PK
  }
}
typedef __attribute__((address_space(3))) const float* lds_fptr;
__device__ __forceinline__ void split3(float x,unsigned&h,unsigned&m,unsigned&l){ h=f2bf(x); const float r1=x-__builtin_bit_cast(float,h<<16); m=f2bf(r1); const float r2=r1-__builtin_bit_cast(float,m<<16); l=f2bf(r2); }
__device__ __forceinline__ bf16x8 mk_qm(float mhat,int hi){ unsigned h,m,l; split3(-mhat,h,m,l);
  u32x4 w; w[0]=0x3F803F80u; w[1]=0x3F80u|(h<<16); w[2]=m|(l<<16); w[3]=0u; if(hi){w[0]=0u;w[1]=0u;w[2]=0u;} return __builtin_bit_cast(bf16x8,w); }
__device__ __forceinline__ void bias_add(f32x16&X0,f32x16&X1,lds_fptr tb,int t){
  const lds_fptr p=tb+64*t;
  #pragma unroll
  for(int r=0;r<16;++r){ X0[r]+=p[(r&3)+8*(r>>2)]; X1[r]+=p[32+(r&3)+8*(r>>2)]; }
}
#ifndef ATTN_STORE16
#define ATTN_STORE16(p,v) (*(u32x4*)(p)=(v))
#endif
template<int THRL,int MODE,int PO> __device__ __forceinline__ void attn_unit(int q0,int NTp,const bf16*Q,const bf16*__restrict__ K,const bf16*__restrict__ V,bf16*O,char*shm){
  int tid=threadIdx.x; asm volatile("":"+v"(tid));
  const int lane=tid&63,r32=lane&31,hi=lane>>5; const int wid=__builtin_amdgcn_readfirstlane(tid>>6);
  const bf16*Qw=Q+(long)(q0+wid*QBLK)*PQ;
  const unsigned lds0=(unsigned)(uintptr_t)shm;
  float*wsf=(float*)(shm+LDS_WS)+wid*64;
  const bf16*ksrc=K+(long)lane*PQ+wid*8;
  const bf16*vsrc=V+(long)(16*(wid&3)+(lane>>2))*PQ+(wid>>2)*32+(lane&3)*8;
  const unsigned kdst=lds0+LDS_K+wid*1024, vdst=lds0+LDS_V+wid*1024;
  #define DMA_K(t,slot) glds16(ksrc+(long)(t)*KVBLK*PQ,(unsigned)__builtin_amdgcn_readfirstlane(kdst+(slot)))
  #define DMA_V(t,slot) glds16(vsrc+(long)(t)*KVBLK*PQ,(unsigned)__builtin_amdgcn_readfirstlane(vdst+(slot)))
  const int vb0=(int)(lds0+LDS_V)+((lane>>4)&1)*32+(lane&3)*8+(4*hi+((lane&15)>>2))*64;
  bf16x8 kf[8];
  const lds_cptr shm3=(lds_cptr)shm; const lds_cptr kp0=shm3+LDS_K+hi*1024+r32*16; const lds_cptr vp0=shm3+LDS_V+((lane>>4)&1)*32+(lane&3)*8+(4*hi+((lane&15)>>2))*64;
  const int qrel=wid*QBLK+r32;
  const lds_fptr tb=(lds_fptr)(shm3+LDS_TAB)+(2047-(q0+qrel))+4*hi;
  const lds_cptr kbp=hi?(shm3+LDS_ZERO-16*64*0):(shm3+LDS_TAB+16*r32);
  const int kbs=hi?0:1024;
  bf16x8 kb0,kb1;
  { u32x4 w; w[0]=0u; w[1]=hi?0u:0x3F800000u; w[2]=hi?0u:0x3F803F80u; w[3]=0u; kb0=__builtin_bit_cast(bf16x8,w); kb1=kb0; }
  #define KBLD(t) do{ if(MODE==0){ kb0=*(const __attribute__((address_space(3))) bf16x8*)(kbp+(t)*kbs); kb1=*(const __attribute__((address_space(3))) bf16x8*)(kbp+(t)*kbs+(hi?0:512)); } }while(0)
  bf16x8 qm=mk_qm(0.f,hi);
  const int NT=NTp;
  DMA_K(0,0);DMA_V(0,0);DMA_K(1,SLOTB);
  bf16x8 qr[4];
  #pragma unroll
  for(int d0=0;d0<4;++d0)qr[d0]=*reinterpret_cast<const bf16x8*>(&Qw[(long)r32*PQ+d0*16+hi*8]);
  float mhat=0.f,l_reg=0.f;f32x16 o[2];o[0]=f32x16{};o[1]=f32x16{};
  #define CMASK(P0,P1,t) do{int jb_=(t)-(NT-4); if(jb_>=0)cmask(P0,P1,jb_,qrel,hi);}while(0)
  bool resc=false;
  #define RESC() do{ if(resc){ asm volatile("s_waitcnt lgkmcnt(0)":::"memory"); \
      _Pragma("unroll") for(int d_=0;d_<2;++d_) _Pragma("unroll") for(int r=0;r<16;++r)o[d_][r]*=wsf[crow(r,hi)]; } }while(0)
  f32x16 pA0,pA1,pB0,pB1;
  int sl_prev=0,sl_cur=0,sl_next=SLOTB;
  #define ROT() do{sl_prev=sl_cur;sl_cur=sl_next;sl_next=(sl_next==(NSLOT-1)*SLOTB)?0:sl_next+SLOTB;}while(0)
  DMA_K(2,2*SLOTB);
  KBLD(0);
  WAIT_BAR(3);
  { const lds_cptr kb=kp0; const f32x16 z16=f32x16{};
    pA0=__builtin_amdgcn_mfma_f32_32x32x16_bf16(kb0,qm,z16,0,0,0); pA1=__builtin_amdgcn_mfma_f32_32x32x16_bf16(kb1,qm,z16,0,0,0);
    #pragma unroll
    for(int d0=0;d0<4;++d0){ const bf16x8 b0=*(const __attribute__((address_space(3))) bf16x8*)(kb+d0*2048), b1=*(const __attribute__((address_space(3))) bf16x8*)(kb+d0*2048+512);
      pA0=__builtin_amdgcn_mfma_f32_32x32x16_bf16(b0,qr[d0],pA0,0,0,0); pA1=__builtin_amdgcn_mfma_f32_32x32x16_bf16(b1,qr[d0],pA1,0,0,0); } }
  if(MODE==1&&NT<=6)bias_add(pA0,pA1,tb,0);
  CMASK(pA0,pA1,0);
  { float rm=fmaxf(pA0[0],pA1[0]);
    #pragma unroll
    for(int r=1;r<16;++r)rm=fmaxf(rm,fmaxf(pA0[r],pA1[r]));
    { auto rr=__builtin_amdgcn_permlane32_swap(__float_as_uint(rm),__float_as_uint(rm),false,false); rm=fmaxf(__uint_as_float(rr[0]),__uint_as_float(rr[1])); }
    mhat=rm;
    #pragma unroll
    for(int r=0;r<16;++r){pA0[r]=__builtin_amdgcn_exp2f(pA0[r]-rm);pA1[r]=__builtin_amdgcn_exp2f(pA1[r]-rm);} }
  qm=mk_qm(mhat,hi); KBLD(1);
  WAIT_BAR(0);
  DMA_K(3,0);DMA_V(1,SLOTB);
  ROT();
  kload8(kf,kp0+sl_cur);
  WAIT_BAR(2);
  s16x4 vlo[8],vhi[8]; u32x4 pw0,pw1,pw2,pw3;
  #define PKW(P,B) cvtpk_s(P[B],P[B+1])
  #define PAF(k) __builtin_bit_cast(bf16x8,pw##k)
  #define VFR(i) (bf16x8){vlo[i][0],vlo[i][1],vlo[i][2],vlo[i][3],vhi[i][0],vhi[i][1],vhi[i][2],vhi[i][3]}
  #define PIN(x) asm volatile("":"+v"(x))
  #define MX3(a,b,c) __builtin_fmaxf(__builtin_fmaxf((a),(b)),(c))
  #define GAPA(MF,A0,A1,A2,A3,W0,W1,PW) do{ MF; sacc+=A0; sacc+=A1; sacc+=A2; sacc+=A3; PIN(sacc); W0; W1; PIN(PW); SBAR(); }while(0)
  #define EX(v) __builtin_amdgcn_exp2f(v)
  #define GAPB(MF,X,B) do{ MF; X[B]=EX(X[B]); X[B+1]=EX(X[B+1]); X[B+2]=EX(X[B+2]); X[B+3]=EX(X[B+3]); PIN(X); SBAR(); }while(0)
  #define VRD(i) do{ vlo[i]=vtr(vp_+(((i)>>2)*4096+((i)&3)*1024)); vhi[i]=vtr(vp_+(((i)>>2)*4096+((i)&3)*1024+512)); }while(0)
  #define KRD(G,j) do{ if(G){ kload2(kf,kp0+sl_next,j); SBAR(); } }while(0)
  #define STEP(C0,C1,P0,P1,t,GK,GV,GL,GB) do{ SBAR(); \
    const lds_cptr vp_=vp0+sl_prev; \
    C0=__builtin_amdgcn_mfma_f32_32x32x16_bf16(kb0,qm,f32x16{},0,0,0); C1=__builtin_amdgcn_mfma_f32_32x32x16_bf16(kb1,qm,f32x16{},0,0,0); SBAR(); \
    VRD(0); SBAR(); float sacc=(P0[0]+P0[1]); \
    GAPA(C0=__builtin_amdgcn_mfma_f32_32x32x16_bf16(kf[0],qr[0],C0,0,0,0), P0[2],P0[3],P0[4],P0[5],     pw0[0]=PKW(P0,0), pw0[1]=PKW(P0,2), pw0); \
    VRD(4); SBAR(); GAPA(C1=__builtin_amdgcn_mfma_f32_32x32x16_bf16(kf[1],qr[0],C1,0,0,0), P0[6],P0[7],P0[8],P0[9],     pw0[2]=PKW(P0,4), pw0[3]=PKW(P0,6), pw0); \
    VRD(1); SBAR(); GAPA(C0=__builtin_amdgcn_mfma_f32_32x32x16_bf16(kf[2],qr[1],C0,0,0,0),   P0[10],P0[11],P0[12],P0[13], pw1[0]=PKW(P0,8), pw1[1]=PKW(P0,10), pw1); \
    VRD(5); SBAR(); GAPA(C1=__builtin_amdgcn_mfma_f32_32x32x16_bf16(kf[3],qr[1],C1,0,0,0),   P0[14],P0[15],P1[0],P1[1],   pw1[2]=PKW(P0,12),pw1[3]=PKW(P0,14), pw1); \
    VRD(2); SBAR(); GAPA(C0=__builtin_amdgcn_mfma_f32_32x32x16_bf16(kf[4],qr[2],C0,0,0,0),   P1[2],P1[3],P1[4],P1[5],     pw2[0]=PKW(P1,0), pw2[1]=PKW(P1,2), pw2); \
    VRD(6); SBAR(); GAPA(C1=__builtin_amdgcn_mfma_f32_32x32x16_bf16(kf[5],qr[2],C1,0,0,0),   P1[6],P1[7],P1[8],P1[9],     pw2[2]=PKW(P1,4), pw2[3]=PKW(P1,6), pw2); \
    VRD(3); SBAR(); GAPA(C0=__builtin_amdgcn_mfma_f32_32x32x16_bf16(kf[6],qr[3],C0,0,0,0),   P1[10],P1[11],P1[12],P1[13], pw3[0]=PKW(P1,8), pw3[1]=PKW(P1,10), pw3); \
    VRD(7); SBAR(); GAPA(C1=__builtin_amdgcn_mfma_f32_32x32x16_bf16(kf[7],qr[3],C1,0,0,0),   P1[14],P1[15],0.f,0.f,       pw3[2]=PKW(P1,12),pw3[3]=PKW(P1,14), pw3); \
    l_reg+=sacc; \
    if(GK){DMA_K((t)+3,sl_cur);} if(GV){DMA_V((t)+1,sl_next);} \
    BADD(C0,C1,t); CMASK(C0,C1,t); \
    { float a=MX3(C0[0],C0[1],C1[0]),b=MX3(C0[2],C0[3],C1[1]); a=MX3(a,C1[2],C1[3]); \
      _Pragma("unroll") for(int r=4;r<16;r+=4){a=MX3(a,C0[r],C0[r+1]);b=MX3(b,C0[r+2],C0[r+3]);a=MX3(a,C1[r],C1[r+1]);b=MX3(b,C1[r+2],C1[r+3]);} \
      float rm=__builtin_fmaxf(a,b); { auto rr=__builtin_amdgcn_permlane32_swap(__float_as_uint(rm),__float_as_uint(rm),false,false); rm=__builtin_fmaxf(__uint_as_float(rr[0]),__uint_as_float(rr[1])); } \
      resc=false; \
      if(__builtin_expect(__any(rm>(float)THRL),0)){ const float dl=__builtin_fmaxf(rm,0.f); mhat+=dl; \
        _Pragma("unroll") for(int r=0;r<16;++r){C0[r]-=dl;C1[r]-=dl;} \
        qm=mk_qm(mhat,hi); \
        const float f=__builtin_amdgcn_exp2f(-dl); l_reg*=f; if(hi==0)wsf[r32]=f; resc=true; } } \
    SBAR(); \
    GAPB(o[0]=__builtin_amdgcn_mfma_f32_32x32x16_bf16(PAF(0),VFR(0),o[0],0,0,0), C0,0); \
    GAPB(o[1]=__builtin_amdgcn_mfma_f32_32x32x16_bf16(PAF(0),VFR(4),o[1],0,0,0), C0,4); \
    if(GL){KBLD((t)+1);} KRD(GL,0); GAPB(o[0]=__builtin_amdgcn_mfma_f32_32x32x16_bf16(PAF(1),VFR(1),o[0],0,0,0), C0,8); \
    KRD(GL,1); GAPB(o[1]=__builtin_amdgcn_mfma_f32_32x32x16_bf16(PAF(1),VFR(5),o[1],0,0,0), C0,12); \
    KRD(GL,2); GAPB(o[0]=__builtin_amdgcn_mfma_f32_32x32x16_bf16(PAF(2),VFR(2),o[0],0,0,0), C1,0); \
    KRD(GL,3); GAPB(o[1]=__builtin_amdgcn_mfma_f32_32x32x16_bf16(PAF(2),VFR(6),o[1],0,0,0), C1,4); \
    GAPB(o[0]=__builtin_amdgcn_mfma_f32_32x32x16_bf16(PAF(3),VFR(3),o[0],0,0,0), C1,8); \
    GAPB(o[1]=__builtin_amdgcn_mfma_f32_32x32x16_bf16(PAF(3),VFR(7),o[1],0,0,0), C1,12); \
    }while(0)
  int t=1;
  #undef CMASK
  #define CMASK(P0,P1,t) do{}while(0)
  #define BADD(P0,P1,t) do{}while(0)
  for(;t+(MODE==1?7:5)<NT;t+=2){
    STEP(pB0,pB1,pA0,pA1,t,true,true,true,true);     WAIT_BAR(2); RESC(); ROT();
    STEP(pA0,pA1,pB0,pB1,t+1,true,true,true,true);   WAIT_BAR(2); RESC(); ROT();
  }
  #undef CMASK
  #undef BADD
  #define CMASK(P0,P1,t) do{int jb_=(t)-(NT-4); if(jb_>=0)cmask(P0,P1,jb_,qrel,hi);}while(0)
  #define BADD(P0,P1,t) do{ if(MODE==1&&(t)>=NT-6)bias_add(P0,P1,tb,t); }while(0)
  #define ENDW(tt) do{ if((tt)+3<NT){WAIT_BAR(2);} else if((tt)+2<NT){WAIT_BAR(1);} else {WAIT_BAR(0);} }while(0)
  for(;t+1<NT;t+=2){
    STEP(pB0,pB1,pA0,pA1,t,(t+3<NT),(t+1<NT),(t+1<NT),(t+1<NT));       ENDW(t);   RESC(); ROT();
    STEP(pA0,pA1,pB0,pB1,t+1,(t+4<NT),(t+2<NT),(t+2<NT),(t+2<NT));     ENDW(t+1); RESC(); ROT();
  }
  STEP(pB0,pB1,pA0,pA1,NT-1,false,false,false,false); RESC();
  { float sacc=pB0[0]+pB0[1]; _Pragma("unroll") for(int r=2;r<16;++r)sacc+=pB0[r]; _Pragma("unroll") for(int r=0;r<16;++r)sacc+=pB1[r]; l_reg+=sacc;
    pw0=(u32x4){PKW(pB0,0),PKW(pB0,2),PKW(pB0,4),PKW(pB0,6)};pw1=(u32x4){PKW(pB0,8),PKW(pB0,10),PKW(pB0,12),PKW(pB0,14)};pw2=(u32x4){PKW(pB1,0),PKW(pB1,2),PKW(pB1,4),PKW(pB1,6)};pw3=(u32x4){PKW(pB1,8),PKW(pB1,10),PKW(pB1,12),PKW(pB1,14)};
    SBAR(); pv(o,vb0+sl_cur,PAF(0),PAF(1),PAF(2),PAF(3)); }
  #undef PKW
  #undef PAF
  #undef VFR
  #undef PIN
  #undef MX3
  #undef GAPA
  #undef GAPB
  #undef EX
  #undef VRD
  #undef KRD
  #undef BADD
  #undef STEP
  #undef ENDW
  {auto rr=__builtin_amdgcn_permlane32_swap(__float_as_uint(l_reg),__float_as_uint(l_reg),false,false);l_reg=__uint_as_float(rr[0])+__uint_as_float(rr[1]);}
  if(hi==0)wsf[32+r32]=l_reg;asm volatile("s_waitcnt lgkmcnt(0)":::"memory");
  float rli[16];
  #pragma unroll
  for(int r=0;r<16;++r)rli[r]=__builtin_amdgcn_rcpf(wsf[32+crow(r,hi)]);
  bf16*Ow=O+(long)(q0+wid*QBLK)*PO;
  { bf16*stg=(bf16*)(shm+LDS_OST)+wid*2048;
    #pragma unroll
    for(int r=0;r<16;++r){const int orow=crow(r,hi);
      #pragma unroll
      for(int d0=0;d0<2;++d0)stg[orow*64+d0*32+r32]=(bf16)f2bf(o[d0][r]*rli[r]);}
    asm volatile("s_waitcnt lgkmcnt(0)":::"memory");
    unsigned char*Ow8=(unsigned char*)O+(long)(q0+wid*QBLK)*PO;
    (void)Ow;
    #pragma unroll
    for(int i=0;i<4;++i){const int row=i*8+(lane>>3),ch=lane&7; const u32x4 v=*(const u32x4*)(stg+row*64+ch*8);
      typedef unsigned u32x2o __attribute__((ext_vector_type(2))); u32x2o w8;
      #define F8LO(x) __builtin_bit_cast(float,(x)<<16)
      #define F8HI(x) __builtin_bit_cast(float,(x)&0xffff0000u)
      { int t_=__builtin_amdgcn_cvt_pk_fp8_f32(F8LO(v[0]),F8HI(v[0]),0,false); t_=__builtin_amdgcn_cvt_pk_fp8_f32(F8LO(v[1]),F8HI(v[1]),t_,true); w8[0]=(unsigned)t_; }
      { int t_=__builtin_amdgcn_cvt_pk_fp8_f32(F8LO(v[2]),F8HI(v[2]),0,false); t_=__builtin_amdgcn_cvt_pk_fp8_f32(F8LO(v[3]),F8HI(v[3]),t_,true); w8[1]=(unsigned)t_; }
      #undef F8LO
      #undef F8HI
      *(u32x2o*)(Ow8+(long)row*PO+ch*8)=w8;} }
  asm volatile("s_waitcnt lgkmcnt(0)\n\ts_barrier":::"memory");
  #undef DMA_K
  #undef DMA_V
  #undef CMASK
  #undef RESC
  #undef ROT
}
__device__ __forceinline__ void pv128(f32x16*o,int vb,bf16x8 pa0,bf16x8 pa1,bf16x8 pa2,bf16x8 pa3){
  #pragma unroll
  for(int d0=0;d0<4;++d0){s16x4 lo[4],hi[4];
    #pragma unroll
    for(int ks=0;ks<4;++ks){
      asm volatile("ds_read_b64_tr_b16 %0,%1 offset:%c2":"=&v"(lo[ks]):"v"(vb),"i"(d0*4096+ks*1024):"memory");
      asm volatile("ds_read_b64_tr_b16 %0,%1 offset:%c2":"=&v"(hi[ks]):"v"(vb),"i"(d0*4096+ks*1024+512):"memory");}
    asm volatile("s_waitcnt lgkmcnt(0)":::"memory");SBAR();
    #define PK(k) (bf16x8){lo[k][0],lo[k][1],lo[k][2],lo[k][3],hi[k][0],hi[k][1],hi[k][2],hi[k][3]}
    o[d0]=__builtin_amdgcn_mfma_f32_32x32x16_bf16(pa0,PK(0),o[d0],0,0,0);
    o[d0]=__builtin_amdgcn_mfma_f32_32x32x16_bf16(pa1,PK(1),o[d0],0,0,0);
    o[d0]=__builtin_amdgcn_mfma_f32_32x32x16_bf16(pa2,PK(2),o[d0],0,0,0);
    o[d0]=__builtin_amdgcn_mfma_f32_32x32x16_bf16(pa3,PK(3),o[d0],0,0,0);
    #undef PK
  }
}
constexpr int L8_K=0, L8_V=24576, L8_WS=73728, L8_TAB=75776, SLOTBV=16384;
template<int THRL,int STG_OFF> __device__ __forceinline__ void attn_unit128(int q0,const bf16*Q,const bf16*__restrict__ K,const bf16*__restrict__ V,char*shm){
  int tid=threadIdx.x; asm volatile("":"+v"(tid));
  const int lane=tid&63,r32=lane&31,hi=lane>>5; const int wid=__builtin_amdgcn_readfirstlane(tid>>6);
  const bf16*Qw=Q+(long)(q0+wid*QBLK)*PQ;
  const unsigned lds0=(unsigned)(uintptr_t)shm;
  float*wsf=(float*)(shm+L8_WS)+wid*64;
  const bf16*ksrc=K+(long)lane*PQ+wid*8;
  const bf16*vsrc=V+(long)(16*(wid&3)+(lane>>2))*PQ+(wid>>2)*32+(lane&3)*8;
  const unsigned kdst=lds0+L8_K+wid*1024, vdst=lds0+L8_V+wid*1024;
  #define DMA_K(t,slot) glds16(ksrc+(long)(t)*KVBLK*PQ,(unsigned)__builtin_amdgcn_readfirstlane(kdst+(slot)))
  #define DMA_V(t,slot) do{ glds16(vsrc+(long)(t)*KVBLK*PQ,(unsigned)__builtin_amdgcn_readfirstlane(vdst+2*(slot))); glds16(vsrc+64+(long)(t)*KVBLK*PQ,(unsigned)__builtin_amdgcn_readfirstlane(vdst+2*(slot)+8192)); }while(0)
  const int vb0=(int)(lds0+L8_V)+((lane>>4)&1)*32+(lane&3)*8+(4*hi+((lane&15)>>2))*64;
  bf16x8 kf[8];
  const lds_cptr shm3=(lds_cptr)shm; const lds_cptr kp0=shm3+L8_K+hi*1024+r32*16; const lds_cptr vp0=shm3+L8_V+((lane>>4)&1)*32+(lane&3)*8+(4*hi+((lane&15)>>2))*64;
  const int qrel=wid*QBLK+r32;
  const lds_fptr tb=(lds_fptr)(shm3+L8_TAB)+(2047-(q0+qrel))+4*hi;
  const lds_cptr kbp=hi?(shm3+L8_TAB-16*64*0):(shm3+L8_TAB+16*r32);
  const int kbs=hi?0:1024;
  bf16x8 kb0,kb1;
  { u32x4 w; w[0]=0u; w[1]=hi?0u:0x3F800000u; w[2]=hi?0u:0x3F803F80u; w[3]=0u; kb0=__builtin_bit_cast(bf16x8,w); kb1=kb0; }
  #define KBLD(t) do{ if(false){ kb0=*(const __attribute__((address_space(3))) bf16x8*)(kbp+(t)*kbs); kb1=*(const __attribute__((address_space(3))) bf16x8*)(kbp+(t)*kbs+(hi?0:512)); } }while(0)
  bf16x8 qm=mk_qm(0.f,hi);
  const int NT=(q0+QB)/KVBLK;
  DMA_K(0,0);DMA_V(0,0);DMA_K(1,SLOTB);
  bf16x8 qr[4];
  #pragma unroll
  for(int d0=0;d0<4;++d0)qr[d0]=*reinterpret_cast<const bf16x8*>(&Qw[(long)r32*PQ+d0*16+hi*8]);
  float mhat=0.f,l_reg=0.f;f32x16 o[4];o[0]=f32x16{};o[1]=f32x16{};o[2]=f32x16{};o[3]=f32x16{};
  #define CMASK(P0,P1,t) do{int jb_=(t)-(NT-4); if(jb_>=0)cmask(P0,P1,jb_,qrel,hi);}while(0)
  bool resc=false;
  #define RESC() do{ if(resc){ asm volatile("s_waitcnt lgkmcnt(0)":::"memory"); \
      _Pragma("unroll") for(int d_=0;d_<4;++d_) _Pragma("unroll") for(int r=0;r<16;++r)o[d_][r]*=wsf[crow(r,hi)]; } }while(0)
  f32x16 pA0,pA1,pB0,pB1;
  int sl_prev=0,sl_cur=0,sl_next=SLOTB;
  #define ROT() do{sl_prev=sl_cur;sl_cur=sl_next;sl_next=(sl_next==(NSLOT-1)*SLOTB)?0:sl_next+SLOTB;}while(0)
  DMA_K(2,2*SLOTB);
  KBLD(0);
  WAIT_BAR(4);
  { const lds_cptr kb=kp0; const f32x16 z16=f32x16{};
    pA0=__builtin_amdgcn_mfma_f32_32x32x16_bf16(kb0,qm,z16,0,0,0); pA1=__builtin_amdgcn_mfma_f32_32x32x16_bf16(kb0,qm,z16,0,0,0);
    #pragma unroll
    for(int d0=0;d0<4;++d0){ const bf16x8 b0=*(const __attribute__((address_space(3))) bf16x8*)(kb+d0*2048), b1=*(const __attribute__((address_space(3))) bf16x8*)(kb+d0*2048+512);
      pA0=__builtin_amdgcn_mfma_f32_32x32x16_bf16(b0,qr[d0],pA0,0,0,0); pA1=__builtin_amdgcn_mfma_f32_32x32x16_bf16(b1,qr[d0],pA1,0,0,0); } }
  if(NT<=6)bias_add(pA0,pA1,tb,0);
  CMASK(pA0,pA1,0);
  { float rm=fmaxf(pA0[0],pA1[0]);
    #pragma unroll
    for(int r=1;r<16;++r)rm=fmaxf(rm,fmaxf(pA0[r],pA1[r]));
    { auto rr=__builtin_amdgcn_permlane32_swap(__float_as_uint(rm),__float_as_uint(rm),false,false); rm=fmaxf(__uint_as_float(rr[0]),__uint_as_float(rr[1])); }
    mhat=rm;
    #pragma unroll
    for(int r=0;r<16;++r){pA0[r]=__builtin_amdgcn_exp2f(pA0[r]-rm);pA1[r]=__builtin_amdgcn_exp2f(pA1[r]-rm);} }
  qm=mk_qm(mhat,hi); KBLD(1);
  WAIT_BAR(0);
  DMA_K(3,0);DMA_V(1,SLOTB);
  ROT();
  kload8(kf,kp0+sl_cur);
  WAIT_BAR(3);
  s16x4 V0lo,V0hi,V1lo,V1hi,V2lo,V2hi; u32x4 pw0,pw1,pw2,pw3;
  #define PKW(P,B) cvtpk_s(P[B],P[B+1])
  #define PAF(k) __builtin_bit_cast(bf16x8,pw##k)
  #define PIN(x) asm volatile("":"+v"(x))
  #define MX3(a,b,c) __builtin_fmaxf(__builtin_fmaxf((a),(b)),(c))
  #define GAPA(MF,A0,A1,A2,A3,W0,W1,PW) do{ MF; sacc+=A0; sacc+=A1; sacc+=A2; sacc+=A3; PIN(sacc); W0; W1; PIN(PW); SBAR(); }while(0)
  #define EX(v) __builtin_amdgcn_exp2f(v)
  #define VRDX(S,f) do{ S##lo=vtr(vp_+(((f)>>2)*4096+((f)&3)*1024)); S##hi=vtr(vp_+(((f)>>2)*4096+((f)&3)*1024+512)); }while(0)
  #define VFX(S) (bf16x8){S##lo[0],S##lo[1],S##lo[2],S##lo[3],S##hi[0],S##hi[1],S##hi[2],S##hi[3]}
  #define GAPB(D,KS,SU,SL,FL,X,B) do{ o[D]=__builtin_amdgcn_mfma_f32_32x32x16_bf16(PAF(KS),VFX(SU),o[D],0,0,0); VRDX(SL,FL); X[B]=EX(X[B]); X[B+1]=EX(X[B+1]); PIN(X); SBAR(); }while(0)
  #define GAPBL(D,KS,SU,X,B) do{ o[D]=__builtin_amdgcn_mfma_f32_32x32x16_bf16(PAF(KS),VFX(SU),o[D],0,0,0); X[B]=EX(X[B]); X[B+1]=EX(X[B+1]); PIN(X); SBAR(); }while(0)
  #define KRD(G,j) do{ if(G){ kload2(kf,kp0+sl_next,j); SBAR(); } }while(0)
  #define STEP(C0,C1,P0,P1,t,GK,GV,GL,GB) do{ SBAR(); \
    const lds_cptr vp_=vp0+2*sl_prev; \
    C0=__builtin_amdgcn_mfma_f32_32x32x16_bf16(kb0,qm,f32x16{},0,0,0); C1=__builtin_amdgcn_mfma_f32_32x32x16_bf16(kb0,qm,f32x16{},0,0,0); SBAR(); \
    float sacc=(P0[0]+P0[1]); \
    GAPA(C0=__builtin_amdgcn_mfma_f32_32x32x16_bf16(kf[0],qr[0],C0,0,0,0), P0[2],P0[3],P0[4],P0[5],     pw0[0]=PKW(P0,0), pw0[1]=PKW(P0,2), pw0); \
    GAPA(C1=__builtin_amdgcn_mfma_f32_32x32x16_bf16(kf[1],qr[0],C1,0,0,0), P0[6],P0[7],P0[8],P0[9],     pw0[2]=PKW(P0,4), pw0[3]=PKW(P0,6), pw0); \
    KRD(GL,0); GAPA(C0=__builtin_amdgcn_mfma_f32_32x32x16_bf16(kf[2],qr[1],C0,0,0,0),   P0[10],P0[11],P0[12],P0[13], pw1[0]=PKW(P0,8), pw1[1]=PKW(P0,10), pw1); \
    GAPA(C1=__builtin_amdgcn_mfma_f32_32x32x16_bf16(kf[3],qr[1],C1,0,0,0),   P0[14],P0[15],P1[0],P1[1],   pw1[2]=PKW(P0,12),pw1[3]=PKW(P0,14), pw1); \
    KRD(GL,1); GAPA(C0=__builtin_amdgcn_mfma_f32_32x32x16_bf16(kf[4],qr[2],C0,0,0,0),   P1[2],P1[3],P1[4],P1[5],     pw2[0]=PKW(P1,0), pw2[1]=PKW(P1,2), pw2); \
    GAPA(C1=__builtin_amdgcn_mfma_f32_32x32x16_bf16(kf[5],qr[2],C1,0,0,0),   P1[6],P1[7],P1[8],P1[9],     pw2[2]=PKW(P1,4), pw2[3]=PKW(P1,6), pw2); \
    KRD(GL,2); GAPA(C0=__builtin_amdgcn_mfma_f32_32x32x16_bf16(kf[6],qr[3],C0,0,0,0),   P1[10],P1[11],P1[12],P1[13], pw3[0]=PKW(P1,8), pw3[1]=PKW(P1,10), pw3); \
    GAPA(C1=__builtin_amdgcn_mfma_f32_32x32x16_bf16(kf[7],qr[3],C1,0,0,0),   P1[14],P1[15],0.f,0.f,       pw3[2]=PKW(P1,12),pw3[3]=PKW(P1,14), pw3); \
    KRD(GL,3); VRDX(V0,0); VRDX(V1,4); SBAR(); \
    l_reg+=sacc; \
    if(GK){DMA_K((t)+3,sl_cur);} if(GV){DMA_V((t)+1,sl_next);} \
    BADD(C0,C1,t); CMASK(C0,C1,t); \
    { float a=MX3(C0[0],C0[1],C1[0]),b=MX3(C0[2],C0[3],C1[1]); a=MX3(a,C1[2],C1[3]); \
      _Pragma("unroll") for(int r=4;r<16;r+=4){a=MX3(a,C0[r],C0[r+1]);b=MX3(b,C0[r+2],C0[r+3]);a=MX3(a,C1[r],C1[r+1]);b=MX3(b,C1[r+2],C1[r+3]);} \
      float rm=__builtin_fmaxf(a,b); { auto rr=__builtin_amdgcn_permlane32_swap(__float_as_uint(rm),__float_as_uint(rm),false,false); rm=__builtin_fmaxf(__uint_as_float(rr[0]),__uint_as_float(rr[1])); } \
      resc=false; \
      if(__builtin_expect(__any(rm>(float)THRL),0)){ const float dl=__builtin_fmaxf(rm,0.f); mhat+=dl; \
        _Pragma("unroll") for(int r=0;r<16;++r){C0[r]-=dl;C1[r]-=dl;} \
        qm=mk_qm(mhat,hi); \
        const float f=__builtin_amdgcn_exp2f(-dl); l_reg*=f; if(hi==0)wsf[r32]=f; resc=true; } } \
    SBAR(); \
    GAPB(0,0,V0,V2,8, C0,0);  GAPB(1,0,V1,V0,12,C0,2);  GAPB(2,0,V2,V1,1, C0,4);  GAPB(3,0,V0,V2,5, C0,6); \
    GAPB(0,1,V1,V0,9, C0,8);  GAPB(1,1,V2,V1,13,C0,10); GAPB(2,1,V0,V2,2, C0,12); GAPB(3,1,V1,V0,6, C0,14); \
    GAPB(0,2,V2,V1,10,C1,0);  GAPB(1,2,V0,V2,14,C1,2);  GAPB(2,2,V1,V0,3, C1,4);  GAPB(3,2,V2,V1,7, C1,6); \
    GAPB(0,3,V0,V2,11,C1,8);  GAPB(1,3,V1,V0,15,C1,10); GAPBL(2,3,V2,C1,12);      GAPBL(3,3,V0,C1,14); \
    }while(0)
  int t=1;
  #undef CMASK
  #define CMASK(P0,P1,t) do{}while(0)
  #define BADD(P0,P1,t) do{}while(0)
  for(;t+(7)<NT;t+=2){
    STEP(pB0,pB1,pA0,pA1,t,true,true,true,true);     WAIT_BAR(3); RESC(); ROT();
    STEP(pA0,pA1,pB0,pB1,t+1,true,true,true,true);   WAIT_BAR(3); RESC(); ROT();
  }
  #undef CMASK
  #undef BADD
  #define CMASK(P0,P1,t) do{int jb_=(t)-(NT-4); if(jb_>=0)cmask(P0,P1,jb_,qrel,hi);}while(0)
  #define BADD(P0,P1,t) do{ if((t)>=NT-6)bias_add(P0,P1,tb,t); }while(0)
  #define ENDW(tt) do{ if((tt)+3<NT){WAIT_BAR(3);} else if((tt)+2<NT){WAIT_BAR(2);} else {WAIT_BAR(0);} }while(0)
  for(;t+1<NT;t+=2){
    STEP(pB0,pB1,pA0,pA1,t,(t+3<NT),(t+1<NT),(t+1<NT),(t+1<NT));       ENDW(t);   RESC(); ROT();
    STEP(pA0,pA1,pB0,pB1,t+1,(t+4<NT),(t+2<NT),(t+2<NT),(t+2<NT));     ENDW(t+1); RESC(); ROT();
  }
  STEP(pB0,pB1,pA0,pA1,NT-1,false,false,false,false); RESC();
  { float sacc=pB0[0]+pB0[1]; _Pragma("unroll") for(int r=2;r<16;++r)sacc+=pB0[r]; _Pragma("unroll") for(int r=0;r<16;++r)sacc+=pB1[r]; l_reg+=sacc;
    pw0=(u32x4){PKW(pB0,0),PKW(pB0,2),PKW(pB0,4),PKW(pB0,6)};pw1=(u32x4){PKW(pB0,8),PKW(pB0,10),PKW(pB0,12),PKW(pB0,14)};pw2=(u32x4){PKW(pB1,0),PKW(pB1,2),PKW(pB1,4),PKW(pB1,6)};pw3=(u32x4){PKW(pB1,8),PKW(pB1,10),PKW(pB1,12),PKW(pB1,14)};
    SBAR(); pv128(o,vb0+2*sl_cur,PAF(0),PAF(1),PAF(2),PAF(3)); }
  #undef PKW
  #undef PAF
  #undef VFX
  #undef VRDX
  #undef GAPBL
  #undef PIN
  #undef MX3
  #undef GAPA
  #undef GAPB
  #undef EX
  #undef KRD
  #undef BADD
  #undef STEP
  #undef ENDW
  {auto rr=__builtin_amdgcn_permlane32_swap(__float_as_uint(l_reg),__float_as_uint(l_reg),false,false);l_reg=__uint_as_float(rr[0])+__uint_as_float(rr[1]);}
  if(hi==0)wsf[32+r32]=l_reg;asm volatile("s_waitcnt lgkmcnt(0)":::"memory");
  float rli[16];
  #pragma unroll
  for(int r=0;r<16;++r)rli[r]=__builtin_amdgcn_rcpf(wsf[32+crow(r,hi)]);
  asm volatile("s_waitcnt lgkmcnt(0)\n\ts_barrier":::"memory");
  { bf16*stg=(bf16*)(shm+STG_OFF)+wid*4096;
    #pragma unroll
    for(int r=0;r<16;++r){const int orow=crow(r,hi);
      #pragma unroll
      for(int d0=0;d0<4;++d0)stg[orow*128+d0*32+r32]=(bf16)f2bf(o[d0][r]*rli[r]);} }
  asm volatile("s_waitcnt lgkmcnt(0)\n\ts_barrier":::"memory");
  #undef DMA_K
  #undef DMA_V
  #undef CMASK
  #undef RESC
  #undef ROT
}
#undef SBAR
#undef WAIT_BAR
}

typedef float f32x16 __attribute__((ext_vector_type(16)));
typedef short s16x4 __attribute__((ext_vector_type(4)));
typedef unsigned u32x2v __attribute__((ext_vector_type(2)));
typedef float f32x2t __attribute__((ext_vector_type(2)));
struct Args { const float* in[26]; float* out; unsigned char* ws; int ph_lo, ph_hi; };
#define KARG ((const __attribute__((address_space(4))) Args*)__builtin_amdgcn_kernarg_segment_ptr())
#define FRESH(F) do { int t_ = threadIdx.x; asm volatile("" : "+v"(t_)); (F).tid = t_; (F).lane = t_ & 63; (F).wave = __builtin_amdgcn_readfirstlane(t_ >> 6); } while (0)
struct Frame {
    LAS unsigned char* lds;
    volatile LAS unsigned* MISC;
    gu32* ctl;
    int tid, lane, wave;
    int vcu, G;
    unsigned char* ws;
    float* out;
};
__device__ __forceinline__ float wave_sum(float v) {
#pragma unroll
    for (int o = 1; o < 64; o <<= 1) v += __shfl_xor(v, o);
    return v;
}
__device__ __forceinline__ float bf2f(unsigned short b) { return __builtin_bit_cast(float, (unsigned)b << 16); }
__device__ __forceinline__ float bflo(unsigned w) { return __builtin_bit_cast(float, w << 16); }
__device__ __forceinline__ float bfhi(unsigned w) { return __builtin_bit_cast(float, w & 0xffff0000u); }
__device__ __forceinline__ int crow(int r, int hi) { return (r & 3) + 8 * (r >> 2) + 4 * hi; }
__device__ __forceinline__ unsigned pk4_fp8_nc(float a, float b, float c, float d) { int w = __builtin_amdgcn_cvt_pk_fp8_f32(a, b, 0, false); w = __builtin_amdgcn_cvt_pk_fp8_f32(c, d, w, true); return (unsigned)w; }
__device__ __forceinline__ unsigned pk4_fp8(float a, float b, float c, float d) {
    a = __builtin_amdgcn_fmed3f(a, -448.f, 448.f); b = __builtin_amdgcn_fmed3f(b, -448.f, 448.f); c = __builtin_amdgcn_fmed3f(c, -448.f, 448.f); d = __builtin_amdgcn_fmed3f(d, -448.f, 448.f);
    int w = __builtin_amdgcn_cvt_pk_fp8_f32(a, b, 0, false); w = __builtin_amdgcn_cvt_pk_fp8_f32(c, d, w, true); return (unsigned)w; }

constexpr int NPPU = (NTOK / 256) * (D / 256);
struct SchedC {
    static constexpr bool GATHER = false;
    int nM, nN, G, c, K; const char* Bt;
    __device__ __forceinline__ size_t aoff_uniform(const pg8::Unit& u) const { return (size_t)u.pm * 256 * K * 2; }
    __device__ __forceinline__ bool next(int i, pg8::Unit& u) const { u.e = 0; u.lr0 = 0; u.ui = i; return pg8::order_tile((long)i * G + c, nM, nN, u.pm, u.pn); }
    __device__ __forceinline__ const char* bptr(const pg8::Unit& u) const { return Bt + (size_t)u.pn * 256 * K * 2; }
    __device__ __forceinline__ void aoffs(const pg8::Unit& u, const int (&aR)[2], const int (&aC)[2], unsigned (&ao)[2][2]) const {
#pragma unroll
        for (int h = 0; h < 2; ++h)
#pragma unroll
            for (int i = 0; i < 2; ++i) ao[h][i] = (unsigned)((u.pm * 256 + h * 128 + aR[i]) * K + aC[i]) * 2u; }
};
__device__ __forceinline__ LAS unsigned short* lds_tileE(LAS unsigned char* lds) { return (LAS unsigned short*)(lds + TILEE_OFF); }
__device__ __forceinline__ LAS int* lds_tstart(LAS unsigned char* lds) { return (LAS int*)(lds + TILEE_OFF + 1152); }
__device__ __forceinline__ LAS int* lds_cnt(LAS unsigned char* lds) { return (LAS int*)(lds + TILEE_OFF + 1152 + 144); }
template <bool GATHER_, int NN, int NROWS_B  , int KU  >
struct SchedM {
    static constexpr bool GATHER = GATHER_;
    __device__ __forceinline__ size_t aoff_uniform(const pg8::Unit& u) const { return (size_t)u.pm * 256 * KU * 2; }
    int G, c; const char* Bt; LAS unsigned char* lds; int ntile;
    __device__ __forceinline__ bool next(int i, pg8::Unit& u) const {
        if (GATHER && i >= 18) return false;
        if (!pg8::order_tile((long)i * G + c, ntile, NN, u.pm, u.pn)) return false;
        u.e = __builtin_amdgcn_readfirstlane((int)lds_tileE(lds)[u.pm]); u.lr0 = (u.pm - __builtin_amdgcn_readfirstlane(lds_tstart(lds)[u.e])) * 256; u.ui = i; return true; }
    __device__ __forceinline__ const char* bptr(const pg8::Unit& u) const { return Bt + ((size_t)u.e * NROWS_B + (size_t)u.pn * 256) * KU * 2; }
    __device__ __forceinline__ void aoffs(const pg8::Unit& u, const int (&aR)[2], const int (&aC)[2], unsigned (&ao)[2][2]) const {
        const LAS int* tk = (const LAS int*)(lds + TOKL_OFF) + u.ui * 256;
#pragma unroll
        for (int h = 0; h < 2; ++h)
#pragma unroll
            for (int i = 0; i < 2; ++i) {
                if (GATHER) ao[h][i] = (unsigned)(tk[h * 128 + aR[i]] * KU + aC[i]) * 2u;
                else ao[h][i] = (unsigned)((u.pm * 256 + h * 128 + aR[i]) * KU + aC[i]) * 2u; }
    }
};

using pg8::Unit; using pg8::cvt_pk_bf16; using pg8::HALF; using pg8::BM;
struct EpiBf16P {
    static constexpr bool PERM = true, PREFETCH = false;
    unsigned char* O; int ldc;
    __device__ __forceinline__ void operator()(const f32x4 (&acc)[2][2][4][2], const Unit& u, int wr, int wc, int fr, int fq) const {
        const int row0 = u.pm * BM + wr * 64 + fr, col0 = u.pn * BM + wc * 32 + 8 * fq;
#pragma unroll
        for (int ai = 0; ai < 2; ++ai)
#pragma unroll
            for (int m = 0; m < 4; ++m) { unsigned char* rowp = O + (size_t)(row0 + ai * HALF + m * 16) * ldc + col0;
#pragma unroll
                for (int bj = 0; bj < 2; ++bj) { const f32x4 v0 = acc[ai][bj][m][0], v1 = acc[ai][bj][m][1];
                    u32x2v w; w.x = pk4_fp8(v0[0], v0[1], v0[2], v0[3]); w.y = pk4_fp8(v1[0], v1[1], v1[2], v1[3]);
                    *(u32x2v*)(rowp + bj * HALF) = w; }
                __builtin_amdgcn_sched_barrier(0); }
    }
};
struct EpiProj {
    static constexpr bool PERM = true, PREFETCH = false;
    bf16* O; const float *gqf, *gkf, *gqd, *gkd;
    __device__ __forceinline__ void operator()(const f32x4 (&acc)[2][2][4][2], const Unit& u, int wr, int wc, int fr, int fq) const {
        const int seg = u.pn >> 1;
        const float* g = seg == 0 ? gqf : seg == 1 ? gkf : seg == 3 ? gqd : seg == 4 ? gkd : nullptr;
        const float sc = (seg == 0 || seg == 3) ? C2 : 1.0f;
        f32x4 gv[2][2];
#pragma unroll
        for (int bj = 0; bj < 2; ++bj)
#pragma unroll
            for (int n = 0; n < 2; ++n) gv[bj][n] = g ? *(const f32x4*)(g + 32 * bj + 8 * fq + 4 * n) : (f32x4){1.f, 1.f, 1.f, 1.f};
        const int row0 = u.pm * BM + wr * 64 + fr, col0 = u.pn * BM + 64 * wc + 8 * fq;
#pragma unroll
        for (int ai = 0; ai < 2; ++ai)
#pragma unroll
            for (int m = 0; m < 4; ++m) {
                float r = 1.0f;
                if (g) { float ss = 0.f;
#pragma unroll
                    for (int bj = 0; bj < 2; ++bj)
#pragma unroll
                        for (int n = 0; n < 2; ++n) { const f32x4 x = acc[ai][bj][m][n]; ss += (x[0] * x[0] + x[1] * x[1]) + (x[2] * x[2] + x[3] * x[3]); }
                    ss += __shfl_xor(ss, 16); ss += __shfl_xor(ss, 32);
                    r = __builtin_amdgcn_rsqf(ss * (1.0f / 64.0f) + EPS) * sc; }
                bf16* rowp = O + (size_t)(row0 + ai * HALF + m * 16) * NPROJ + col0;
#pragma unroll
                for (int bj = 0; bj < 2; ++bj) { const f32x4 v0 = acc[ai][bj][m][0] * gv[bj][0] * r, v1 = acc[ai][bj][m][1] * gv[bj][1] * r;
                    v4u w; w.x = cvt_pk_bf16(v0[0], v0[1]); w.y = cvt_pk_bf16(v0[2], v0[3]); w.z = cvt_pk_bf16(v1[0], v1[1]); w.w = cvt_pk_bf16(v1[2], v1[3]);
                    *(v4u*)(rowp + 32 * bj) = w; }
                __builtin_amdgcn_sched_barrier(0); }
    }
};
struct EpiRes {
    static constexpr bool PERM = true, PREFETCH = false;
    const float* base; bf16* out;
    __device__ __forceinline__ void operator()(const f32x4 (&acc)[2][2][4][2], const Unit& u, int wr, int wc, int fr, int fq) const {
        const int row0 = u.pm * BM + wr * 64 + fr, col0 = u.pn * BM + wc * 32 + 8 * fq;
#pragma unroll
        for (int ai = 0; ai < 2; ++ai) {
            f32x4 xv[4][2][2];
#pragma unroll
            for (int m = 0; m < 4; ++m) { const size_t off = (size_t)(row0 + ai * HALF + m * 16) * D + col0;
#pragma unroll
                for (int bj = 0; bj < 2; ++bj) { xv[m][bj][0] = *(const f32x4*)(base + off + bj * HALF); xv[m][bj][1] = *(const f32x4*)(base + off + bj * HALF + 4); } }
#pragma unroll
            for (int m = 0; m < 4; ++m) { const size_t off = (size_t)(row0 + ai * HALF + m * 16) * D + col0;
#pragma unroll
                for (int bj = 0; bj < 2; ++bj) { const f32x4 v0 = xv[m][bj][0] + acc[ai][bj][m][0], v1 = xv[m][bj][1] + acc[ai][bj][m][1];
                    v4u w; w.x = cvt_pk_bf16(v0[0], v0[1]); w.y = cvt_pk_bf16(v0[2], v0[3]); w.z = cvt_pk_bf16(v1[0], v1[1]); w.w = cvt_pk_bf16(v1[2], v1[3]);
                    *(v4u*)(out + off + bj * HALF) = w; } }
            __builtin_amdgcn_sched_barrier(0); }
    }
};
struct EpiSwiglu {
    static constexpr bool PERM = true, PREFETCH = true;
    unsigned char* HB; const float* b1p; const float* rsE; LAS unsigned char* lds;
    __device__ __forceinline__ void prefetch(const Unit& u, LAS unsigned char* buf, int wid, int lane) const {
        if (wid == 0) __builtin_amdgcn_global_load_lds((const unsigned*)(b1p + (size_t)u.e * 2048 + u.pn * 256 + 4 * lane), (LAS unsigned*)buf, 16, 0, 0);
        else if (wid == 1) __builtin_amdgcn_global_load_lds((const unsigned*)(rsE + (size_t)u.e * ECAP + u.lr0 + 4 * lane), (LAS unsigned*)(buf + 1024), 16, 0, 0);
    }
    __device__ __forceinline__ void operator()(const f32x4 (&acc)[2][2][4][2], const Unit& u, int wr, int wc, int fr, int fq, LAS unsigned char* buf) const {
        const int cnt = __builtin_amdgcn_readfirstlane(lds_cnt(lds)[u.e]);
        const LAS float* bp = (const LAS float*)buf + wc * 32 + 8 * fq; const LAS float* rp = (const LAS float*)(buf + 1024);
        f32x4 bv[2][2];
#pragma unroll
        for (int bj = 0; bj < 2; ++bj)
#pragma unroll
            for (int n = 0; n < 2; ++n) bv[bj][n] = *(const LAS f32x4*)(bp + bj * HALF + 4 * n);
        const int col0 = u.pn * 128 + wc * 32 + 8 * fq;
#pragma unroll
        for (int ai = 0; ai < 2; ++ai)
#pragma unroll
            for (int m = 0; m < 4; ++m) { const int lrow = ai * HALF + wr * 64 + m * 16 + fr; const int lr = u.lr0 + lrow;
                const float rsv = rp[lrow]; const float rs = lr < cnt ? rsv : 0.f;
                float o[8]; const f32x2t rs2 = {rs, rs};
#pragma unroll
                for (int n = 0; n < 2; ++n)
#pragma unroll
                    for (int i = 0; i < 4; i += 2) {
                        f32x2t gl = (f32x2t){acc[ai][0][m][n][i], acc[ai][0][m][n][i + 1]} * rs2 + (f32x2t){bv[0][n][i], bv[0][n][i + 1]};
                        f32x2t li = (f32x2t){acc[ai][1][m][n][i], acc[ai][1][m][n][i + 1]} * rs2 + (f32x2t){bv[1][n][i], bv[1][n][i + 1]};
                        gl[0] = fminf(gl[0], 7.0f); gl[1] = fminf(gl[1], 7.0f); li[0] = __builtin_amdgcn_fmed3f(li[0], -6.0f, 8.0f); li[1] = __builtin_amdgcn_fmed3f(li[1], -6.0f, 8.0f);
                        const f32x2t t = gl * (-1.702f * LOG2E); f32x2t e; e[0] = __builtin_amdgcn_exp2f(t[0]); e[1] = __builtin_amdgcn_exp2f(t[1]);
                        const f32x2t d = e + 1.0f; f32x2t sg; sg[0] = __builtin_amdgcn_rcpf(d[0]); sg[1] = __builtin_amdgcn_rcpf(d[1]);
                        const f32x2t r = (gl * sg) * li; o[4 * n + i] = r[0]; o[4 * n + i + 1] = r[1]; }
                u32x2v w; w.x = pk4_fp8_nc(o[0], o[1], o[2], o[3]); w.y = pk4_fp8_nc(o[4], o[5], o[6], o[7]);
                *(u32x2v*)(HB + (size_t)(u.pm * 256 + lrow) * FF + col0) = w; }
    }
};
struct EpiY {
    static constexpr bool PERM = true, PREFETCH = true;
    unsigned char* Y; const float* b2; const float* gateE; LAS unsigned char* lds;
    __device__ __forceinline__ void prefetch(const Unit& u, LAS unsigned char* buf, int wid, int lane) const {
        if (wid == 0) __builtin_amdgcn_global_load_lds((const unsigned*)(b2 + (size_t)u.e * D + u.pn * 256 + 4 * lane), (LAS unsigned*)buf, 16, 0, 0);
        else if (wid == 1) __builtin_amdgcn_global_load_lds((const unsigned*)(gateE + (size_t)u.e * ECAP + u.lr0 + 4 * lane), (LAS unsigned*)(buf + 1024), 16, 0, 0);
    }
    __device__ __forceinline__ void operator()(const f32x4 (&acc)[2][2][4][2], const Unit& u, int wr, int wc, int fr, int fq, LAS unsigned char* buf) const {
        const int cnt = __builtin_amdgcn_readfirstlane(lds_cnt(lds)[u.e]);
        const int colt = wc * 64 + 16 * fq, col0 = u.pn * 256 + colt;
        const LAS float* bp = (const LAS float*)buf + colt; const LAS float* gp = (const LAS float*)(buf + 1024);
        f32x4 bv[2][2];
#pragma unroll
        for (int bj = 0; bj < 2; ++bj)
#pragma unroll
            for (int n = 0; n < 2; ++n) bv[bj][n] = *(const LAS f32x4*)(bp + 8 * bj + 4 * n);
#pragma unroll
        for (int ai = 0; ai < 2; ++ai)
#pragma unroll
            for (int m = 0; m < 4; ++m) { const int lrow = ai * HALF + wr * 64 + m * 16 + fr; const int lr = u.lr0 + lrow;
                const float gv_ = gp[lrow]; const float gt = lr < cnt ? gv_ * 16.0f : 0.f;
                v4u w;
                { const f32x4 v0 = (acc[ai][0][m][0] + bv[0][0]) * gt, v1 = (acc[ai][0][m][1] + bv[0][1]) * gt; w.x = pk4_fp8(v0[0], v0[1], v0[2], v0[3]); w.y = pk4_fp8(v1[0], v1[1], v1[2], v1[3]); }
                { const f32x4 v0 = (acc[ai][1][m][0] + bv[1][0]) * gt, v1 = (acc[ai][1][m][1] + bv[1][1]) * gt; w.z = pk4_fp8(v0[0], v0[1], v0[2], v0[3]); w.w = pk4_fp8(v1[0], v1[1], v1[2], v1[3]); }
                *(v4u*)(Y + (size_t)(u.pm * 256 + lrow) * D + col0) = w;
                __builtin_amdgcn_sched_barrier(0); }
    }
};
struct EpiFinal {
    static constexpr bool PERM = true, PREFETCH = false;
    float* out; const bf16* H2; const unsigned char* PP; const float* rs3;
    __device__ __forceinline__ void operator()(const f32x4 (&acc)[2][2][4][2], const Unit& u, int wr, int wc, int fr, int fq) const {
        const int row0 = u.pm * BM + wr * 64 + fr, col0 = u.pn * BM + wc * 32 + 8 * fq;
#pragma unroll
        for (int ai = 0; ai < 2; ++ai) {
            v4u hw[4][2]; u32x2v pw[4][2]; float rs[4];
#pragma unroll
            for (int m = 0; m < 4; ++m) { const int row = row0 + ai * HALF + m * 16; const size_t off = (size_t)row * D + col0; rs[m] = rs3[row];
#pragma unroll
                for (int bj = 0; bj < 2; ++bj) { hw[m][bj] = *(const v4u*)(H2 + off + bj * HALF); pw[m][bj] = *(const u32x2v*)(PP + off + bj * HALF); } }
#pragma unroll
            for (int m = 0; m < 4; ++m) { const int row = row0 + ai * HALF + m * 16; const size_t off = (size_t)row * D + col0;
#pragma unroll
                for (int bj = 0; bj < 2; ++bj) { const v4u h_ = hw[m][bj]; const u32x2v p_ = pw[m][bj];
                    const float hv[8] = {bflo(h_.x), bfhi(h_.x), bflo(h_.y), bfhi(h_.y), bflo(h_.z), bfhi(h_.z), bflo(h_.w), bfhi(h_.w)};
                    const f32x2t p0 = __builtin_amdgcn_cvt_pk_f32_fp8((int)p_.x, false), p1 = __builtin_amdgcn_cvt_pk_f32_fp8((int)p_.x, true), p2 = __builtin_amdgcn_cvt_pk_f32_fp8((int)p_.y, false), p3 = __builtin_amdgcn_cvt_pk_f32_fp8((int)p_.y, true);
                    const float pv[8] = {p0[0], p0[1], p1[0], p1[1], p2[0], p2[1], p3[0], p3[1]};
#pragma unroll
                    for (int n = 0; n < 2; ++n) { const f32x4 a = acc[ai][bj][m][n] * rs[m]; f32x4 o;
#pragma unroll
                        for (int i = 0; i < 4; ++i) o[i] = hv[4 * n + i] + __builtin_amdgcn_rcpf(1.0f + __builtin_amdgcn_exp2f(-LOG2E * a[i])) * pv[4 * n + i];
                        *(f32x4*)(out + off + bj * HALF + 4 * n) = o; } } }
            __builtin_amdgcn_sched_barrier(0); }
    }
};

__device__ __forceinline__ int dest_row(int mode, int nn) {
    if (mode == 1) { const int c = nn & 255; return (nn & ~255) + 128 * ((c >> 5) & 1) + 32 * (c >> 6) + (c & 31); }
    if (mode == 2) { const int o = nn >> 1; return 256 * (o >> 7) + (o & 127) + 128 * (nn & 1); }
    if (mode == 3) { const int c = nn & 255; return (nn & ~255) + 128 * ((c >> 3) & 1) + 32 * (c >> 6) + 8 * ((c >> 4) & 3) + (c & 7); }
    return nn;
}
__device__ __forceinline__ void tr_item(const float* W, int ldw, int k0, int n0src, int n0, int mode, bf16* WT, int Kdim, LAS float* scr, int lane) {
    float v[32];
#pragma unroll
    for (int i = 0; i < 32; ++i) { const int kk = 2 * i + (lane >> 5); v[i] = W[(size_t)(k0 + kk) * ldw + n0src + (lane & 31)]; }
#pragma unroll
    for (int i = 0; i < 32; ++i) { const int kk = 2 * i + (lane >> 5); scr[kk * 33 + (lane & 31)] = v[i]; }
    LDS_WAIT(); asm volatile("" ::: "memory");
    const int c = lane & 7;
#pragma unroll
    for (int j = 0; j < 4; ++j) { const int n = (lane >> 3) + 8 * j; const LAS float* s = scr + (8 * c) * 33 + n;
        v4u o; o.x = pk2(s[0 * 33], s[1 * 33]); o.y = pk2(s[2 * 33], s[3 * 33]); o.z = pk2(s[4 * 33], s[5 * 33]); o.w = pk2(s[6 * 33], s[7 * 33]);
        *(GAS v4u*)(WT + (size_t)dest_row(mode, n0 + n) * Kdim + k0 + 8 * c) = o; }
    LDS_WAIT(); asm volatile("" ::: "memory");
}
__device__ __forceinline__ void tr_item_f8(const float* W, int ldw, int k0, int n0src, int n0, int mode, unsigned char* WT, int Kdim, LAS float* scr, int lane) {
    float v[32];
#pragma unroll
    for (int i = 0; i < 32; ++i) { const int kk = 2 * i + (lane >> 5); v[i] = W[(size_t)(k0 + kk) * ldw + n0src + (lane & 31)]; }
#pragma unroll
    for (int i = 0; i < 32; ++i) { const int kk = 2 * i + (lane >> 5); scr[kk * 33 + (lane & 31)] = v[i] * 32.0f; }
    LDS_WAIT(); asm volatile("" ::: "memory");
    const int c = lane & 3;
#pragma unroll
    for (int j = 0; j < 2; ++j) { const int n = (lane >> 2) + 16 * j; const LAS float* s = scr + (16 * c) * 33 + n;
        v4u o; o.x = pk4_fp8(s[0 * 33], s[1 * 33], s[2 * 33], s[3 * 33]); o.y = pk4_fp8(s[4 * 33], s[5 * 33], s[6 * 33], s[7 * 33]);
        o.z = pk4_fp8(s[8 * 33], s[9 * 33], s[10 * 33], s[11 * 33]); o.w = pk4_fp8(s[12 * 33], s[13 * 33], s[14 * 33], s[15 * 33]);
        *(GAS v4u*)(WT + (size_t)dest_row(mode, n0 + n) * Kdim + k0 + 16 * c) = o; }
    LDS_WAIT(); asm volatile("" ::: "memory");
}
__device__ __forceinline__ float log_sigmoid(float z) { return fminf(z, 0.f) - log1pf(expf(-fabsf(z))); }

__device__ __forceinline__ void p0_prologue(Frame& F) {
    const float* x = KARG->in[0]; const float* p = KARG->in[1]; const float* g_attn = KARG->in[3]; const float* w_in = KARG->in[4]; const float* b_f = KARG->in[5];
    const float* w_out = KARG->in[15]; const float* g_mlp = KARG->in[16]; const float* w_router = KARG->in[17]; const float* w1 = KARG->in[19]; const float* b1 = KARG->in[20];
    const float* w2 = KARG->in[21]; const float* w_pg = KARG->in[24]; const float* w_pp = KARG->in[25];
    unsigned char* ws = F.ws;
    const int gw = F.vcu * NWAVES + F.wave, NGW = F.G * NWAVES;
    const int gt = F.vcu * (NWAVES * 64) + F.tid, NGT = F.G * NWAVES * 64;
    { LAS float* wf = (LAS float*)(F.lds + RING_OFF);
      for (int i = F.tid; i < 8192; i += NWAVES * 64) { const int k = i >> 3, h = i & 7; wf[(((((k >> 8) * 4 + (k & 3)) * 2 + (h >> 2)) * 64 + ((k & 255) >> 2)) * 4) + (h & 3)] = g_attn[k] * w_in[(size_t)k * INW + 1536 + h]; }
      __syncthreads();
      f32x4 gv[4];
#pragma unroll
      for (int j = 0; j < 4; ++j) gv[j] = *(const f32x4*)(g_attn + 256 * j + 4 * F.lane);
      bf16* A0 = (bf16*)(ws + WS_A0); float* LF = (float*)(ws + WS_LF);
      for (int m = gw; m < NTOK; m += NGW) {
          const GAS f32x4* xr = (const GAS f32x4*)(x + (size_t)m * D) + F.lane;
          f32x4 v[4]; float ss = 0.f;
#pragma unroll
          for (int j = 0; j < 4; ++j) { v[j] = xr[64 * j]; ss += (v[j].x * v[j].x + v[j].y * v[j].y) + (v[j].z * v[j].z + v[j].w * v[j].w); }
          const float rs = 1.0f / sqrtf(wave_sum(ss) * (1.0f / D) + EPS);
          GAS unsigned long long* o8 = (GAS unsigned long long*)(A0 + (size_t)m * D) + F.lane;
          float fa[8];
#pragma unroll
          for (int h = 0; h < 8; ++h) fa[h] = 0.f;
#pragma unroll
          for (int j = 0; j < 4; ++j) {
              const f32x4 y = v[j] * gv[j] * rs;
              o8[64 * j] = (unsigned long long)pk2(y.x, y.y) | ((unsigned long long)pk2(y.z, y.w) << 32);
#pragma unroll
              for (int i = 0; i < 4; ++i) { const LAS f32x4* wp = (const LAS f32x4*)(wf + ((j * 4 + i) * 128 + F.lane) * 4); const f32x4 wa = wp[0], wb = wp[64]; const float xv = v[j][i];
                  fa[0] += xv * wa.x; fa[1] += xv * wa.y; fa[2] += xv * wa.z; fa[3] += xv * wa.w; fa[4] += xv * wb.x; fa[5] += xv * wb.y; fa[6] += xv * wb.z; fa[7] += xv * wb.w; }
          }
          float mine = 0.f;
#pragma unroll
          for (int h = 0; h < 8; ++h) { const float t = wave_sum(fa[h]); if (F.lane == h) mine = t; }
          if (F.lane < 8) LF[(size_t)m * 8 + F.lane] = log_sigmoid(mine * rs + b_f[F.lane]);
      }
      __syncthreads();
    }
    { bf16* wrH = (bf16*)(ws + WS_WRH); bf16* wrL = (bf16*)(ws + WS_WRL); float* b1p = (float*)(ws + WS_B1P);
      for (int i = gt; i < NE * D; i += NGT) { const int e = i >> 10, k = i & 1023; const float w = g_mlp[k] * w_router[(size_t)k * NE + e]; const unsigned hb = f2bf(w);
          wrH[i] = (bf16)hb; wrL[i] = (bf16)f2bf(w - __builtin_bit_cast(float, hb << 16)); }
      for (int i = gt; i < NE * 2048; i += NGT) { const int e = i >> 11, r = i & 2047, pn = r >> 8, rho = r & 255; const int o = 128 * pn + (rho & 127); b1p[i] = b1[(size_t)e * 2048 + 2 * o + (rho >> 7)] + (float)(rho >> 7); }
      bf16* PB = (bf16*)(ws + WS_PB);
      for (int i = gt; i < NTOK * PLE / 8; i += NGT) { const f32x4 a = *(const f32x4*)(p + (size_t)i * 8), b = *(const f32x4*)(p + (size_t)i * 8 + 4);
          v4u o; o.x = pk2(a.x, a.y); o.y = pk2(a.z, a.w); o.z = pk2(b.x, b.y); o.w = pk2(b.z, b.w); *(GAS v4u*)(PB + (size_t)i * 8) = o; }
    }
    { LAS float* scr = (LAS float*)(F.lds + RING_OFF + F.wave * 16384);
      constexpr int I_W1 = NE * 16 * 64, I_W2 = NE * 16 * 32, I_IN = 16 * 96, I_O = 16 * 32, I_G = 16 * 32, I_P = 4 * 32;
      constexpr int NITEMS = I_W1 + I_W2 + I_IN + I_O + I_G + I_P;
      for (int it = gw; it < NITEMS; it += NGW) {
          int r = it;
          if (r < I_W1) { const int e = r >> 10, q = r & 1023, kb = q >> 6, nb = q & 63;
              tr_item_f8(w1 + (size_t)e * D * 2048, 2048, 64 * kb, 32 * nb, 32 * nb, 2, ws + WS_W1 + (size_t)e * 2048 * D, D, scr, F.lane); continue; } r -= I_W1;
          if (r < I_W2) { const int e = r >> 9, q = r & 511, kb = q >> 5, nb = q & 31;
              tr_item_f8(w2 + (size_t)e * FF * D, D, 64 * kb, 32 * nb, 32 * nb, 3, ws + WS_W2 + (size_t)e * D * FF, FF, scr, F.lane); continue; } r -= I_W2;
          if (r < I_IN) { const int kb = r / 96, nb = r % 96; const int P0 = 32 * nb;
              tr_item(w_in, INW, 64 * kb, P0 + (P0 >= 1536 ? 8 : 0), P0, 1, (bf16*)(ws + WS_WIN), D, scr, F.lane); continue; } r -= I_IN;
          if (r < I_O) { const int kb = r >> 5, nb = r & 31; tr_item_f8(w_out, D, 64 * kb, 32 * nb, 32 * nb, 0, ws + WS_WOUT, D, scr, F.lane); continue; } r -= I_O;
          if (r < I_G) { const int kb = r >> 5, nb = r & 31; tr_item_f8(w_pg, D, 64 * kb, 32 * nb, 32 * nb, 0, ws + WS_WG, D, scr, F.lane); continue; } r -= I_G;
          { const int kb = r >> 5, nb = r & 31; tr_item(w_pp, D, 64 * kb, 32 * nb, 32 * nb, 0, (bf16*)(ws + WS_WP), PLE, scr, F.lane); }
      }
    }
}

__device__ __forceinline__ void p1_scan(Frame& F) {
    const float* LF = (const float*)(F.ws + WS_LF); float* CS = (float*)(F.ws + WS_CS);
    LAS float* sc = (LAS float*)(F.lds + RING_OFF);
    for (int seq = F.vcu; seq < BATCH * NFOX; seq += F.G) {
        const int b = seq >> 3, h = seq & 7;
        float v[4];
#pragma unroll
        for (int i = 0; i < 4; ++i) v[i] = LF[((size_t)b * SEQ + 4 * F.tid + i) * 8 + h];
        v[1] += v[0]; v[2] += v[1]; v[3] += v[2];
        float incl = v[3];
#pragma unroll
        for (int o = 1; o < 64; o <<= 1) { const float t = __shfl_up(incl, o); if (F.lane >= o) incl += t; }
        if (F.lane == 63) sc[F.wave] = incl;
        __syncthreads();
        float off = incl - v[3];
        for (int w = 0; w < F.wave; ++w) off += sc[w];
        f32x4 o; o.x = -(off + v[0]) * LOG2E; o.y = -(off + v[1]) * LOG2E; o.z = -(off + v[2]) * LOG2E; o.w = -(off + v[3]) * LOG2E;
        *(f32x4*)(CS + (size_t)seq * SEQ + 4 * F.tid) = o;
        __syncthreads();
    }
}

constexpr int CSL_OFF = 122880;
static_assert(CSL_OFF >= attn_body::LDS_ZERO + 16 && CSL_OFF + SEQ * 4 <= MISC_OFF, "FoX cs cache");
constexpr int DSTASH = 86016;
static_assert(DSTASH >= attn_body::L8_TAB + 2304 * 4 && DSTASH + 65536 <= MISC_OFF, "diff-attention stash");
__device__ __forceinline__ int t5_bucket(int n) {
    if (n < 16) return n;
    int b = 16;
    b += (n >= 19); b += (n >= 21); b += (n >= 24); b += (n >= 27); b += (n >= 31); b += (n >= 35); b += (n >= 40); b += (n >= 46);
    b += (n >= 52); b += (n >= 59); b += (n >= 67); b += (n >= 77); b += (n >= 87); b += (n >= 99); b += (n >= 113);
    return b;
}
__device__ __forceinline__ void p2_attention(Frame& F, char* shm) {
    const bf16* PROJ = (const bf16*)(F.ws + WS_PROJ); unsigned char* MIXED = F.ws + WS_MIXED;   const float* CS = (const float*)(F.ws + WS_CS);
    const float* rel_bias = KARG->in[2]; const float* g_subln = KARG->in[14];
    const int lane = F.lane, wid = F.wave;
    LAS float* tab = (LAS float*)(F.lds + attn_body::LDS_TAB);
    float skip_th;
    { const float gq = fabsf(KARG->in[6][lane]), gk = fabsf(KARG->in[7][lane]); float mq = gq, mk = gk;
#pragma unroll
      for (int o = 1; o < 64; o <<= 1) { mq = fmaxf(mq, __shfl_xor(mq, o)); mk = fmaxf(mk, __shfl_xor(mk, o)); }
      skip_th = 2.0f * (64.0f * C2) * mq * mk + 40.0f; }
    unsigned hpack;
    { const float bv = KARG->in[5][lane & 7]; int rk = 0;
#pragma unroll
      for (int j = 0; j < 8; ++j) { const float o = __shfl(bv, j); rk += (o < bv || (o == bv && j < (lane & 7))) ? 1 : 0; }
      hpack = 0u;
#pragma unroll
      for (int r = 0; r < 8; ++r) { const unsigned long long bal = __ballot(lane < 8 && rk == r); hpack |= (unsigned)__builtin_ctzll(bal) << (4 * r); }
      hpack = (unsigned)__builtin_amdgcn_readfirstlane((int)hpack); }
    for (int pi = F.vcu; pi < 128 * 4; pi += F.G) {
        const int bh = pi >> 2, s = (pi < 256) ? (pi & 3) : 3 - (pi & 3), b = bh >> 3, h = (hpack >> (4 * ((pi < 256) ? (bh & 7) : 7 - (bh & 7)))) & 7;
        LAS float* cs = (LAS float*)(F.lds + CSL_OFF);
        __syncthreads();
        { const float* csg = CS + (size_t)(b * 8 + h) * SEQ; for (int i = F.tid; i < SEQ / 4; i += NWAVES * 64) ((LAS f32x4*)cs)[i] = ((const f32x4*)csg)[i]; }
        __syncthreads();
        for (int half = 0; half < 2; ++half) {
            const int qb = half ? 7 - s : s, q0 = qb * 256, NTfull = 4 * qb + 4;
            int t0;
            { const float cq = cs[q0]; const int i = lane & 15; const bool ok = (2 * i <= NTfull - 4) && (i == 0 || cq - cs[128 * i - 1] > skip_th);
              const unsigned long long bal = __ballot(ok) & 0xffffull; t0 = 2 * (63 - __builtin_clzll(bal)); t0 = __builtin_amdgcn_readfirstlane(t0); }
            const int k0 = 64 * t0;
            __syncthreads();
            for (int i = F.tid; i < q0 + 256 - k0; i += NWAVES * 64) { unsigned h_, m_, l_; attn_body::split3(cs[k0 + i], h_, m_, l_);
                *(LAS v4u*)(F.lds + attn_body::LDS_TAB + 16 * i) = (v4u){h_ | (m_ << 16), l_ | 0x3F800000u, 0x3F803F80u, 0u}; }
            if (F.tid == 0) *(LAS v4u*)(F.lds + attn_body::LDS_ZERO) = (v4u){0u, 0u, 0u, 0u};
            __syncthreads();
            const bf16* base = PROJ + (size_t)b * SEQ * NPROJ;
            attn_body::attn_unit<8, 0, D>(q0, NTfull - t0, base + CQF + h * 64, base + (size_t)k0 * NPROJ + CKF + h * 64, base + (size_t)k0 * NPROJ + CVF + h * 64, (bf16*)(MIXED + (size_t)b * SEQ * D + h * 64), shm);
        }
    }
    float lam;
    { const float a = KARG->in[10][lane] * KARG->in[11][lane], c = KARG->in[12][lane] * KARG->in[13][lane]; lam = expf(wave_sum(a)) - expf(wave_sum(c)) + 0.2f; }
    for (int pi = F.vcu; pi < 64 * 4; pi += F.G) {
        const int bh = pi >> 2, s = pi & 3, b = bh >> 2, h = bh & 3;
        __syncthreads();
        LAS float* tab8 = (LAS float*)(F.lds + attn_body::L8_TAB);
        for (int i = F.tid; i < 2304; i += NWAVES * 64) { const int dist = 2047 - i; tab8[i] = (rel_bias[t5_bucket(dist > 0 ? dist : 0) * NDIFF + h] - rel_bias[31 * NDIFF + h]) * LOG2E; }
        __syncthreads();
        for (int half = 0; half < 2; ++half) {
            const int qb = half ? 7 - s : s, q0 = qb * 256;
            const bf16* base = PROJ + (size_t)b * SEQ * NPROJ;
            attn_body::attn_unit128<8, DSTASH>(q0, base + CQD + h * 128, base + CKD + h * 128, base + CVD + h * 128, shm);
            attn_body::attn_unit128<8, 0>(q0, base + CQD + h * 128 + 64, base + CKD + h * 128 + 64, base + CVD + h * 128, shm);
            int l2 = threadIdx.x & 63; asm volatile("" : "+v"(l2));
            const int cr = l2 >> 4, cc = (l2 & 15) * 8;
            const LAS bf16* s1 = (const LAS bf16*)(F.lds + DSTASH) + wid * 4096 + cr * 128 + cc; const LAS bf16* s2 = (const LAS bf16*)(F.lds) + wid * 4096 + cr * 128 + cc;
            unsigned char* mrow = MIXED + ((size_t)b * SEQ + q0 + 32 * wid + cr) * D + 512 + h * 128 + cc;
            v4u w1[8], w2[8];
#pragma unroll
            for (int it = 0; it < 8; ++it) { w1[it] = *(const LAS v4u*)(s1 + 4 * it * 128); w2[it] = *(const LAS v4u*)(s2 + 4 * it * 128); }
            f32x4 ga = *(const f32x4*)(g_subln + cc), gb = *(const f32x4*)(g_subln + cc + 4);
#pragma unroll
            for (int it = 0; it < 8; ++it) {
                const unsigned a1[4] = {w1[it].x, w1[it].y, w1[it].z, w1[it].w}, a2[4] = {w2[it].x, w2[it].y, w2[it].z, w2[it].w};
                float dv[8]; float ss = 0.f;
#pragma unroll
                for (int i = 0; i < 4; ++i) { dv[2 * i] = bflo(a1[i]) - lam * bflo(a2[i]); dv[2 * i + 1] = bfhi(a1[i]) - lam * bfhi(a2[i]); ss += dv[2 * i] * dv[2 * i] + dv[2 * i + 1] * dv[2 * i + 1]; }
                ss += __shfl_xor(ss, 1); ss += __shfl_xor(ss, 2); ss += __shfl_xor(ss, 4); ss += __shfl_xor(ss, 8);
                const float rq = 0.8f / sqrtf(ss * (1.0f / 128.0f) + EPS);
                u32x2v o; o.x = pk4_fp8(dv[0] * rq * ga.x, dv[1] * rq * ga.y, dv[2] * rq * ga.z, dv[3] * rq * ga.w); o.y = pk4_fp8(dv[4] * rq * gb.x, dv[5] * rq * gb.y, dv[6] * rq * gb.z, dv[7] * rq * gb.w);
                *(GAS u32x2v*)(mrow + (size_t)(4 * it) * D) = o;
            }
            __syncthreads();
        }
    }
}

__device__ __forceinline__ void p4_router(Frame& F) {
    const bf16* h1 = (const bf16*)(F.ws + WS_H1B); const float* g_mlp = KARG->in[16]; const float* b_router = KARG->in[18];
    const bf16* wrH = (const bf16*)(F.ws + WS_WRH); const bf16* wrL = (const bf16*)(F.ws + WS_WRL);
    unsigned char* A0 = F.ws + WS_A0;
    int* tokE = (int*)(F.ws + WS_TOKE); float* gateE = (float*)(F.ws + WS_GATEE); float* rsE = (float*)(F.ws + WS_RSE); int* tp = (int*)(F.ws + WS_TP);
    const int lane = F.lane, r16 = lane & 15, kq = lane >> 4;
    constexpr int WPITCH = 2064;
    LAS unsigned char* wH = F.lds; LAS unsigned char* wL = F.lds + 32 * WPITCH;
    for (int c = F.tid; c < 2 * 4096; c += NWAVES * 64) { const int mtx = c >> 12, cc = c & 4095, r = cc >> 7, q = cc & 127;
        *(LAS v4u*)((mtx ? wL : wH) + r * WPITCH + q * 16) = *(const v4u*)((mtx ? wrL : wrH) + (size_t)r * D + q * 8); }
    LAS float* lg = (LAS float*)(F.lds + 64 * WPITCH + F.wave * 2176);
    LAS unsigned* hist = (LAS unsigned*)(F.lds + EPI_OFF); LAS unsigned* baseL = hist + 32;
    static_assert(64 * WPITCH + NWAVES * 2176 <= TILEE_OFF, "router LDS map");
    __syncthreads();
    for (int g0 = F.vcu; g0 < NTOK / 128; g0 += F.G) {
        const int R0 = (g0 * NWAVES + F.wave) * 16; const int row = R0 + r16;
        if (F.tid < 32) hist[F.tid] = 0u;
        __syncthreads();
        f32x4 acc0 = {0.f, 0.f, 0.f, 0.f}, acc1 = {0.f, 0.f, 0.f, 0.f}; float ss = 0.f;
        const bf16* xr = h1 + (size_t)row * D + 16 * kq;
#pragma unroll 2
        for (int p = 0; p < 16; ++p) {
            const int k = 64 * p + 16 * kq;
            const v4u xw0 = *(const v4u*)(xr + 64 * p), xw1 = *(const v4u*)(xr + 64 * p + 8);
            const f32x4 g0 = *(const f32x4*)(g_mlp + k), g1 = *(const f32x4*)(g_mlp + k + 4), g2 = *(const f32x4*)(g_mlp + k + 8), g3 = *(const f32x4*)(g_mlp + k + 12);
            const float xv[16] = {bflo(xw0.x), bfhi(xw0.x), bflo(xw0.y), bfhi(xw0.y), bflo(xw0.z), bfhi(xw0.z), bflo(xw0.w), bfhi(xw0.w),
                                  bflo(xw1.x), bfhi(xw1.x), bflo(xw1.y), bfhi(xw1.y), bflo(xw1.z), bfhi(xw1.z), bflo(xw1.w), bfhi(xw1.w)};
#pragma unroll
            for (int j = 0; j < 16; ++j) ss += xv[j] * xv[j];
            { v4u o; o.x = pk4_fp8(xv[0] * g0.x, xv[1] * g0.y, xv[2] * g0.z, xv[3] * g0.w); o.y = pk4_fp8(xv[4] * g1.x, xv[5] * g1.y, xv[6] * g1.z, xv[7] * g1.w);
              o.z = pk4_fp8(xv[8] * g2.x, xv[9] * g2.y, xv[10] * g2.z, xv[11] * g2.w); o.w = pk4_fp8(xv[12] * g3.x, xv[13] * g3.y, xv[14] * g3.z, xv[15] * g3.w);
              *(GAS v4u*)(A0 + (size_t)row * D + k) = o; }
#pragma unroll
            for (int hf = 0; hf < 2; ++hf) {
                const bf16x8 Ah = __builtin_bit_cast(bf16x8, hf ? xw1 : xw0); const int kk = k + 8 * hf;
                const bf16x8 Bh0 = *(const LAS bf16x8*)(wH + r16 * WPITCH + 2 * kk), Bl0 = *(const LAS bf16x8*)(wL + r16 * WPITCH + 2 * kk);
                const bf16x8 Bh1 = *(const LAS bf16x8*)(wH + (16 + r16) * WPITCH + 2 * kk), Bl1 = *(const LAS bf16x8*)(wL + (16 + r16) * WPITCH + 2 * kk);
                acc0 = __builtin_amdgcn_mfma_f32_16x16x32_bf16(Ah, Bh0, acc0, 0, 0, 0); acc0 = __builtin_amdgcn_mfma_f32_16x16x32_bf16(Ah, Bl0, acc0, 0, 0, 0);
                acc1 = __builtin_amdgcn_mfma_f32_16x16x32_bf16(Ah, Bh1, acc1, 0, 0, 0); acc1 = __builtin_amdgcn_mfma_f32_16x16x32_bf16(Ah, Bl1, acc1, 0, 0, 0); }
        }
        ss += __shfl_xor(ss, 16); ss += __shfl_xor(ss, 32);
        const float rs = 1.0f / sqrtf(ss * (1.0f / D) + EPS);
#pragma unroll
        for (int i = 0; i < 4; ++i) { lg[(4 * kq + i) * 33 + r16] = acc0[i]; lg[(4 * kq + i) * 33 + 16 + r16] = acc1[i]; }
        if (kq == 0) lg[16 * 33 + r16] = rs;
        asm volatile("s_waitcnt lgkmcnt(0)" ::: "memory");
        int se[4] = {0, 0, 0, 0}; float sg[4] = {0.f, 0.f, 0.f, 0.f}; unsigned rk[4] = {0u, 0u, 0u, 0u}; float myrs = 0.f;
        if (lane < 16) {
            myrs = lg[16 * 33 + lane];
            float v[32];
#pragma unroll
            for (int e = 0; e < 32; ++e) v[e] = lg[lane * 33 + e] * myrs + b_router[e];
            float sv[4];
#pragma unroll
            for (int k = 0; k < 4; ++k) { float best = v[0]; int bi = 0;
#pragma unroll
                for (int e = 1; e < 32; ++e) { const bool gt = v[e] > best; best = gt ? v[e] : best; bi = gt ? e : bi; }
                sv[k] = best; se[k] = bi;
#pragma unroll
                for (int e = 0; e < 32; ++e) v[e] = (e == bi) ? -INFINITY : v[e]; }
            float den = 0.f;
#pragma unroll
            for (int k = 0; k < 4; ++k) { sg[k] = expf(sv[k] - sv[0]); den += sg[k]; }
            const float inv = 1.0f / den;
#pragma unroll
            for (int k = 0; k < 4; ++k) { sg[k] *= inv; rk[k] = __hip_atomic_fetch_add(hist + se[k], 1u, __ATOMIC_RELAXED, __HIP_MEMORY_SCOPE_WORKGROUP); }
        }
        __syncthreads();
        if (F.tid < 32) { const unsigned c = hist[F.tid]; baseL[F.tid] = c ? __hip_atomic_fetch_add((unsigned*)(F.ctl + CW_CNT + 64 * F.tid), c, __ATOMIC_RELAXED, __HIP_MEMORY_SCOPE_AGENT) : 0u; }
        __syncthreads();
        if (lane < 16) {
            const int trow = R0 + lane;
#pragma unroll
            for (int k = 0; k < 4; ++k) { const unsigned pos = baseL[se[k]] + rk[k]; const size_t ix = (size_t)se[k] * ECAP + pos;
                tokE[ix] = trow; gateE[ix] = sg[k]; rsE[ix] = myrs; tp[(size_t)trow * 4 + k] = se[k] * 32768 + (int)pos; }
        }
        __syncthreads();
    }
}
__device__ __forceinline__ int moe_tables(Frame& F) {
    LAS int* ts = lds_tstart(F.lds); LAS int* cn = lds_cnt(F.lds); LAS unsigned short* te = lds_tileE(F.lds);
    __syncthreads();
    if (F.tid < 64) {
        const int c = F.tid < 32 ? (int)__hip_atomic_load((unsigned*)(F.ctl + CW_CNT + 64 * F.tid), __ATOMIC_RELAXED, __HIP_MEMORY_SCOPE_AGENT) : 0;
        const int nt = (c + 255) >> 8; int incl = nt;
#pragma unroll
        for (int o = 1; o < 32; o <<= 1) { const int t = __shfl_up(incl, o); if (F.lane >= o) incl += t; }
        if (F.tid < 32) { cn[F.tid] = c; ts[F.tid] = incl - nt; if (F.tid == 31) ts[32] = incl; }
    }
    __syncthreads();
    const int total = ts[32];
    for (int t = F.tid; t < total; t += NWAVES * 64) { int e = 0;
#pragma unroll
        for (int j = 1; j < 32; ++j) e += (t >= ts[j]) ? 1 : 0;
        te[t] = (unsigned short)e; }
    __syncthreads();
    return total;
}
__device__ __forceinline__ void p7_combine(Frame& F) {
    const unsigned char* Y = F.ws + WS_Y; const int* tp = (const int*)(F.ws + WS_TP); unsigned char* A3 = F.ws + WS_A3; float* rs3 = (float*)(F.ws + WS_RS3);
    const float* g_ple = KARG->in[23]; const bf16* h1 = (const bf16*)(F.ws + WS_H1B); bf16* h2 = (bf16*)(F.ws + WS_H2B);
    LAS int* ts = lds_tstart(F.lds);
    const int gw = F.vcu * NWAVES + F.wave, NGW = F.G * NWAVES;
    f32x4 gv[4];
#pragma unroll
    for (int j = 0; j < 4; ++j) gv[j] = *(const f32x4*)(g_ple + 256 * j + 4 * F.lane);
    for (int m = gw; m < NTOK; m += NGW) {
        const GAS u32x2v* hr = (const GAS u32x2v*)(h1 + (size_t)m * D) + F.lane; GAS u32x2v* ho = (GAS u32x2v*)(h2 + (size_t)m * D) + F.lane;
        f32x4 v[4];
#pragma unroll
        for (int j = 0; j < 4; ++j) { const u32x2v w = hr[64 * j]; v[j] = (f32x4){bflo(w.x), bfhi(w.x), bflo(w.y), bfhi(w.y)}; }
#pragma unroll
        for (int k = 0; k < 4; ++k) { const int t = tp[(size_t)m * 4 + k]; const int e = t >> 15, pos = t & 32767; const size_t yr = (size_t)ts[e] * 256 + pos;
            const GAS unsigned* yp = (const GAS unsigned*)(Y + yr * D) + F.lane;
#pragma unroll
            for (int j = 0; j < 4; ++j) { const unsigned w = yp[64 * j]; const f32x2t a = __builtin_amdgcn_cvt_pk_f32_fp8((int)w, false), c = __builtin_amdgcn_cvt_pk_f32_fp8((int)w, true);
                v[j].x += a[0] * 0.0625f; v[j].y += a[1] * 0.0625f; v[j].z += c[0] * 0.0625f; v[j].w += c[1] * 0.0625f; } }
        float ss = 0.f;
        GAS unsigned* o4 = (GAS unsigned*)(A3 + (size_t)m * D) + F.lane;
#pragma unroll
        for (int j = 0; j < 4; ++j) { { u32x2v w; w.x = pk2(v[j].x, v[j].y); w.y = pk2(v[j].z, v[j].w); ho[64 * j] = w; } ss += (v[j].x * v[j].x + v[j].y * v[j].y) + (v[j].z * v[j].z + v[j].w * v[j].w);
            const f32x4 y = v[j] * gv[j]; o4[64 * j] = pk4_fp8(y.x, y.y, y.z, y.w); }
        ss = wave_sum(ss);
        if (F.lane == 0) rs3[m] = 1.0f / sqrtf(ss * (1.0f / D) + EPS);
    }
}

__global__ void __launch_bounds__(NWAVES * 64, 2) fwd_kernel(Args args) {
    extern __shared__ __attribute__((aligned(16))) unsigned char lds[];
    Frame F;
    F.lds = (LAS unsigned char*)lds;
    F.MISC = (volatile LAS unsigned*)(F.lds + MISC_OFF);
    FRESH(F);
    F.G = gridDim.x; { const int bx = blockIdx.x; F.vcu = (F.G % 8 == 0) ? (bx % 8) * (F.G / 8) + bx / 8 : bx; }
    F.ws = KARG->ws; F.ctl = (gu32*)(KARG->ws + WS_CTL); F.out = KARG->out;
    unsigned char* ws = KARG->ws;
    if (F.tid < 64) ((LAS unsigned*)(F.lds + MISC_OFF))[F.tid] = 0u;
    __syncthreads();
    XcdBarrier bar = xcd_barrier_post((unsigned*)(F.ctl + CW_BAR), F.MISC + 8);
    const int lo = KARG->ph_lo, hi = KARG->ph_hi;
#ifndef PHMASK
#define PHMASK 0x1ff
#endif
#define IN(k) (((PHMASK >> (k)) & 1) && lo <= (k) && (k) < hi)
#define BOTH(k) (IN(k) && IN((k) + 1))
#define GRID_BAR() xcd_barrier(bar)

    if (IN(0)) { FRESH(F); p0_prologue(F); if (BOTH(0)) GRID_BAR(); }

    if (IN(1)) {
        FRESH(F); p1_scan(F);
        { pg8::Gemm g{(const bf16*)(ws + WS_A0), D}; SchedC S{NTOK / 256, NPROJ / 256, F.G, (int)blockIdx.x, D, (const char*)(ws + WS_WIN)};
          EpiProj E{(bf16*)(ws + WS_PROJ), KARG->in[6], KARG->in[7], KARG->in[8], KARG->in[9]};
          pg8::gemm_phase<EpiProj, SchedC>(F.lds + RING_OFF, g, S, E); }
        if (BOTH(1)) GRID_BAR();
    }

    if (IN(2)) { FRESH(F); p2_attention(F, (char*)lds); if (BOTH(2)) GRID_BAR(); }

    if (IN(3)) {
        pg8::Gemm g{(const bf16*)(ws + WS_MIXED), D / 2}; SchedC S{NTOK / 256, D / 256, F.G, (int)blockIdx.x, D / 2, (const char*)(ws + WS_WOUT)};
        EpiRes E{KARG->in[0], (bf16*)(ws + WS_H1B)};
        pg8::gemm_phase<EpiRes, SchedC, true>(F.lds + RING_OFF, g, S, E);
        if (BOTH(3)) GRID_BAR();
    }

    if (IN(4)) { FRESH(F); p4_router(F); if (BOTH(4)) GRID_BAR(); }

    if (IN(5)) {
        FRESH(F); const int ntile = moe_tables(F);
        typedef SchedM<true, 8, 2048, 512> S1;
        S1 S{F.G, (int)blockIdx.x, (const char*)(ws + WS_W1), F.lds, ntile};
        { const int* tokE = (const int*)(ws + WS_TOKE); LAS int* tk = (LAS int*)(F.lds + TOKL_OFF); pg8::Unit u;
          for (int i = 0; i < 18 && S.next(i, u); ++i) if (F.tid < 256) { const int lr = u.lr0 + F.tid; tk[i * 256 + F.tid] = lr < lds_cnt(F.lds)[u.e] ? tokE[(size_t)u.e * ECAP + lr] : 0; }
          __syncthreads(); }
        pg8::Gemm g{(const bf16*)(ws + WS_A0), D / 2};
        EpiSwiglu E{ws + WS_HB, (const float*)(ws + WS_B1P), (const float*)(ws + WS_RSE), F.lds};
        pg8::gemm_phase<EpiSwiglu, S1, true>(F.lds + RING_OFF, g, S, E);
        { const int c = (int)blockIdx.x, rem = (8 * ntile) % F.G;
          if (rem && c >= rem && c - rem < NPPU) {
              pg8::Gemm g2{(const bf16*)(ws + WS_PB), PLE}; SchedC S2{NTOK / 256, D / 256, 1 << 20, c - rem, PLE, (const char*)(ws + WS_WP)};
              EpiBf16P E2{ws + WS_PP, D};
              pg8::gemm_phase<EpiBf16P, SchedC>(F.lds + RING_OFF, g2, S2, E2); } }
        if (BOTH(5)) GRID_BAR();
    }

    if (IN(6)) {
        FRESH(F); const int ntile = (lo <= 5) ? lds_tstart(F.lds)[32] : moe_tables(F);
        typedef SchedM<false, 4, 1024, 512> S2;
        S2 S{F.G, (int)blockIdx.x, (const char*)(ws + WS_W2), F.lds, ntile};
        pg8::Gemm g{(const bf16*)(ws + WS_HB), FF / 2};
        EpiY E{ws + WS_Y, KARG->in[22], (const float*)(ws + WS_GATEE), F.lds};
        pg8::gemm_phase<EpiY, S2, true>(F.lds + RING_OFF, g, S, E);
        { const int c = (int)blockIdx.x, rem5 = (8 * ntile) % F.G, n5 = rem5 ? min(F.G - rem5, NPPU) : 0, left = NPPU - n5;
          const int rem6 = (4 * ntile) % F.G, idle6 = rem6 ? F.G - rem6 : 0;
          const bool onidle = idle6 > 0 && left <= 3 * idle6;
          const int stride = onidle ? idle6 : F.G, j = onidle ? c - rem6 : c;
          if (j >= 0 && n5 + j < NPPU) {
              pg8::Gemm g2{(const bf16*)(ws + WS_PB), PLE}; SchedC S3{NTOK / 256, D / 256, stride, n5 + j, PLE, (const char*)(ws + WS_WP)};
              EpiBf16P E2{ws + WS_PP, D};
              pg8::gemm_phase<EpiBf16P, SchedC>(F.lds + RING_OFF, g2, S3, E2); } }
        if (BOTH(6)) GRID_BAR();
    }

    if (IN(7)) { FRESH(F); if (lo > 5) (void)moe_tables(F); p7_combine(F); if (BOTH(7)) GRID_BAR(); }

    if (IN(8)) {
        pg8::Gemm g{(const bf16*)(ws + WS_A3), D / 2}; SchedC S{NTOK / 256, D / 256, F.G, (int)blockIdx.x, D / 2, (const char*)(ws + WS_WG)};
        EpiFinal E{F.out, (const bf16*)(ws + WS_H2B), ws + WS_PP, (const float*)(ws + WS_RS3)};
        pg8::gemm_phase<EpiFinal, SchedC, true>(F.lds + RING_OFF, g, S, E);
    }
#undef IN
#undef BOTH
#undef GRID_BAR
}

#ifndef MK_N_LAUNCHES
#define MK_N_LAUNCHES 1
#endif
extern "C" void kernel_launch(void* const* d_in, const int* in_sizes, int n_in, void* d_out, int out_size, void* d_ws, size_t ws_size, hipStream_t stream) {
    static int grid = 0;
    if (grid == 0) {
        if (n_in != 26 || in_sizes[0] != NTOK * D || out_size != NTOK * D || ws_size < WS_END) {
            fprintf(stderr, "kernel_launch: unexpected shapes (n_in %d, in0 %d, out %d, ws %zu need %zu); nothing launched\n", n_in, n_in > 0 ? in_sizes[0] : -1, out_size, ws_size, (size_t)WS_END); grid = -1; return; }
        int dev = 0, cus = 0, per_cu = 0;
        if (hipGetDevice(&dev) != hipSuccess || hipDeviceGetAttribute(&cus, hipDeviceAttributeMultiprocessorCount, dev) != hipSuccess) { grid = -1; return; }
        if (hipFuncSetAttribute((const void*)fwd_kernel, hipFuncAttributeMaxDynamicSharedMemorySize, LDS_BYTES) != hipSuccess) { fprintf(stderr, "kernel_launch: hipFuncSetAttribute failed\n"); grid = -1; return; }
        if (hipOccupancyMaxActiveBlocksPerMultiprocessor(&per_cu, (const void*)fwd_kernel, NWAVES * 64, LDS_BYTES) != hipSuccess || per_cu < 1)
            fprintf(stderr, "kernel_launch: note: occupancy query reports %d workgroups per CU\n", per_cu);
        (void)hipGetLastError();
        grid = cus;
        if (grid != 256) fprintf(stderr, "kernel_launch: note: %d CUs (tuned for 256)\n", grid);
    }
    if (grid < 0) return;
    if (hipMemsetAsync((char*)d_ws + WS_CTL, 0, CTL_ZERO_BYTES, stream) != hipSuccess) { fprintf(stderr, "kernel_launch: memset failed\n"); return; }
    Args a{};
    for (int i = 0; i < 26; ++i) a.in[i] = (const float*)d_in[i];
    a.out = (float*)d_out; a.ws = (unsigned char*)d_ws;
#if MK_N_LAUNCHES == 1
    a.ph_lo = 0; a.ph_hi = 9;
    hipLaunchKernelGGL(fwd_kernel, dim3(grid), dim3(NWAVES * 64), LDS_BYTES, stream, a);
#else
    for (int ph = 0; ph < 9; ++ph) { a.ph_lo = ph; a.ph_hi = ph + 1; hipLaunchKernelGGL(fwd_kernel, dim3(grid), dim3(NWAVES * 64), LDS_BYTES, stream, a); }
#endif
    const hipError_t le = hipPeekAtLastError();
    if (le != hipSuccess) fprintf(stderr, "kernel_launch: launch failed: %s\n", hipGetErrorName(le));
}
```

```cpp
#include <hip/hip_runtime.h>
#include <cstdio>
#include <cstdint>

namespace pg8 {
#define PG8_LAS __attribute__((address_space(3)))
typedef unsigned short bf16_t;
typedef short bf16x8 __attribute__((ext_vector_type(8)));
typedef float f32x4 __attribute__((ext_vector_type(4)));
typedef float f32x2 __attribute__((ext_vector_type(2)));
typedef unsigned u32x4 __attribute__((ext_vector_type(4)));
typedef unsigned u32x2 __attribute__((ext_vector_type(2)));
constexpr int BM = 256, BK = 64, HALF = 128, HTB = HALF * BK * 2  , STAGE_BYTES = 8 * HTB, NXCD = 8, WGM = 8;

__host__ __device__ __forceinline__ int lds_byte(int r, int c) { const int st = (r >> 4) * 2 + (c >> 5), rr = r & 15, cc = c & 31, ob = rr * 64 + cc * 2; return st * 1024 + (ob ^ (((ob >> 9) & 1) << 5)); }
__host__ __device__ __forceinline__ void stage_rc(int b, int& R, int& C) { const int st = b / 1024, sb = b % 1024, swz = sb ^ (((sb >> 9) & 1) << 5); R = (st >> 1) * 16 + swz / 64; C = (st & 1) * 32 + (swz % 64) / 2; }
__host__ __device__ __forceinline__ int perm32(int rho) { const int n = rho >> 4, i = rho & 15; return 8 * (i >> 2) + 4 * n + (i & 3); }

struct Unit { int pm, pn, e, lr0, ui; };
struct Gemm { const bf16_t* A; int K; };

__device__ __forceinline__ bool order_tile(long L, int nM, int nN, int& pm, int& pn) {
    const int nwg = nM * nN; if (L >= nwg) return false;
    int wgid = (int)L; { const int q = nwg / NXCD, r = nwg % NXCD, xcd = wgid % NXCD, off = wgid / NXCD; wgid = (xcd < r ? xcd * (q + 1) : r * (q + 1) + (xcd - r) * q) + off; }
    const int nig = WGM * nN, gid = wgid / nig, fm = gid * WGM, gsz = (nM - fm) < WGM ? (nM - fm) : WGM;
    pm = fm + ((wgid % nig) % gsz); pn = (wgid % nig) / gsz; return true;
}

typedef float f32x2_t __attribute__((ext_vector_type(2))); typedef __bf16 bf16x2_t __attribute__((ext_vector_type(2)));
__device__ __forceinline__ unsigned cvt_pk_bf16(float lo, float hi) { f32x2_t v = {lo, hi}; bf16x2_t b = __builtin_convertvector(v, bf16x2_t); return __builtin_bit_cast(unsigned, b); }

typedef int v8i __attribute__((ext_vector_type(8))); typedef int v4i __attribute__((ext_vector_type(4)));
__device__ __forceinline__ v8i cat8(bf16x8 a, bf16x8 b) { return __builtin_shufflevector(__builtin_bit_cast(v4i, a), __builtin_bit_cast(v4i, b), 0, 1, 2, 3, 4, 5, 6, 7); }
template <class Epi, class Sched, bool F8 = false>
__device__ __forceinline__ void gemm_phase(PG8_LAS unsigned char* lds, const Gemm g, const Sched& S, const Epi& E) {
    int tid = threadIdx.x; asm volatile("" : "+v"(tid));
    const int wid = __builtin_amdgcn_readfirstlane(tid >> 6), lane = tid & 63, wr = wid >> 2, wc = wid & 3, fr = lane & 15, fq = lane >> 4;
    const int K = g.K, nt = K / BK;
    unsigned voffB[2]; int aR[2], aC[2];
#pragma unroll
    for (int i = 0; i < 2; ++i) { int R, C; stage_rc(tid * 16 + i * 8192, R, C); const int Rb = Epi::PERM ? ((R & ~31) + perm32(R & 31)) : R;
        aR[i] = R; aC[i] = C; voffB[i] = (unsigned)(Rb * K + C) * 2u; }
    const size_t kstep = (size_t)(BK * 2);
    const size_t hstep = (size_t)HALF * K * 2;
    const unsigned ldsw = (unsigned)wid * 1024u;
    const int aoff = lds_byte(wr * 64 + fr, fq * 8), boff = lds_byte(wc * 32 + fr, fq * 8);
#define PG8_SA(b, h) (((b) * 2 + (h)) * HTB)
#define PG8_SB(b, h) ((4 + (b) * 2 + (h)) * HTB)
#define PG8_STAGE(bufoff, gbase, voff) do { _Pragma("unroll") for (int _i = 0; _i < 2; ++_i) \
        __builtin_amdgcn_global_load_lds((const unsigned*)((const char*)(gbase) + (voff)[_i]), (PG8_LAS unsigned*)(lds + (bufoff) + ldsw + _i * 8192), 16, 0, 0); } while (0)
#define PG8_LDA(dst, b, h) do { if constexpr (F8) { _Pragma("unroll") for (int m = 0; m < 4; ++m) dst##8[m] = cat8(*(const PG8_LAS bf16x8*)(lds + PG8_SA(b, h) + aoff + m * 2048), *(const PG8_LAS bf16x8*)(lds + PG8_SA(b, h) + aoff + m * 2048 + 1024)); } \
        else { _Pragma("unroll") for (int m = 0; m < 4; ++m) _Pragma("unroll") for (int k = 0; k < 2; ++k) dst[m][k] = *(const PG8_LAS bf16x8*)(lds + PG8_SA(b, h) + aoff + m * 2048 + k * 1024); } } while (0)
#define PG8_LDB(dst, b, h) do { if constexpr (F8) { _Pragma("unroll") for (int n = 0; n < 2; ++n) dst##8[n] = cat8(*(const PG8_LAS bf16x8*)(lds + PG8_SB(b, h) + boff + n * 2048), *(const PG8_LAS bf16x8*)(lds + PG8_SB(b, h) + boff + n * 2048 + 1024)); } \
        else { _Pragma("unroll") for (int n = 0; n < 2; ++n) _Pragma("unroll") for (int k = 0; k < 2; ++k) dst[n][k] = *(const PG8_LAS bf16x8*)(lds + PG8_SB(b, h) + boff + n * 2048 + k * 1024); } } while (0)
#define PG8_MMA(ai, bj, At, Bt) do { __builtin_amdgcn_s_setprio(1); \
        if constexpr (F8) { _Pragma("unroll") for (int m = 0; m < 4; ++m) _Pragma("unroll") for (int n = 0; n < 2; ++n) \
            asm volatile("v_mfma_scale_f32_16x16x128_f8f6f4 %0, %1, %2, %0, %3, %4 op_sel_hi:[0,0,0]" : "+v"(acc[ai][bj][m][n]) : "v"(Bt##8[n]), "v"(At##8[m]), "v"(scW)  , "v"(scX)); } \
        else { _Pragma("unroll") for (int m = 0; m < 4; ++m) _Pragma("unroll") for (int n = 0; n < 2; ++n) _Pragma("unroll") for (int k = 0; k < 2; ++k) \
            acc[ai][bj][m][n] = __builtin_amdgcn_mfma_f32_16x16x32_bf16(Bt[n][k], At[m][k], acc[ai][bj][m][n], 0, 0, 0); } \
        __builtin_amdgcn_s_setprio(0); } while (0)
#define PG8_WAIT_V(n) asm volatile("s_waitcnt vmcnt(" #n ")" ::: "memory")
#define PG8_WAIT_L(n) asm volatile("s_waitcnt lgkmcnt(" #n ")" ::: "memory")
#define PG8_BAR __builtin_amdgcn_s_barrier()
#define PG8_SCHED __builtin_amdgcn_sched_barrier(0)
    Unit cur, nxt; int ui = 0;
    if (!S.next(0, cur)) return;
    f32x4 acc[2][2][4][2];
#pragma unroll
    for (int a = 0; a < 2; ++a)
#pragma unroll
        for (int b = 0; b < 2; ++b)
#pragma unroll
            for (int m = 0; m < 4; ++m)
#pragma unroll
                for (int n = 0; n < 2; ++n) acc[a][b][m][n] = (f32x4){0.f, 0.f, 0.f, 0.f};
    const int scW = 0x7A7A7A7A, scX = 0x7F7F7F7F;
    bf16x8 At[4][2], B0[2][2], B1[2][2]; v8i At8[4], B08[2], B18[2];
    constexpr bool GA = Sched::GATHER;
    constexpr int H1 = GA ? 1 : 0;
    const size_t HS = GA ? (size_t)0 : hstep;
    const char* cA = GA ? (const char*)g.A : (const char*)g.A + S.aoff_uniform(cur);
    const char* cB = S.bptr(cur);
    unsigned aoC[2][2], aoN[2][2];
    if constexpr (GA) S.aoffs(cur, aR, aC, aoC);
    else {
#pragma unroll
        for (int i = 0; i < 2; ++i) aoC[0][i] = (unsigned)(aR[i] * K + aC[i]) * 2u; }
    PG8_STAGE(PG8_SB(0, 0), cB, voffB); PG8_STAGE(PG8_SB(0, 1), cB + hstep, voffB); PG8_STAGE(PG8_SA(0, 0), cA, aoC[0]); PG8_STAGE(PG8_SA(0, 1), cA + HS, aoC[H1]);
    if (wr == 1) PG8_BAR;
    PG8_WAIT_V(2); PG8_BAR;
    PG8_STAGE(PG8_SB(1, 0), cB + kstep, voffB); PG8_STAGE(PG8_SA(1, 0), cA + kstep, aoC[0]); PG8_STAGE(PG8_SB(1, 1), cB + hstep + kstep, voffB);
    PG8_WAIT_V(6); PG8_BAR;
    for (;;) {
        if constexpr (Epi::PREFETCH) E.prefetch(cur, lds + 152064 + (ui & 1) * 2048, wid, lane);
        const bool has_next = S.next(ui + 1, nxt);
        const char* nB = has_next ? S.bptr(nxt) : cB;
        const char* nA = GA ? cA : (has_next ? (const char*)g.A + S.aoff_uniform(nxt) : cA);
        if constexpr (GA) {
            if (has_next) S.aoffs(nxt, aR, aC, aoN);
            else {
#pragma unroll
                for (int h = 0; h < 2; ++h)
#pragma unroll
                    for (int i = 0; i < 2; ++i) aoN[h][i] = aoC[h][i]; } }
#pragma unroll 1
        for (int t = 0; t < nt; t += 2) {
            const bool last = (t == nt - 2);
            const char* a1 = cA + (size_t)(t + 1) * kstep;
            const char* a2 = last ? nA : cA + (size_t)(t + 2) * kstep; const char* b2 = last ? nB : cB + (size_t)(t + 2) * kstep;
            const char* a3 = a2 + kstep; const char* b3 = b2 + kstep;
            unsigned ao2[2][2];
            if constexpr (GA) {
#pragma unroll
                for (int h = 0; h < 2; ++h)
#pragma unroll
                    for (int i = 0; i < 2; ++i) ao2[h][i] = last ? aoN[h][i] : aoC[h][i];
            } else {
#pragma unroll
                for (int i = 0; i < 2; ++i) ao2[0][i] = aoC[0][i]; }
            PG8_LDB(B0, 0, 0); PG8_LDB(B1, 0, 1); PG8_SCHED; PG8_LDA(At, 0, 0); PG8_STAGE(PG8_SA(1, 1), a1 + HS, aoC[H1]);
            PG8_WAIT_V(8); PG8_WAIT_L(0); PG8_BAR; PG8_MMA(0, 0, At, B0); PG8_MMA(0, 1, At, B1); PG8_BAR; PG8_SCHED;
            PG8_LDA(At, 0, 1); PG8_STAGE(PG8_SB(0, 0), b2, voffB); PG8_STAGE(PG8_SB(0, 1), b2 + hstep, voffB); PG8_STAGE(PG8_SA(0, 0), a2, ao2[0]);
            PG8_WAIT_V(8); PG8_WAIT_L(0); PG8_BAR; PG8_MMA(1, 0, At, B0); PG8_MMA(1, 1, At, B1); PG8_BAR; PG8_SCHED;
            PG8_LDB(B0, 1, 0); PG8_LDB(B1, 1, 1); PG8_SCHED; PG8_LDA(At, 1, 0); PG8_STAGE(PG8_SA(0, 1), a2 + HS, ao2[H1]);
            PG8_WAIT_V(8); PG8_WAIT_L(0); PG8_BAR; PG8_MMA(0, 0, At, B0); PG8_MMA(0, 1, At, B1); PG8_BAR; PG8_SCHED;
            PG8_LDA(At, 1, 1); PG8_STAGE(PG8_SB(1, 0), b3, voffB); PG8_STAGE(PG8_SB(1, 1), b3 + hstep, voffB); PG8_STAGE(PG8_SA(1, 0), a3, ao2[0]);
            PG8_WAIT_V(8); PG8_WAIT_L(0); PG8_BAR; PG8_MMA(1, 0, At, B0); PG8_MMA(1, 1, At, B1); PG8_BAR; PG8_SCHED;
        }
        if (wr == 0) PG8_BAR;
        if constexpr (F8) asm volatile("s_nop 15\n\ts_nop 15" ::: "memory");
        { int l2 = lane; asm volatile("" : "+v"(l2)); if constexpr (Epi::PREFETCH) E(acc, cur, wr, wc, l2 & 15, l2 >> 4, lds + 152064 + (ui & 1) * 2048); else E(acc, cur, wr, wc, l2 & 15, l2 >> 4); }
        if (!has_next) break;
#pragma unroll
        for (int a = 0; a < 2; ++a)
#pragma unroll
            for (int b = 0; b < 2; ++b)
#pragma unroll
                for (int m = 0; m < 4; ++m)
#pragma unroll
                    for (int n = 0; n < 2; ++n) acc[a][b][m][n] = (f32x4){0.f, 0.f, 0.f, 0.f};
        cur = nxt; cB = nB; cA = nA; ++ui;
        if constexpr (GA) {
#pragma unroll
            for (int h = 0; h < 2; ++h)
#pragma unroll
                for (int i = 0; i < 2; ++i) aoC[h][i] = aoN[h][i]; }
        if (wr == 1) PG8_BAR;
    }
    PG8_WAIT_V(0);
    PG8_BAR;
#undef PG8_SA
#undef PG8_SB
#undef PG8_STAGE
#undef PG8_LDA
#undef PG8_LDB
#undef PG8_MMA
#undef PG8_WAIT_V
#undef PG8_WAIT_L
#undef PG8_BAR
#undef PG8_SCHED
}
}

constexpr int NWAVES = 8;
constexpr int BATCH = 16, SEQ = 2048, D = 1024, NTOK = BATCH * SEQ;
constexpr int INW = 3080, NPROJ = 3072;
constexpr int NE = 32, TOPK = 4, FF = 1024, PLE = 256;
constexpr int HD = 64, NFOX = 8, NDIFF = 4;
constexpr int CQF = 0, CKF = 512, CVF = 1024, CQD = 1536, CKD = 2048, CVD = 2560;
constexpr float EPS = 1e-6f;
constexpr float LOG2E = 1.4426950408889634f;
constexpr float C2 = 0.125f * LOG2E;
constexpr int MAXTILES = 544;
constexpr int ECAP = NTOK;

constexpr size_t MiB = 1u << 20;
constexpr size_t WS_CTL = 0, CTL_ZERO_BYTES = 1 * MiB;
constexpr size_t WS_WRH = 1 * MiB, WS_WRL = WS_WRH + 65536, WS_B1P = WS_WRL + 65536;
constexpr size_t WS_LF = 2 * MiB, WS_CS = 3 * MiB;
constexpr size_t WS_TP = 4 * MiB, WS_RS3 = 4 * MiB + 512 * 1024;
constexpr size_t WS_TOKE = 5 * MiB, WS_GATEE = 9 * MiB, WS_RSE = 13 * MiB;
constexpr size_t WS_WIN = 17 * MiB, WS_WOUT = 23 * MiB, WS_WG = 25 * MiB, WS_WP = 27 * MiB;
constexpr size_t WS_W1 = 28 * MiB, WS_W2 = 156 * MiB;
constexpr size_t WS_PB = 220 * MiB, WS_PP = 236 * MiB;
constexpr size_t WS_PROJ = 300 * MiB, WS_MIXED = 492 * MiB, WS_A0 = 556 * MiB;
constexpr size_t WS_Y = WS_PROJ;
constexpr size_t WS_HB = 620 * MiB;
constexpr size_t WS_A3 = WS_HB;
constexpr size_t WS_H1B = 756 * MiB, WS_H2B = 820 * MiB;
constexpr size_t WS_END = 892 * MiB;
constexpr int CW_TMO = 0, CW_BAR = 4096, CW_CNT = 8192;

constexpr int RING_OFF = 0, RING_BYTES = 131072;
constexpr int TOKL_OFF = RING_BYTES, TOKL_BYTES = 18 * 1024;
constexpr int TILEE_OFF = TOKL_OFF + TOKL_BYTES, TILEE_BYTES = 2304;
constexpr int MISC_OFF = TILEE_OFF + TILEE_BYTES;
constexpr int EPI_OFF = MISC_OFF + 256, EPI_BYTES = 4096;
constexpr int LDS_BYTES = EPI_OFF + EPI_BYTES;
static_assert(EPI_OFF == 152064, "gemm_phase addresses the epilogue prefetch buffers at this offset");
static_assert(LDS_BYTES <= 160 * 1024, "LDS");

#define GAS __attribute__((address_space(1)))
#define LAS __attribute__((address_space(3)))
typedef unsigned short bf16;
typedef unsigned v4u __attribute__((ext_vector_type(4)));
typedef float f32x4 __attribute__((ext_vector_type(4)));
typedef short bf16x8 __attribute__((ext_vector_type(8)));
typedef GAS unsigned gu32;
typedef GAS unsigned long long gu64;
#define RLX_AGENT __ATOMIC_RELAXED, __HIP_MEMORY_SCOPE_AGENT
#define LDS_WAIT() asm volatile("s_waitcnt lgkmcnt(0)" ::: "memory")
#define VM_WAIT() asm volatile("s_waitcnt vmcnt(0)" ::: "memory")
__device__ __forceinline__ unsigned long long rt() { return __builtin_amdgcn_s_memrealtime(); }
__device__ __forceinline__ unsigned f2bf(float f) { unsigned u = __builtin_bit_cast(unsigned, f); return (u + 0x7fffu + ((u >> 16) & 1u)) >> 16; }
__device__ __forceinline__ unsigned pk2(float lo, float hi) { return f2bf(lo) | (f2bf(hi) << 16); }
#define XB_TMO      128
#define XB_XCNT(j)  (256  + 64 * (j))
#define XB_XSUB(j)  (1280 + 64 * (j))
#define XB_XGEN(j)  (2304 + 64 * (j))
#define XB_TOP      3328
#define XB_TOPGEN   3392
#define XCD_BAR_WORDS 3456
#define XB_SPIN_CAP (1u << 18)

__device__ __forceinline__ unsigned xb_ld(unsigned* p)              { return __hip_atomic_load(p, __ATOMIC_RELAXED, __HIP_MEMORY_SCOPE_AGENT); }
__device__ __forceinline__ unsigned xb_add(unsigned* p, unsigned v) { return __hip_atomic_fetch_add(p, v, __ATOMIC_RELAXED, __HIP_MEMORY_SCOPE_AGENT); }
__device__ __forceinline__ unsigned xb_xcc_id() { return (unsigned)__builtin_amdgcn_s_getreg((3 << 11) | 20) & 0xFu; }
#define XB_SPIN(cond, bar) do { unsigned _sp = 0; while (cond) { __builtin_amdgcn_s_sleep(1); \
    if ((++_sp & 255u) == 0u) { if (xb_ld(&(bar)[XB_TMO])) break; if (_sp > XB_SPIN_CAP) { atomicAdd(&(bar)[XB_TMO], 1u); break; } } } } while (0)

struct XcdBarrier {
    unsigned* bar; unsigned x;
    volatile LAS unsigned* st;
};

__device__ __forceinline__ XcdBarrier xcd_barrier_post(unsigned* bar, volatile LAS unsigned* st) {
    XcdBarrier b; b.bar = bar; b.x = xb_xcc_id(); b.st = st;
    if (threadIdx.x == 0) (void)xb_add(&bar[XB_XCNT(b.x)], 1u);
    return b;
}
__device__ __forceinline__ void xcd_barrier_complete(unsigned* bar, unsigned x, unsigned& nloc, unsigned& nx) {
    const unsigned G = gridDim.x * gridDim.y * gridDim.z;
    unsigned sum, cnt, mine, sp = 0u;
    for (;;) {
        sum = 0u; cnt = 0u; mine = 0u;
#pragma unroll
        for (unsigned j = 0; j < 16; ++j) { const unsigned c = xb_ld(&bar[XB_XCNT(j)]); sum += c; cnt += (c > 0u) ? 1u : 0u; mine = (j == x) ? c : mine; }
        if (sum == G) break;
        __builtin_amdgcn_s_sleep(1);
        if ((++sp & 255u) == 0u) { if (xb_ld(&bar[XB_TMO])) break; if (sp > XB_SPIN_CAP) { atomicAdd(&bar[XB_TMO], 1u); break; } }
    }
    nloc = mine > 0u ? mine : 1u; nx = cnt > 0u ? cnt : 1u;
}

__device__ __forceinline__ void xcd_barrier(const XcdBarrier& b) {
    asm volatile("s_waitcnt vmcnt(0)" ::: "memory");
    __syncthreads();
    if (threadIdx.x == 0) {
        unsigned* bar = b.bar;
        __builtin_amdgcn_s_waitcnt(0);
        unsigned nloc = b.st[0], nx = b.st[1];
        if (nloc == 0u) { xcd_barrier_complete(bar, b.x, nloc, nx); b.st[0] = nloc; b.st[1] = nx; }
        const unsigned old = xb_add(&bar[XB_XSUB(b.x)], 1u);
        const unsigned gen = old / nloc;
        if (old + 1u == (gen + 1u) * nloc) {
            __builtin_amdgcn_fence(__ATOMIC_RELEASE, "agent");
            asm volatile("s_waitcnt vmcnt(0)" ::: "memory");
            const unsigned og = xb_add(&bar[XB_TOP], 1u);
            const unsigned tg = og / nx;
            if (og + 1u == (tg + 1u) * nx) xb_add(&bar[XB_TOPGEN], 1u);
            else XB_SPIN(xb_ld(&bar[XB_TOPGEN]) == tg, bar);
            __builtin_amdgcn_fence(__ATOMIC_ACQUIRE, "agent");
            xb_add(&bar[XB_XGEN(b.x)], 1u);
            asm volatile("s_waitcnt vmcnt(0)" ::: "memory");
        } else {
            XB_SPIN(xb_ld(&bar[XB_XGEN(b.x)]) == gen, bar);
            __builtin_amdgcn_fence(__ATOMIC_ACQUIRE, "agent");
            asm volatile("s_waitcnt vmcnt(0)" ::: "memory");
        }
    }
    __syncthreads();
}

namespace attn_body {
using bf16x8=__attribute__((ext_vector_type(8)))short;
using s16x4=__attribute__((ext_vector_type(4)))short;
using f32x16=__attribute__((ext_vector_type(16)))float;
using f32x4a=__attribute__((ext_vector_type(4)))float;
using u32x4=__attribute__((ext_vector_type(4)))unsigned;
constexpr int PQ=3072;
constexpr int NW=8,QBLK=32,QB=QBLK*NW,KVBLK=64;
__device__ __forceinline__ int crow(int r,int hi){return (r&3)+8*(r>>2)+4*hi;}
#define SBAR() __builtin_amdgcn_sched_barrier(0)
__device__ __forceinline__ void cmask(f32x16&p0,f32x16&p1,int jb,int qrel,int hi){
  const float NEG=-INFINITY; int kb=64*jb+4*hi;
  #pragma unroll
  for(int r=0;r<16;++r){int kv=kb+(r&3)+8*(r>>2); if(kv>qrel)p0[r]=NEG; if(kv+32>qrel)p1[r]=NEG;}
}
constexpr int NSLOT=3, SLOTB=8192;
constexpr int LDS_K=0, LDS_V=NSLOT*SLOTB, LDS_WS=2*NSLOT*SLOTB, LDS_OST=LDS_WS+NW*64*4, LDS_BYTES=LDS_OST+NW*4096;
constexpr int LDS_TAB=86016, LDS_ZERO=LDS_TAB+32768;
__device__ __forceinline__ void glds16(const void*gsrc,unsigned lds_dst){unsigned keep;
  asm volatile("s_mov_b32 %0, m0\n\ts_mov_b32 m0, %2\n\ts_nop 0\n\tglobal_load_lds_dwordx4 %1, off\n\ts_mov_b32 m0, %0":"=&s"(keep):"v"(gsrc),"s"(lds_dst):"memory");}
typedef float f32x2_t __attribute__((ext_vector_type(2))); typedef __bf16 bf16x2_t __attribute__((ext_vector_type(2)));
__device__ __forceinline__ unsigned cvtpk_s(float lo,float hi){f32x2_t v={lo,hi};bf16x2_t b=__builtin_convertvector(v,bf16x2_t);return __builtin_bit_cast(unsigned,b);}
#define WAIT_BAR(N) asm volatile("s_waitcnt vmcnt(" #N ") lgkmcnt(0)\n\ts_barrier":::"memory")
typedef __attribute__((address_space(3))) const char* lds_cptr;
typedef short v4i16_t __attribute__((ext_vector_type(4)));
__device__ __forceinline__ void kload8(bf16x8*kf,lds_cptr kp){
  kf[0]=*(const __attribute__((address_space(3))) bf16x8*)(kp);      kf[1]=*(const __attribute__((address_space(3))) bf16x8*)(kp+512);
  kf[2]=*(const __attribute__((address_space(3))) bf16x8*)(kp+2048); kf[3]=*(const __attribute__((address_space(3))) bf16x8*)(kp+2560);
  kf[4]=*(const __attribute__((address_space(3))) bf16x8*)(kp+4096); kf[5]=*(const __attribute__((address_space(3))) bf16x8*)(kp+4608);
  kf[6]=*(const __attribute__((address_space(3))) bf16x8*)(kp+6144); kf[7]=*(const __attribute__((address_space(3))) bf16x8*)(kp+6656);
}
__device__ __forceinline__ void kload2(bf16x8*kf,lds_cptr kp,int j){ kf[2*j]=*(const __attribute__((address_space(3))) bf16x8*)(kp+j*2048); kf[2*j+1]=*(const __attribute__((address_space(3))) bf16x8*)(kp+j*2048+512); }
__device__ __forceinline__ s16x4 vtr(lds_cptr p){ return __builtin_bit_cast(s16x4,__builtin_amdgcn_ds_read_tr16_b64_v4i16((__attribute__((address_space(3))) v4i16_t*)p)); }
__device__ __forceinline__ void pv(f32x16*o,int vb,bf16x8 pa0,bf16x8 pa1,bf16x8 pa2,bf16x8 pa3){
  #pragma unroll
  for(int d0=0;d0<2;++d0){s16x4 lo[4],hi[4];
    #pragma unroll
    for(int ks=0;ks<4;++ks){
      asm volatile("ds_read_b64_tr_b16 %0,%1 offset:%c2":"=&v"(lo[ks]):"v"(vb),"i"(d0*4096+ks*1024):"memory");
      asm volatile("ds_read_b64_tr_b16 %0,%1 offset:%c2":"=&v"(hi[ks]):"v"(vb),"i"(d0*4096+ks*1024+512):"memory");}
    asm volatile("s_waitcnt lgkmcnt(0)":::"memory");SBAR();
    #define PK(k) (bf16x8){lo[k][0],lo[k][1],lo[k][2],lo[k][3],hi[k][0],hi[k][1],hi[k][2],hi[k][3]}
    o[d0]=__builtin_amdgcn_mfma_f32_32x32x16_bf16(pa0,PK(0),o[d0],0,0,0);
    o[d0]=__builtin_amdgcn_mfma_f32_32x32x16_bf16(pa1,PK(1),o[d0],0,0,0);
    o[d0]=__builtin_amdgcn_mfma_f32_32x32x16_bf16(pa2,PK(2),o[d0],0,0,0);
    o[d0]=__builtin_amdgcn_mfma_f32_32x32x16_bf16(pa3,PK(3),o[d0],0,0,0);
    #undef PK
  }
}
typedef __attribute__((address_space(3))) const float* lds_fptr;
__device__ __forceinline__ void split3(float x,unsigned&h,unsigned&m,unsigned&l){ h=f2bf(x); const float r1=x-__builtin_bit_cast(float,h<<16); m=f2bf(r1); const float r2=r1-__builtin_bit_cast(float,m<<16); l=f2bf(r2); }
__device__ __forceinline__ bf16x8 mk_qm(float mhat,int hi){ unsigned h,m,l; split3(-mhat,h,m,l);
  u32x4 w; w[0]=0x3F803F80u; w[1]=0x3F80u|(h<<16); w[2]=m|(l<<16); w[3]=0u; if(hi){w[0]=0u;w[1]=0u;w[2]=0u;} return __builtin_bit_cast(bf16x8,w); }
__device__ __forceinline__ void bias_add(f32x16&X0,f32x16&X1,lds_fptr tb,int t){
  const lds_fptr p=tb+64*t;
  #pragma unroll
  for(int r=0;r<16;++r){ X0[r]+=p[(r&3)+8*(r>>2)]; X1[r]+=p[32+(r&3)+8*(r>>2)]; }
}
#ifndef ATTN_STORE16
#define ATTN_STORE16(p,v) (*(u32x4*)(p)=(v))
#endif
template<int THRL,int MODE,int PO> __device__ __forceinline__ void attn_unit(int q0,int NTp,const bf16*Q,const bf16*__restrict__ K,const bf16*__restrict__ V,bf16*O,char*shm){
  int tid=threadIdx.x; asm volatile("":"+v"(tid));
  const int lane=tid&63,r32=lane&31,hi=lane>>5; const int wid=__builtin_amdgcn_readfirstlane(tid>>6);
  const bf16*Qw=Q+(long)(q0+wid*QBLK)*PQ;
  const unsigned lds0=(unsigned)(uintptr_t)shm;
  float*wsf=(float*)(shm+LDS_WS)+wid*64;
  const bf16*ksrc=K+(long)lane*PQ+wid*8;
  const bf16*vsrc=V+(long)(16*(wid&3)+(lane>>2))*PQ+(wid>>2)*32+(lane&3)*8;
  const unsigned kdst=lds0+LDS_K+wid*1024, vdst=lds0+LDS_V+wid*1024;
  #define DMA_K(t,slot) glds16(ksrc+(long)(t)*KVBLK*PQ,(unsigned)__builtin_amdgcn_readfirstlane(kdst+(slot)))
  #define DMA_V(t,slot) glds16(vsrc+(long)(t)*KVBLK*PQ,(unsigned)__builtin_amdgcn_readfirstlane(vdst+(slot)))
  const int vb0=(int)(lds0+LDS_V)+((lane>>4)&1)*32+(lane&3)*8+(4*hi+((lane&15)>>2))*64;
  bf16x8 kf[8];
  const lds_cptr shm3=(lds_cptr)shm; const lds_cptr kp0=shm3+LDS_K+hi*1024+r32*16; const lds_cptr vp0=shm3+LDS_V+((lane>>4)&1)*32+(lane&3)*8+(4*hi+((lane&15)>>2))*64;
  const int qrel=wid*QBLK+r32;
  const lds_fptr tb=(lds_fptr)(shm3+LDS_TAB)+(2047-(q0+qrel))+4*hi;
  const lds_cptr kbp=hi?(shm3+LDS_ZERO-16*64*0):(shm3+LDS_TAB+16*r32);
  const int kbs=hi?0:1024;
  bf16x8 kb0,kb1;
  { u32x4 w; w[0]=0u; w[1]=hi?0u:0x3F800000u; w[2]=hi?0u:0x3F803F80u; w[3]=0u; kb0=__builtin_bit_cast(bf16x8,w); kb1=kb0; }
  #define KBLD(t) do{ if(MODE==0){ kb0=*(const __attribute__((address_space(3))) bf16x8*)(kbp+(t)*kbs); kb1=*(const __attribute__((address_space(3))) bf16x8*)(kbp+(t)*kbs+(hi?0:512)); } }while(0)
  bf16x8 qm=mk_qm(0.f,hi);
  const int NT=NTp;
  DMA_K(0,0);DMA_V(0,0);DMA_K(1,SLOTB);
  bf16x8 qr[4];
  #pragma unroll
  for(int d0=0;d0<4;++d0)qr[d0]=*reinterpret_cast<const bf16x8*>(&Qw[(long)r32*PQ+d0*16+hi*8]);
  float mhat=0.f,l_reg=0.f;f32x16 o[2];o[0]=f32x16{};o[1]=f32x16{};
  #define CMASK(P0,P1,t) do{int jb_=(t)-(NT-4); if(jb_>=0)cmask(P0,P1,jb_,qrel,hi);}while(0)
  bool resc=false;
  #define RESC() do{ if(resc){ asm volatile("s_waitcnt lgkmcnt(0)":::"memory"); \
      _Pragma("unroll") for(int d_=0;d_<2;++d_) _Pragma("unroll") for(int r=0;r<16;++r)o[d_][r]*=wsf[crow(r,hi)]; } }while(0)
  f32x16 pA0,pA1,pB0,pB1;
  int sl_prev=0,sl_cur=0,sl_next=SLOTB;
  #define ROT() do{sl_prev=sl_cur;sl_cur=sl_next;sl_next=(sl_next==(NSLOT-1)*SLOTB)?0:sl_next+SLOTB;}while(0)
  DMA_K(2,2*SLOTB);
  KBLD(0);
  WAIT_BAR(3);
  { const lds_cptr kb=kp0; const f32x16 z16=f32x16{};
    pA0=__builtin_amdgcn_mfma_f32_32x32x16_bf16(kb0,qm,z16,0,0,0); pA1=__builtin_amdgcn_mfma_f32_32x32x16_bf16(kb1,qm,z16,0,0,0);
    #pragma unroll
    for(int d0=0;d0<4;++d0){ const bf16x8 b0=*(const __attribute__((address_space(3))) bf16x8*)(kb+d0*2048), b1=*(const __attribute__((address_space(3))) bf16x8*)(kb+d0*2048+512);
      pA0=__builtin_amdgcn_mfma_f32_32x32x16_bf16(b0,qr[d0],pA0,0,0,0); pA1=__builtin_amdgcn_mfma_f32_32x32x16_bf16(b1,qr[d0],pA1,0,0,0); } }
  if(MODE==1&&NT<=6)bias_add(pA0,pA1,tb,0);
  CMASK(pA0,pA1,0);
  { float rm=fmaxf(pA0[0],pA1[0]);
    #pragma unroll
    for(int r=1;r<16;++r)rm=fmaxf(rm,fmaxf(pA0[r],pA1[r]));
    { auto rr=__builtin_amdgcn_permlane32_swap(__float_as_uint(rm),__float_as_uint(rm),false,false); rm=fmaxf(__uint_as_float(rr[0]),__uint_as_float(rr[1])); }
    mhat=rm;
    #pragma unroll
    for(int r=0;r<16;++r){pA0[r]=__builtin_amdgcn_exp2f(pA0[r]-rm);pA1[r]=__builtin_amdgcn_exp2f(pA1[r]-rm);} }
  qm=mk_qm(mhat,hi); KBLD(1);
  WAIT_BAR(0);
  DMA_K(3,0);DMA_V(1,SLOTB);
  ROT();
  kload8(kf,kp0+sl_cur);
  WAIT_BAR(2);
  s16x4 vlo[8],vhi[8]; u32x4 pw0,pw1,pw2,pw3;
  #define PKW(P,B) cvtpk_s(P[B],P[B+1])
  #define PAF(k) __builtin_bit_cast(bf16x8,pw##k)
  #define VFR(i) (bf16x8){vlo[i][0],vlo[i][1],vlo[i][2],vlo[i][3],vhi[i][0],vhi[i][1],vhi[i][2],vhi[i][3]}
  #define PIN(x) asm volatile("":"+v"(x))
  #define MX3(a,b,c) __builtin_fmaxf(__builtin_fmaxf((a),(b)),(c))
  #define GAPA(MF,A0,A1,A2,A3,W0,W1,PW) do{ MF; sacc+=A0; sacc+=A1; sacc+=A2; sacc+=A3; PIN(sacc); W0; W1; PIN(PW); SBAR(); }while(0)
  #define EX(v) __builtin_amdgcn_exp2f(v)
  #define GAPB(MF,X,B) do{ MF; X[B]=EX(X[B]); X[B+1]=EX(X[B+1]); X[B+2]=EX(X[B+2]); X[B+3]=EX(X[B+3]); PIN(X); SBAR(); }while(0)
  #define VRD(i) do{ vlo[i]=vtr(vp_+(((i)>>2)*4096+((i)&3)*1024)); vhi[i]=vtr(vp_+(((i)>>2)*4096+((i)&3)*1024+512)); }while(0)
  #define KRD(G,j) do{ if(G){ kload2(kf,kp0+sl_next,j); SBAR(); } }while(0)
  #define STEP(C0,C1,P0,P1,t,GK,GV,GL,GB) do{ SBAR(); \
    const lds_cptr vp_=vp0+sl_prev; \
    C0=__builtin_amdgcn_mfma_f32_32x32x16_bf16(kb0,qm,f32x16{},0,0,0); C1=__builtin_amdgcn_mfma_f32_32x32x16_bf16(kb1,qm,f32x16{},0,0,0); SBAR(); \
    VRD(0); SBAR(); float sacc=(P0[0]+P0[1]); \
    GAPA(C0=__builtin_amdgcn_mfma_f32_32x32x16_bf16(kf[0],qr[0],C0,0,0,0), P0[2],P0[3],P0[4],P0[5],     pw0[0]=PKW(P0,0), pw0[1]=PKW(P0,2), pw0); \
    VRD(4); SBAR(); GAPA(C1=__builtin_amdgcn_mfma_f32_32x32x16_bf16(kf[1],qr[0],C1,0,0,0), P0[6],P0[7],P0[8],P0[9],     pw0[2]=PKW(P0,4), pw0[3]=PKW(P0,6), pw0); \
    VRD(1); SBAR(); GAPA(C0=__builtin_amdgcn_mfma_f32_32x32x16_bf16(kf[2],qr[1],C0,0,0,0),   P0[10],P0[11],P0[12],P0[13], pw1[0]=PKW(P0,8), pw1[1]=PKW(P0,10), pw1); \
    VRD(5); SBAR(); GAPA(C1=__builtin_amdgcn_mfma_f32_32x32x16_bf16(kf[3],qr[1],C1,0,0,0),   P0[14],P0[15],P1[0],P1[1],   pw1[2]=PKW(P0,12),pw1[3]=PKW(P0,14), pw1); \
    VRD(2); SBAR(); GAPA(C0=__builtin_amdgcn_mfma_f32_32x32x16_bf16(kf[4],qr[2],C0,0,0,0),   P1[2],P1[3],P1[4],P1[5],     pw2[0]=PKW(P1,0), pw2[1]=PKW(P1,2), pw2); \
    VRD(6); SBAR(); GAPA(C1=__builtin_amdgcn_mfma_f32_32x32x16_bf16(kf[5],qr[2],C1,0,0,0),   P1[6],P1[7],P1[8],P1[9],     pw2[2]=PKW(P1,4), pw2[3]=PKW(P1,6), pw2); \
    VRD(3); SBAR(); GAPA(C0=__builtin_amdgcn_mfma_f32_32x32x16_bf16(kf[6],qr[3],C0,0,0,0),   P1[10],P1[11],P1[12],P1[13], pw3[0]=PKW(P1,8), pw3[1]=PKW(P1,10), pw3); \
    VRD(7); SBAR(); GAPA(C1=__builtin_amdgcn_mfma_f32_32x32x16_bf16(kf[7],qr[3],C1,0,0,0),   P1[14],P1[15],0.f,0.f,       pw3[2]=PKW(P1,12),pw3[3]=PKW(P1,14), pw3); \
    l_reg+=sacc; \
    if(GK){DMA_K((t)+3,sl_cur);} if(GV){DMA_V((t)+1,sl_next);} \
    BADD(C0,C1,t); CMASK(C0,C1,t); \
    { float a=MX3(C0[0],C0[1],C1[0]),b=MX3(C0[2],C0[3],C1[1]); a=MX3(a,C1[2],C1[3]); \
      _Pragma("unroll") for(int r=4;r<16;r+=4){a=MX3(a,C0[r],C0[r+1]);b=MX3(b,C0[r+2],C0[r+3]);a=MX3(a,C1[r],C1[r+1]);b=MX3(b,C1[r+2],C1[r+3]);} \
      float rm=__builtin_fmaxf(a,b); { auto rr=__builtin_amdgcn_permlane32_swap(__float_as_uint(rm),__float_as_uint(rm),false,false); rm=__builtin_fmaxf(__uint_as_float(rr[0]),__uint_as_float(rr[1])); } \
      resc=false; \
      if(__builtin_expect(__any(rm>(float)THRL),0)){ const float dl=__builtin_fmaxf(rm,0.f); mhat+=dl; \
        _Pragma("unroll") for(int r=0;r<16;++r){C0[r]-=dl;C1[r]-=dl;} \
        qm=mk_qm(mhat,hi); \
        const float f=__builtin_amdgcn_exp2f(-dl); l_reg*=f; if(hi==0)wsf[r32]=f; resc=true; } } \
    SBAR(); \
    GAPB(o[0]=__builtin_amdgcn_mfma_f32_32x32x16_bf16(PAF(0),VFR(0),o[0],0,0,0), C0,0); \
    GAPB(o[1]=__builtin_amdgcn_mfma_f32_32x32x16_bf16(PAF(0),VFR(4),o[1],0,0,0), C0,4); \
    if(GL){KBLD((t)+1);} KRD(GL,0); GAPB(o[0]=__builtin_amdgcn_mfma_f32_32x32x16_bf16(PAF(1),VFR(1),o[0],0,0,0), C0,8); \
    KRD(GL,1); GAPB(o[1]=__builtin_amdgcn_mfma_f32_32x32x16_bf16(PAF(1),VFR(5),o[1],0,0,0), C0,12); \
    KRD(GL,2); GAPB(o[0]=__builtin_amdgcn_mfma_f32_32x32x16_bf16(PAF(2),VFR(2),o[0],0,0,0), C1,0); \
    KRD(GL,3); GAPB(o[1]=__builtin_amdgcn_mfma_f32_32x32x16_bf16(PAF(2),VFR(6),o[1],0,0,0), C1,4); \
    GAPB(o[0]=__builtin_amdgcn_mfma_f32_32x32x16_bf16(PAF(3),VFR(3),o[0],0,0,0), C1,8); \
    GAPB(o[1]=__builtin_amdgcn_mfma_f32_32x32x16_bf16(PAF(3),VFR(7),o[1],0,0,0), C1,12); \
    }while(0)
  int t=1;
  #undef CMASK
  #define CMASK(P0,P1,t) do{}while(0)
  #define BADD(P0,P1,t) do{}while(0)
  for(;t+(MODE==1?7:5)<NT;t+=2){
    STEP(pB0,pB1,pA0,pA1,t,true,true,true,true);     WAIT_BAR(2); RESC(); ROT();
    STEP(pA0,pA1,pB0,pB1,t+1,true,true,true,true);   WAIT_BAR(2); RESC(); ROT();
  }
  #undef CMASK
  #undef BADD
  #define CMASK(P0,P1,t) do{int jb_=(t)-(NT-4); if(jb_>=0)cmask(P0,P1,jb_,qrel,hi);}while(0)
  #define BADD(P0,P1,t) do{ if(MODE==1&&(t)>=NT-6)bias_add(P0,P1,tb,t); }while(0)
  #define ENDW(tt) do{ if((tt)+3<NT){WAIT_BAR(2);} else if((tt)+2<NT){WAIT_BAR(1);} else {WAIT_BAR(0);} }while(0)
  for(;t+1<NT;t+=2){
    STEP(pB0,pB1,pA0,pA1,t,(t+3<NT),(t+1<NT),(t+1<NT),(t+1<NT));       ENDW(t);   RESC(); ROT();
    STEP(pA0,pA1,pB0,pB1,t+1,(t+4<NT),(t+2<NT),(t+2<NT),(t+2<NT));     ENDW(t+1); RESC(); ROT();
  }
  STEP(pB0,pB1,pA0,pA1,NT-1,false,false,false,false); RESC();
  { float sacc=pB0[0]+pB0[1]; _Pragma("unroll") for(int r=2;r<16;++r)sacc+=pB0[r]; _Pragma("unroll") for(int r=0;r<16;++r)sacc+=pB1[r]; l_reg+=sacc;
    pw0=(u32x4){PKW(pB0,0),PKW(pB0,2),PKW(pB0,4),PKW(pB0,6)};pw1=(u32x4){PKW(pB0,8),PKW(pB0,10),PKW(pB0,12),PKW(pB0,14)};pw2=(u32x4){PKW(pB1,0),PKW(pB1,2),PKW(pB1,4),PKW(pB1,6)};pw3=(u32x4){PKW(pB1,8),PKW(pB1,10),PKW(pB1,12),PKW(pB1,14)};
    SBAR(); pv(o,vb0+sl_cur,PAF(0),PAF(1),PAF(2),PAF(3)); }
  #undef PKW
  #undef PAF
  #undef VFR
  #undef PIN
  #undef MX3
  #undef GAPA
  #undef GAPB
  #undef EX
  #undef VRD
  #undef KRD
  #undef BADD
  #undef STEP
  #undef ENDW
  {auto rr=__builtin_amdgcn_permlane32_swap(__float_as_uint(l_reg),__float_as_uint(l_reg),false,false);l_reg=__uint_as_float(rr[0])+__uint_as_float(rr[1]);}
  if(hi==0)wsf[32+r32]=l_reg;asm volatile("s_waitcnt lgkmcnt(0)":::"memory");
  float rli[16];
  #pragma unroll
  for(int r=0;r<16;++r)rli[r]=__builtin_amdgcn_rcpf(wsf[32+crow(r,hi)]);
  bf16*Ow=O+(long)(q0+wid*QBLK)*PO;
  { bf16*stg=(bf16*)(shm+LDS_OST)+wid*2048;
    #pragma unroll
    for(int r=0;r<16;++r){const int orow=crow(r,hi);
      #pragma unroll
      for(int d0=0;d0<2;++d0)stg[orow*64+d0*32+r32]=(bf16)f2bf(o[d0][r]*rli[r]);}
    asm volatile("s_waitcnt lgkmcnt(0)":::"memory");
    unsigned char*Ow8=(unsigned char*)O+(long)(q0+wid*QBLK)*PO;
    (void)Ow;
    #pragma unroll
    for(int i=0;i<4;++i){const int row=i*8+(lane>>3),ch=lane&7; const u32x4 v=*(const u32x4*)(stg+row*64+ch*8);
      typedef unsigned u32x2o __attribute__((ext_vector_type(2))); u32x2o w8;
      #define F8LO(x) __builtin_bit_cast(float,(x)<<16)
      #define F8HI(x) __builtin_bit_cast(float,(x)&0xffff0000u)
      { int t_=__builtin_amdgcn_cvt_pk_fp8_f32(F8LO(v[0]),F8HI(v[0]),0,false); t_=__builtin_amdgcn_cvt_pk_fp8_f32(F8LO(v[1]),F8HI(v[1]),t_,true); w8[0]=(unsigned)t_; }
      { int t_=__builtin_amdgcn_cvt_pk_fp8_f32(F8LO(v[2]),F8HI(v[2]),0,false); t_=__builtin_amdgcn_cvt_pk_fp8_f32(F8LO(v[3]),F8HI(v[3]),t_,true); w8[1]=(unsigned)t_; }
      #undef F8LO
      #undef F8HI
      *(u32x2o*)(Ow8+(long)row*PO+ch*8)=w8;} }
  asm volatile("s_waitcnt lgkmcnt(0)\n\ts_barrier":::"memory");
  #undef DMA_K
  #undef DMA_V
  #undef CMASK
  #undef RESC
  #undef ROT
}
__device__ __forceinline__ void pv128(f32x16*o,int vb,bf16x8 pa0,bf16x8 pa1,bf16x8 pa2,bf16x8 pa3){
  #pragma unroll
  for(int d0=0;d0<4;++d0){s16x4 lo[4],hi[4];
    #pragma unroll
    for(int ks=0;ks<4;++ks){
      asm volatile("ds_read_b64_tr_b16 %0,%1 offset:%c2":"=&v"(lo[ks]):"v"(vb),"i"(d0*4096+ks*1024):"memory");
      asm volatile("ds_read_b64_tr_b16 %0,%1 offset:%c2":"=&v"(hi[ks]):"v"(vb),"i"(d0*4096+ks*1024+512):"memory");}
    asm volatile("s_waitcnt lgkmcnt(0)":::"memory");SBAR();
    #define PK(k) (bf16x8){lo[k][0],lo[k][1],lo[k][2],lo[k][3],hi[k][0],hi[k][1],hi[k][2],hi[k][3]}
    o[d0]=__builtin_amdgcn_mfma_f32_32x32x16_bf16(pa0,PK(0),o[d0],0,0,0);
    o[d0]=__builtin_amdgcn_mfma_f32_32x32x16_bf16(pa1,PK(1),o[d0],0,0,0);
    o[d0]=__builtin_amdgcn_mfma_f32_32x32x16_bf16(pa2,PK(2),o[d0],0,0,0);
    o[d0]=__builtin_amdgcn_mfma_f32_32x32x16_bf16(pa3,PK(3),o[d0],0,0,0);
    #undef PK
  }
}
constexpr int L8_K=0, L8_V=24576, L8_WS=73728, L8_TAB=75776, SLOTBV=16384;
template<int THRL,int STG_OFF> __device__ __forceinline__ void attn_unit128(int q0,const bf16*Q,const bf16*__restrict__ K,const bf16*__restrict__ V,char*shm){
  int tid=threadIdx.x; asm volatile("":"+v"(tid));
  const int lane=tid&63,r32=lane&31,hi=lane>>5; const int wid=__builtin_amdgcn_readfirstlane(tid>>6);
  const bf16*Qw=Q+(long)(q0+wid*QBLK)*PQ;
  const unsigned lds0=(unsigned)(uintptr_t)shm;
  float*wsf=(float*)(shm+L8_WS)+wid*64;
  const bf16*ksrc=K+(long)lane*PQ+wid*8;
  const bf16*vsrc=V+(long)(16*(wid&3)+(lane>>2))*PQ+(wid>>2)*32+(lane&3)*8;
  const unsigned kdst=lds0+L8_K+wid*1024, vdst=lds0+L8_V+wid*1024;
  #define DMA_K(t,slot) glds16(ksrc+(long)(t)*KVBLK*PQ,(unsigned)__builtin_amdgcn_readfirstlane(kdst+(slot)))
  #define DMA_V(t,slot) do{ glds16(vsrc+(long)(t)*KVBLK*PQ,(unsigned)__builtin_amdgcn_readfirstlane(vdst+2*(slot))); glds16(vsrc+64+(long)(t)*KVBLK*PQ,(unsigned)__builtin_amdgcn_readfirstlane(vdst+2*(slot)+8192)); }while(0)
  const int vb0=(int)(lds0+L8_V)+((lane>>4)&1)*32+(lane&3)*8+(4*hi+((lane&15)>>2))*64;
  bf16x8 kf[8];
  const lds_cptr shm3=(lds_cptr)shm; const lds_cptr kp0=shm3+L8_K+hi*1024+r32*16; const lds_cptr vp0=shm3+L8_V+((lane>>4)&1)*32+(lane&3)*8+(4*hi+((lane&15)>>2))*64;
  const int qrel=wid*QBLK+r32;
  const lds_fptr tb=(lds_fptr)(shm3+L8_TAB)+(2047-(q0+qrel))+4*hi;
  const lds_cptr kbp=hi?(shm3+L8_TAB-16*64*0):(shm3+L8_TAB+16*r32);
  const int kbs=hi?0:1024;
  bf16x8 kb0,kb1;
  { u32x4 w; w[0]=0u; w[1]=hi?0u:0x3F800000u; w[2]=hi?0u:0x3F803F80u; w[3]=0u; kb0=__builtin_bit_cast(bf16x8,w); kb1=kb0; }
  #define KBLD(t) do{ if(false){ kb0=*(const __attribute__((address_space(3))) bf16x8*)(kbp+(t)*kbs); kb1=*(const __attribute__((address_space(3))) bf16x8*)(kbp+(t)*kbs+(hi?0:512)); } }while(0)
  bf16x8 qm=mk_qm(0.f,hi);
  const int NT=(q0+QB)/KVBLK;
  DMA_K(0,0);DMA_V(0,0);DMA_K(1,SLOTB);
  bf16x8 qr[4];
  #pragma unroll
  for(int d0=0;d0<4;++d0)qr[d0]=*reinterpret_cast<const bf16x8*>(&Qw[(long)r32*PQ+d0*16+hi*8]);
  float mhat=0.f,l_reg=0.f;f32x16 o[4];o[0]=f32x16{};o[1]=f32x16{};o[2]=f32x16{};o[3]=f32x16{};
  #define CMASK(P0,P1,t) do{int jb_=(t)-(NT-4); if(jb_>=0)cmask(P0,P1,jb_,qrel,hi);}while(0)
  bool resc=false;
  #define RESC() do{ if(resc){ asm volatile("s_waitcnt lgkmcnt(0)":::"memory"); \
      _Pragma("unroll") for(int d_=0;d_<4;++d_) _Pragma("unroll") for(int r=0;r<16;++r)o[d_][r]*=wsf[crow(r,hi)]; } }while(0)
  f32x16 pA0,pA1,pB0,pB1;
  int sl_prev=0,sl_cur=0,sl_next=SLOTB;
  #define ROT() do{sl_prev=sl_cur;sl_cur=sl_next;sl_next=(sl_next==(NSLOT-1)*SLOTB)?0:sl_next+SLOTB;}while(0)
  DMA_K(2,2*SLOTB);
  KBLD(0);
  WAIT_BAR(4);
  { const lds_cptr kb=kp0; const f32x16 z16=f32x16{};
    pA0=__builtin_amdgcn_mfma_f32_32x32x16_bf16(kb0,qm,z16,0,0,0); pA1=__builtin_amdgcn_mfma_f32_32x32x16_bf16(kb0,qm,z16,0,0,0);
    #pragma unroll
    for(int d0=0;d0<4;++d0){ const bf16x8 b0=*(const __attribute__((address_space(3))) bf16x8*)(kb+d0*2048), b1=*(const __attribute__((address_space(3))) bf16x8*)(kb+d0*2048+512);
      pA0=__builtin_amdgcn_mfma_f32_32x32x16_bf16(b0,qr[d0],pA0,0,0,0); pA1=__builtin_amdgcn_mfma_f32_32x32x16_bf16(b1,qr[d0],pA1,0,0,0); } }
  if(NT<=6)bias_add(pA0,pA1,tb,0);
  CMASK(pA0,pA1,0);
  { float rm=fmaxf(pA0[0],pA1[0]);
    #pragma unroll
    for(int r=1;r<16;++r)rm=fmaxf(rm,fmaxf(pA0[r],pA1[r]));
    { auto rr=__builtin_amdgcn_permlane32_swap(__float_as_uint(rm),__float_as_uint(rm),false,false); rm=fmaxf(__uint_as_float(rr[0]),__uint_as_float(rr[1])); }
    mhat=rm;
    #pragma unroll
    for(int r=0;r<16;++r){pA0[r]=__builtin_amdgcn_exp2f(pA0[r]-rm);pA1[r]=__builtin_amdgcn_exp2f(pA1[r]-rm);} }
  qm=mk_qm(mhat,hi); KBLD(1);
  WAIT_BAR(0);
  DMA_K(3,0);DMA_V(1,SLOTB);
  ROT();
  kload8(kf,kp0+sl_cur);
  WAIT_BAR(3);
  s16x4 V0lo,V0hi,V1lo,V1hi,V2lo,V2hi; u32x4 pw0,pw1,pw2,pw3;
  #define PKW(P,B) cvtpk_s(P[B],P[B+1])
  #define PAF(k) __builtin_bit_cast(bf16x8,pw##k)
  #define PIN(x) asm volatile("":"+v"(x))
  #define MX3(a,b,c) __builtin_fmaxf(__builtin_fmaxf((a),(b)),(c))
  #define GAPA(MF,A0,A1,A2,A3,W0,W1,PW) do{ MF; sacc+=A0; sacc+=A1; sacc+=A2; sacc+=A3; PIN(sacc); W0; W1; PIN(PW); SBAR(); }while(0)
  #define EX(v) __builtin_amdgcn_exp2f(v)
  #define VRDX(S,f) do{ S##lo=vtr(vp_+(((f)>>2)*4096+((f)&3)*1024)); S##hi=vtr(vp_+(((f)>>2)*4096+((f)&3)*1024+512)); }while(0)
  #define VFX(S) (bf16x8){S##lo[0],S##lo[1],S##lo[2],S##lo[3],S##hi[0],S##hi[1],S##hi[2],S##hi[3]}
  #define GAPB(D,KS,SU,SL,FL,X,B) do{ o[D]=__builtin_amdgcn_mfma_f32_32x32x16_bf16(PAF(KS),VFX(SU),o[D],0,0,0); VRDX(SL,FL); X[B]=EX(X[B]); X[B+1]=EX(X[B+1]); PIN(X); SBAR(); }while(0)
  #define GAPBL(D,KS,SU,X,B) do{ o[D]=__builtin_amdgcn_mfma_f32_32x32x16_bf16(PAF(KS),VFX(SU),o[D],0,0,0); X[B]=EX(X[B]); X[B+1]=EX(X[B+1]); PIN(X); SBAR(); }while(0)
  #define KRD(G,j) do{ if(G){ kload2(kf,kp0+sl_next,j); SBAR(); } }while(0)
  #define STEP(C0,C1,P0,P1,t,GK,GV,GL,GB) do{ SBAR(); \
    const lds_cptr vp_=vp0+2*sl_prev; \
    C0=__builtin_amdgcn_mfma_f32_32x32x16_bf16(kb0,qm,f32x16{},0,0,0); C1=__builtin_amdgcn_mfma_f32_32x32x16_bf16(kb0,qm,f32x16{},0,0,0); SBAR(); \
    float sacc=(P0[0]+P0[1]); \
    GAPA(C0=__builtin_amdgcn_mfma_f32_32x32x16_bf16(kf[0],qr[0],C0,0,0,0), P0[2],P0[3],P0[4],P0[5],     pw0[0]=PKW(P0,0), pw0[1]=PKW(P0,2), pw0); \
    GAPA(C1=__builtin_amdgcn_mfma_f32_32x32x16_bf16(kf[1],qr[0],C1,0,0,0), P0[6],P0[7],P0[8],P0[9],     pw0[2]=PKW(P0,4), pw0[3]=PKW(P0,6), pw0); \
    KRD(GL,0); GAPA(C0=__builtin_amdgcn_mfma_f32_32x32x16_bf16(kf[2],qr[1],C0,0,0,0),   P0[10],P0[11],P0[12],P0[13], pw1[0]=PKW(P0,8), pw1[1]=PKW(P0,10), pw1); \
    GAPA(C1=__builtin_amdgcn_mfma_f32_32x32x16_bf16(kf[3],qr[1],C1,0,0,0),   P0[14],P0[15],P1[0],P1[1],   pw1[2]=PKW(P0,12),pw1[3]=PKW(P0,14), pw1); \
    KRD(GL,1); GAPA(C0=__builtin_amdgcn_mfma_f32_32x32x16_bf16(kf[4],qr[2],C0,0,0,0),   P1[2],P1[3],P1[4],P1[5],     pw2[0]=PKW(P1,0), pw2[1]=PKW(P1,2), pw2); \
    GAPA(C1=__builtin_amdgcn_mfma_f32_32x32x16_bf16(kf[5],qr[2],C1,0,0,0),   P1[6],P1[7],P1[8],P1[9],     pw2[2]=PKW(P1,4), pw2[3]=PKW(P1,6), pw2); \
    KRD(GL,2); GAPA(C0=__builtin_amdgcn_mfma_f32_32x32x16_bf16(kf[6],qr[3],C0,0,0,0),   P1[10],P1[11],P1[12],P1[13], pw3[0]=PKW(P1,8), pw3[1]=PKW(P1,10), pw3); \
    GAPA(C1=__builtin_amdgcn_mfma_f32_32x32x16_bf16(kf[7],qr[3],C1,0,0,0),   P1[14],P1[15],0.f,0.f,       pw3[2]=PKW(P1,12),pw3[3]=PKW(P1,14), pw3); \
    KRD(GL,3); VRDX(V0,0); VRDX(V1,4); SBAR(); \
    l_reg+=sacc; \
    if(GK){DMA_K((t)+3,sl_cur);} if(GV){DMA_V((t)+1,sl_next);} \
    BADD(C0,C1,t); CMASK(C0,C1,t); \
    { float a=MX3(C0[0],C0[1],C1[0]),b=MX3(C0[2],C0[3],C1[1]); a=MX3(a,C1[2],C1[3]); \
      _Pragma("unroll") for(int r=4;r<16;r+=4){a=MX3(a,C0[r],C0[r+1]);b=MX3(b,C0[r+2],C0[r+3]);a=MX3(a,C1[r],C1[r+1]);b=MX3(b,C1[r+2],C1[r+3]);} \
      float rm=__builtin_fmaxf(a,b); { auto rr=__builtin_amdgcn_permlane32_swap(__float_as_uint(rm),__float_as_uint(rm),false,false); rm=__builtin_fmaxf(__uint_as_float(rr[0]),__uint_as_float(rr[1])); } \
      resc=false; \
      if(__builtin_expect(__any(rm>(float)THRL),0)){ const float dl=__builtin_fmaxf(rm,0.f); mhat+=dl; \
        _Pragma("unroll") for(int r=0;r<16;++r){C0[r]-=dl;C1[r]-=dl;} \
        qm=mk_qm(mhat,hi); \
        const float f=__builtin_amdgcn_exp2f(-dl); l_reg*=f; if(hi==0)wsf[r32]=f; resc=true; } } \
    SBAR(); \
    GAPB(0,0,V0,V2,8, C0,0);  GAPB(1,0,V1,V0,12,C0,2);  GAPB(2,0,V2,V1,1, C0,4);  GAPB(3,0,V0,V2,5, C0,6); \
    GAPB(0,1,V1,V0,9, C0,8);  GAPB(1,1,V2,V1,13,C0,10); GAPB(2,1,V0,V2,2, C0,12); GAPB(3,1,V1,V0,6, C0,14); \
    GAPB(0,2,V2,V1,10,C1,0);  GAPB(1,2,V0,V2,14,C1,2);  GAPB(2,2,V1,V0,3, C1,4);  GAPB(3,2,V2,V1,7, C1,6); \
    GAPB(0,3,V0,V2,11,C1,8);  GAPB(1,3,V1,V0,15,C1,10); GAPBL(2,3,V2,C1,12);      GAPBL(3,3,V0,C1,14); \
    }while(0)
  int t=1;
  #undef CMASK
  #define CMASK(P0,P1,t) do{}while(0)
  #define BADD(P0,P1,t) do{}while(0)
  for(;t+(7)<NT;t+=2){
    STEP(pB0,pB1,pA0,pA1,t,true,true,true,true);     WAIT_BAR(3); RESC(); ROT();
    STEP(pA0,pA1,pB0,pB1,t+1,true,true,true,true);   WAIT_BAR(3); RESC(); ROT();
  }
  #undef CMASK
  #undef BADD
  #define CMASK(P0,P1,t) do{int jb_=(t)-(NT-4); if(jb_>=0)cmask(P0,P1,jb_,qrel,hi);}while(0)
  #define BADD(P0,P1,t) do{ if((t)>=NT-6)bias_add(P0,P1,tb,t); }while(0)
  #define ENDW(tt) do{ if((tt)+3<NT){WAIT_BAR(3);} else if((tt)+2<NT){WAIT_BAR(2);} else {WAIT_BAR(0);} }while(0)
  for(;t+1<NT;t+=2){
    STEP(pB0,pB1,pA0,pA1,t,(t+3<NT),(t+1<NT),(t+1<NT),(t+1<NT));       ENDW(t);   RESC(); ROT();
    STEP(pA0,pA1,pB0,pB1,t+1,(t+4<NT),(t+2<NT),(t+2<NT),(t+2<NT));     ENDW(t+1); RESC(); ROT();
  }
  STEP(pB0,pB1,pA0,pA1,NT-1,false,false,false,false); RESC();
  { float sacc=pB0[0]+pB0[1]; _Pragma("unroll") for(int r=2;r<16;++r)sacc+=pB0[r]; _Pragma("unroll") for(int r=0;r<16;++r)sacc+=pB1[r]; l_reg+=sacc;
    pw0=(u32x4){PKW(pB0,0),PKW(pB0,2),PKW(pB0,4),PKW(pB0,6)};pw1=(u32x4){PKW(pB0,8),PKW(pB0,10),PKW(pB0,12),PKW(pB0,14)};pw2=(u32x4){PKW(pB1,0),PKW(pB1,2),PKW(pB1,4),PKW(pB1,6)};pw3=(u32x4){PKW(pB1,8),PKW(pB1,10),PKW(pB1,12),PKW(pB1,14)};
    SBAR(); pv128(o,vb0+2*sl_cur,PAF(0),PAF(1),PAF(2),PAF(3)); }
  #undef PKW
  #undef PAF
  #undef VFX
  #undef VRDX
  #undef GAPBL
  #undef PIN
  #undef MX3
  #undef GAPA
  #undef GAPB
  #undef EX
  #undef KRD
  #undef BADD
  #undef STEP
  #undef ENDW
  {auto rr=__builtin_amdgcn_permlane32_swap(__float_as_uint(l_reg),__float_as_uint(l_reg),false,false);l_reg=__uint_as_float(rr[0])+__uint_as_float(rr[1]);}
  if(hi==0)wsf[32+r32]=l_reg;asm volatile("s_waitcnt lgkmcnt(0)":::"memory");
  float rli[16];
  #pragma unroll
  for(int r=0;r<16;++r)rli[r]=__builtin_amdgcn_rcpf(wsf[32+crow(r,hi)]);
  asm volatile("s_waitcnt lgkmcnt(0)\n\ts_barrier":::"memory");
  { bf16*stg=(bf16*)(shm+STG_OFF)+wid*4096;
    #pragma unroll
    for(int r=0;r<16;++r){const int orow=crow(r,hi);
      #pragma unroll
      for(int d0=0;d0<4;++d0)stg[orow*128+d0*32+r32]=(bf16)f2bf(o[d0][r]*rli[r]);} }
  asm volatile("s_waitcnt lgkmcnt(0)\n\ts_barrier":::"memory");
  #undef DMA_K
  #undef DMA_V
  #undef CMASK
  #undef RESC
  #undef ROT
}
#undef SBAR
#undef WAIT_BAR
}

typedef float f32x16 __attribute__((ext_vector_type(16)));
typedef short s16x4 __attribute__((ext_vector_type(4)));
typedef unsigned u32x2v __attribute__((ext_vector_type(2)));
typedef float f32x2t __attribute__((ext_vector_type(2)));
struct Args { const float* in[26]; float* out; unsigned char* ws; int ph_lo, ph_hi; };
#define KARG ((const __attribute__((address_space(4))) Args*)__builtin_amdgcn_kernarg_segment_ptr())
#define FRESH(F) do { int t_ = threadIdx.x; asm volatile("" : "+v"(t_)); (F).tid = t_; (F).lane = t_ & 63; (F).wave = __builtin_amdgcn_readfirstlane(t_ >> 6); } while (0)
struct Frame {
    LAS unsigned char* lds;
    volatile LAS unsigned* MISC;
    gu32* ctl;
    int tid, lane, wave;
    int vcu, G;
    unsigned char* ws;
    float* out;
};
__device__ __forceinline__ float wave_sum(float v) {
#pragma unroll
    for (int o = 1; o < 64; o <<= 1) v += __shfl_xor(v, o);
    return v;
}
__device__ __forceinline__ float bf2f(unsigned short b) { return __builtin_bit_cast(float, (unsigned)b << 16); }
__device__ __forceinline__ float bflo(unsigned w) { return __builtin_bit_cast(float, w << 16); }
__device__ __forceinline__ float bfhi(unsigned w) { return __builtin_bit_cast(float, w & 0xffff0000u); }
__device__ __forceinline__ int crow(int r, int hi) { return (r & 3) + 8 * (r >> 2) + 4 * hi; }
__device__ __forceinline__ unsigned pk4_fp8_nc(float a, float b, float c, float d) { int w = __builtin_amdgcn_cvt_pk_fp8_f32(a, b, 0, false); w = __builtin_amdgcn_cvt_pk_fp8_f32(c, d, w, true); return (unsigned)w; }
__device__ __forceinline__ unsigned pk4_fp8(float a, float b, float c, float d) {
    a = __builtin_amdgcn_fmed3f(a, -448.f, 448.f); b = __builtin_amdgcn_fmed3f(b, -448.f, 448.f); c = __builtin_amdgcn_fmed3f(c, -448.f, 448.f); d = __builtin_amdgcn_fmed3f(d, -448.f, 448.f);
    int w = __builtin_amdgcn_cvt_pk_fp8_f32(a, b, 0, false); w = __builtin_amdgcn_cvt_pk_fp8_f32(c, d, w, true); return (unsigned)w; }

constexpr int NPPU = (NTOK / 256) * (D / 256);
struct SchedC {
    static constexpr bool GATHER = false;
    int nM, nN, G, c, K; const char* Bt;
    __device__ __forceinline__ size_t aoff_uniform(const pg8::Unit& u) const { return (size_t)u.pm * 256 * K * 2; }
    __device__ __forceinline__ bool next(int i, pg8::Unit& u) const { u.e = 0; u.lr0 = 0; u.ui = i; return pg8::order_tile((long)i * G + c, nM, nN, u.pm, u.pn); }
    __device__ __forceinline__ const char* bptr(const pg8::Unit& u) const { return Bt + (size_t)u.pn * 256 * K * 2; }
    __device__ __forceinline__ void aoffs(const pg8::Unit& u, const int (&aR)[2], const int (&aC)[2], unsigned (&ao)[2][2]) const {
#pragma unroll
        for (int h = 0; h < 2; ++h)
#pragma unroll
            for (int i = 0; i < 2; ++i) ao[h][i] = (unsigned)((u.pm * 256 + h * 128 + aR[i]) * K + aC[i]) * 2u; }
};
__device__ __forceinline__ LAS unsigned short* lds_tileE(LAS unsigned char* lds) { return (LAS unsigned short*)(lds + TILEE_OFF); }
__device__ __forceinline__ LAS int* lds_tstart(LAS unsigned char* lds) { return (LAS int*)(lds + TILEE_OFF + 1152); }
__device__ __forceinline__ LAS int* lds_cnt(LAS unsigned char* lds) { return (LAS int*)(lds + TILEE_OFF + 1152 + 144); }
template <bool GATHER_, int NN, int NROWS_B  , int KU  >
struct SchedM {
    static constexpr bool GATHER = GATHER_;
    __device__ __forceinline__ size_t aoff_uniform(const pg8::Unit& u) const { return (size_t)u.pm * 256 * KU * 2; }
    int G, c; const char* Bt; LAS unsigned char* lds; int ntile;
    __device__ __forceinline__ bool next(int i, pg8::Unit& u) const {
        if (GATHER && i >= 18) return false;
        if (!pg8::order_tile((long)i * G + c, ntile, NN, u.pm, u.pn)) return false;
        u.e = __builtin_amdgcn_readfirstlane((int)lds_tileE(lds)[u.pm]); u.lr0 = (u.pm - __builtin_amdgcn_readfirstlane(lds_tstart(lds)[u.e])) * 256; u.ui = i; return true; }
    __device__ __forceinline__ const char* bptr(const pg8::Unit& u) const { return Bt + ((size_t)u.e * NROWS_B + (size_t)u.pn * 256) * KU * 2; }
    __device__ __forceinline__ void aoffs(const pg8::Unit& u, const int (&aR)[2], const int (&aC)[2], unsigned (&ao)[2][2]) const {
        const LAS int* tk = (const LAS int*)(lds + TOKL_OFF) + u.ui * 256;
#pragma unroll
        for (int h = 0; h < 2; ++h)
#pragma unroll
            for (int i = 0; i < 2; ++i) {
                if (GATHER) ao[h][i] = (unsigned)(tk[h * 128 + aR[i]] * KU + aC[i]) * 2u;
                else ao[h][i] = (unsigned)((u.pm * 256 + h * 128 + aR[i]) * KU + aC[i]) * 2u; }
    }
};

using pg8::Unit; using pg8::cvt_pk_bf16; using pg8::HALF; using pg8::BM;
struct EpiBf16P {
    static constexpr bool PERM = true, PREFETCH = false;
    unsigned char* O; int ldc;
    __device__ __forceinline__ void operator()(const f32x4 (&acc)[2][2][4][2], const Unit& u, int wr, int wc, int fr, int fq) const {
        const int row0 = u.pm * BM + wr * 64 + fr, col0 = u.pn * BM + wc * 32 + 8 * fq;
#pragma unroll
        for (int ai = 0; ai < 2; ++ai)
#pragma unroll
            for (int m = 0; m < 4; ++m) { unsigned char* rowp = O + (size_t)(row0 + ai * HALF + m * 16) * ldc + col0;
#pragma unroll
                for (int bj = 0; bj < 2; ++bj) { const f32x4 v0 = acc[ai][bj][m][0], v1 = acc[ai][bj][m][1];
                    u32x2v w; w.x = pk4_fp8(v0[0], v0[1], v0[2], v0[3]); w.y = pk4_fp8(v1[0], v1[1], v1[2], v1[3]);
                    *(u32x2v*)(rowp + bj * HALF) = w; }
                __builtin_amdgcn_sched_barrier(0); }
    }
};
struct EpiProj {
    static constexpr bool PERM = true, PREFETCH = false;
    bf16* O; const float *gqf, *gkf, *gqd, *gkd;
    __device__ __forceinline__ void operator()(const f32x4 (&acc)[2][2][4][2], const Unit& u, int wr, int wc, int fr, int fq) const {
        const int seg = u.pn >> 1;
        const float* g = seg == 0 ? gqf : seg == 1 ? gkf : seg == 3 ? gqd : seg == 4 ? gkd : nullptr;
        const float sc = (seg == 0 || seg == 3) ? C2 : 1.0f;
        f32x4 gv[2][2];
#pragma unroll
        for (int bj = 0; bj < 2; ++bj)
#pragma unroll
            for (int n = 0; n < 2; ++n) gv[bj][n] = g ? *(const f32x4*)(g + 32 * bj + 8 * fq + 4 * n) : (f32x4){1.f, 1.f, 1.f, 1.f};
        const int row0 = u.pm * BM + wr * 64 + fr, col0 = u.pn * BM + 64 * wc + 8 * fq;
#pragma unroll
        for (int ai = 0; ai < 2; ++ai)
#pragma unroll
            for (int m = 0; m < 4; ++m) {
                float r = 1.0f;
                if (g) { float ss = 0.f;
#pragma unroll
                    for (int bj = 0; bj < 2; ++bj)
#pragma unroll
                        for (int n = 0; n < 2; ++n) { const f32x4 x = acc[ai][bj][m][n]; ss += (x[0] * x[0] + x[1] * x[1]) + (x[2] * x[2] + x[3] * x[3]); }
                    ss += __shfl_xor(ss, 16); ss += __shfl_xor(ss, 32);
                    r = __builtin_amdgcn_rsqf(ss * (1.0f / 64.0f) + EPS) * sc; }
                bf16* rowp = O + (size_t)(row0 + ai * HALF + m * 16) * NPROJ + col0;
#pragma unroll
                for (int bj = 0; bj < 2; ++bj) { const f32x4 v0 = acc[ai][bj][m][0] * gv[bj][0] * r, v1 = acc[ai][bj][m][1] * gv[bj][1] * r;
                    v4u w; w.x = cvt_pk_bf16(v0[0], v0[1]); w.y = cvt_pk_bf16(v0[2], v0[3]); w.z = cvt_pk_bf16(v1[0], v1[1]); w.w = cvt_pk_bf16(v1[2], v1[3]);
                    *(v4u*)(rowp + 32 * bj) = w; }
                __builtin_amdgcn_sched_barrier(0); }
    }
};
struct EpiRes {
    static constexpr bool PERM = true, PREFETCH = false;
    const float* base; bf16* out;
    __device__ __forceinline__ void operator()(const f32x4 (&acc)[2][2][4][2], const Unit& u, int wr, int wc, int fr, int fq) const {
        const int row0 = u.pm * BM + wr * 64 + fr, col0 = u.pn * BM + wc * 32 + 8 * fq;
#pragma unroll
        for (int ai = 0; ai < 2; ++ai) {
            f32x4 xv[4][2][2];
#pragma unroll
            for (int m = 0; m < 4; ++m) { const size_t off = (size_t)(row0 + ai * HALF + m * 16) * D + col0;
#pragma unroll
                for (int bj = 0; bj < 2; ++bj) { xv[m][bj][0] = *(const f32x4*)(base + off + bj * HALF); xv[m][bj][1] = *(const f32x4*)(base + off + bj * HALF + 4); } }
#pragma unroll
            for (int m = 0; m < 4; ++m) { const size_t off = (size_t)(row0 + ai * HALF + m * 16) * D + col0;
#pragma unroll
                for (int bj = 0; bj < 2; ++bj) { const f32x4 v0 = xv[m][bj][0] + acc[ai][bj][m][0], v1 = xv[m][bj][1] + acc[ai][bj][m][1];
                    v4u w; w.x = cvt_pk_bf16(v0[0], v0[1]); w.y = cvt_pk_bf16(v0[2], v0[3]); w.z = cvt_pk_bf16(v1[0], v1[1]); w.w = cvt_pk_bf16(v1[2], v1[3]);
                    *(v4u*)(out + off + bj * HALF) = w; } }
            __builtin_amdgcn_sched_barrier(0); }
    }
};
struct EpiSwiglu {
    static constexpr bool PERM = true, PREFETCH = true;
    unsigned char* HB; const float* b1p; const float* rsE; LAS unsigned char* lds;
    __device__ __forceinline__ void prefetch(const Unit& u, LAS unsigned char* buf, int wid, int lane) const {
        if (wid == 0) __builtin_amdgcn_global_load_lds((const unsigned*)(b1p + (size_t)u.e * 2048 + u.pn * 256 + 4 * lane), (LAS unsigned*)buf, 16, 0, 0);
        else if (wid == 1) __builtin_amdgcn_global_load_lds((const unsigned*)(rsE + (size_t)u.e * ECAP + u.lr0 + 4 * lane), (LAS unsigned*)(buf + 1024), 16, 0, 0);
    }
    __device__ __forceinline__ void operator()(const f32x4 (&acc)[2][2][4][2], const Unit& u, int wr, int wc, int fr, int fq, LAS unsigned char* buf) const {
        const int cnt = __builtin_amdgcn_readfirstlane(lds_cnt(lds)[u.e]);
        const LAS float* bp = (const LAS float*)buf + wc * 32 + 8 * fq; const LAS float* rp = (const LAS float*)(buf + 1024);
        f32x4 bv[2][2];
#pragma unroll
        for (int bj = 0; bj < 2; ++bj)
#pragma unroll
            for (int n = 0; n < 2; ++n) bv[bj][n] = *(const LAS f32x4*)(bp + bj * HALF + 4 * n);
        const int col0 = u.pn * 128 + wc * 32 + 8 * fq;
#pragma unroll
        for (int ai = 0; ai < 2; ++ai)
#pragma unroll
            for (int m = 0; m < 4; ++m) { const int lrow = ai * HALF + wr * 64 + m * 16 + fr; const int lr = u.lr0 + lrow;
                const float rsv = rp[lrow]; const float rs = lr < cnt ? rsv : 0.f;
                float o[8]; const f32x2t rs2 = {rs, rs};
#pragma unroll
                for (int n = 0; n < 2; ++n)
#pragma unroll
                    for (int i = 0; i < 4; i += 2) {
                        f32x2t gl = (f32x2t){acc[ai][0][m][n][i], acc[ai][0][m][n][i + 1]} * rs2 + (f32x2t){bv[0][n][i], bv[0][n][i + 1]};
                        f32x2t li = (f32x2t){acc[ai][1][m][n][i], acc[ai][1][m][n][i + 1]} * rs2 + (f32x2t){bv[1][n][i], bv[1][n][i + 1]};
                        gl[0] = fminf(gl[0], 7.0f); gl[1] = fminf(gl[1], 7.0f); li[0] = __builtin_amdgcn_fmed3f(li[0], -6.0f, 8.0f); li[1] = __builtin_amdgcn_fmed3f(li[1], -6.0f, 8.0f);
                        const f32x2t t = gl * (-1.702f * LOG2E); f32x2t e; e[0] = __builtin_amdgcn_exp2f(t[0]); e[1] = __builtin_amdgcn_exp2f(t[1]);
                        const f32x2t d = e + 1.0f; f32x2t sg; sg[0] = __builtin_amdgcn_rcpf(d[0]); sg[1] = __builtin_amdgcn_rcpf(d[1]);
                        const f32x2t r = (gl * sg) * li; o[4 * n + i] = r[0]; o[4 * n + i + 1] = r[1]; }
                u32x2v w; w.x = pk4_fp8_nc(o[0], o[1], o[2], o[3]); w.y = pk4_fp8_nc(o[4], o[5], o[6], o[7]);
                *(u32x2v*)(HB + (size_t)(u.pm * 256 + lrow) * FF + col0) = w; }
    }
};
struct EpiY {
    static constexpr bool PERM = true, PREFETCH = true;
    unsigned char* Y; const float* b2; const float* gateE; LAS unsigned char* lds;
    __device__ __forceinline__ void prefetch(const Unit& u, LAS unsigned char* buf, int wid, int lane) const {
        if (wid == 0) __builtin_amdgcn_global_load_lds((const unsigned*)(b2 + (size_t)u.e * D + u.pn * 256 + 4 * lane), (LAS unsigned*)buf, 16, 0, 0);
        else if (wid == 1) __builtin_amdgcn_global_load_lds((const unsigned*)(gateE + (size_t)u.e * ECAP + u.lr0 + 4 * lane), (LAS unsigned*)(buf + 1024), 16, 0, 0);
    }
    __device__ __forceinline__ void operator()(const f32x4 (&acc)[2][2][4][2], const Unit& u, int wr, int wc, int fr, int fq, LAS unsigned char* buf) const {
        const int cnt = __builtin_amdgcn_readfirstlane(lds_cnt(lds)[u.e]);
        const int colt = wc * 64 + 16 * fq, col0 = u.pn * 256 + colt;
        const LAS float* bp = (const LAS float*)buf + colt; const LAS float* gp = (const LAS float*)(buf + 1024);
        f32x4 bv[2][2];
#pragma unroll
        for (int bj = 0; bj < 2; ++bj)
#pragma unroll
            for (int n = 0; n < 2; ++n) bv[bj][n] = *(const LAS f32x4*)(bp + 8 * bj + 4 * n);
#pragma unroll
        for (int ai = 0; ai < 2; ++ai)
#pragma unroll
            for (int m = 0; m < 4; ++m) { const int lrow = ai * HALF + wr * 64 + m * 16 + fr; const int lr = u.lr0 + lrow;
                const float gv_ = gp[lrow]; const float gt = lr < cnt ? gv_ * 16.0f : 0.f;
                v4u w;
                { const f32x4 v0 = (acc[ai][0][m][0] + bv[0][0]) * gt, v1 = (acc[ai][0][m][1] + bv[0][1]) * gt; w.x = pk4_fp8(v0[0], v0[1], v0[2], v0[3]); w.y = pk4_fp8(v1[0], v1[1], v1[2], v1[3]); }
                { const f32x4 v0 = (acc[ai][1][m][0] + bv[1][0]) * gt, v1 = (acc[ai][1][m][1] + bv[1][1]) * gt; w.z = pk4_fp8(v0[0], v0[1], v0[2], v0[3]); w.w = pk4_fp8(v1[0], v1[1], v1[2], v1[3]); }
                *(v4u*)(Y + (size_t)(u.pm * 256 + lrow) * D + col0) = w;
                __builtin_amdgcn_sched_barrier(0); }
    }
};
struct EpiFinal {
    static constexpr bool PERM = true, PREFETCH = false;
    float* out; const bf16* H2; const unsigned char* PP; const float* rs3;
    __device__ __forceinline__ void operator()(const f32x4 (&acc)[2][2][4][2], const Unit& u, int wr, int wc, int fr, int fq) const {
        const int row0 = u.pm * BM + wr * 64 + fr, col0 = u.pn * BM + wc * 32 + 8 * fq;
#pragma unroll
        for (int ai = 0; ai < 2; ++ai) {
            v4u hw[4][2]; u32x2v pw[4][2]; float rs[4];
#pragma unroll
            for (int m = 0; m < 4; ++m) { const int row = row0 + ai * HALF + m * 16; const size_t off = (size_t)row * D + col0; rs[m] = rs3[row];
#pragma unroll
                for (int bj = 0; bj < 2; ++bj) { hw[m][bj] = *(const v4u*)(H2 + off + bj * HALF); pw[m][bj] = *(const u32x2v*)(PP + off + bj * HALF); } }
#pragma unroll
            for (int m = 0; m < 4; ++m) { const int row = row0 + ai * HALF + m * 16; const size_t off = (size_t)row * D + col0;
#pragma unroll
                for (int bj = 0; bj < 2; ++bj) { const v4u h_ = hw[m][bj]; const u32x2v p_ = pw[m][bj];
                    const float hv[8] = {bflo(h_.x), bfhi(h_.x), bflo(h_.y), bfhi(h_.y), bflo(h_.z), bfhi(h_.z), bflo(h_.w), bfhi(h_.w)};
                    const f32x2t p0 = __builtin_amdgcn_cvt_pk_f32_fp8((int)p_.x, false), p1 = __builtin_amdgcn_cvt_pk_f32_fp8((int)p_.x, true), p2 = __builtin_amdgcn_cvt_pk_f32_fp8((int)p_.y, false), p3 = __builtin_amdgcn_cvt_pk_f32_fp8((int)p_.y, true);
                    const float pv[8] = {p0[0], p0[1], p1[0], p1[1], p2[0], p2[1], p3[0], p3[1]};
#pragma unroll
                    for (int n = 0; n < 2; ++n) { const f32x4 a = acc[ai][bj][m][n] * rs[m]; f32x4 o;
#pragma unroll
                        for (int i = 0; i < 4; ++i) o[i] = hv[4 * n + i] + __builtin_amdgcn_rcpf(1.0f + __builtin_amdgcn_exp2f(-LOG2E * a[i])) * pv[4 * n + i];
                        *(f32x4*)(out + off + bj * HALF + 4 * n) = o; } } }
            __builtin_amdgcn_sched_barrier(0); }
    }
};

__device__ __forceinline__ int dest_row(int mode, int nn) {
    if (mode == 1) { const int c = nn & 255; return (nn & ~255) + 128 * ((c >> 5) & 1) + 32 * (c >> 6) + (c & 31); }
    if (mode == 2) { const int o = nn >> 1; return 256 * (o >> 7) + (o & 127) + 128 * (nn & 1); }
    if (mode == 3) { const int c = nn & 255; return (nn & ~255) + 128 * ((c >> 3) & 1) + 32 * (c >> 6) + 8 * ((c >> 4) & 3) + (c & 7); }
    return nn;
}
__device__ __forceinline__ void tr_item(const float* W, int ldw, int k0, int n0src, int n0, int mode, bf16* WT, int Kdim, LAS float* scr, int lane) {
    float v[32];
#pragma unroll
    for (int i = 0; i < 32; ++i) { const int kk = 2 * i + (lane >> 5); v[i] = __builtin_nontemporal_load(W + (size_t)(k0 + kk) * ldw + n0src + (lane & 31)); }
#pragma unroll
    for (int i = 0; i < 32; ++i) { const int kk = 2 * i + (lane >> 5); scr[kk * 33 + (lane & 31)] = v[i]; }
    LDS_WAIT(); asm volatile("" ::: "memory");
    const int c = lane & 7;
#pragma unroll
    for (int j = 0; j < 4; ++j) { const int n = (lane >> 3) + 8 * j; const LAS float* s = scr + (8 * c) * 33 + n;
        v4u o; o.x = pk2(s[0 * 33], s[1 * 33]); o.y = pk2(s[2 * 33], s[3 * 33]); o.z = pk2(s[4 * 33], s[5 * 33]); o.w = pk2(s[6 * 33], s[7 * 33]);
        *(GAS v4u*)(WT + (size_t)dest_row(mode, n0 + n) * Kdim + k0 + 8 * c) = o; }
    LDS_WAIT(); asm volatile("" ::: "memory");
}
__device__ __forceinline__ void tr_item_f8(const float* W, int ldw, int k0, int n0src, int n0, int mode, unsigned char* WT, int Kdim, LAS float* scr, int lane) {
    float v[32];
#pragma unroll
    for (int i = 0; i < 32; ++i) { const int kk = 2 * i + (lane >> 5); v[i] = __builtin_nontemporal_load(W + (size_t)(k0 + kk) * ldw + n0src + (lane & 31)); }
#pragma unroll
    for (int i = 0; i < 32; ++i) { const int kk = 2 * i + (lane >> 5); scr[kk * 33 + (lane & 31)] = v[i] * 32.0f; }
    LDS_WAIT(); asm volatile("" ::: "memory");
    const int c = lane & 3;
#pragma unroll
    for (int j = 0; j < 2; ++j) { const int n = (lane >> 2) + 16 * j; const LAS float* s = scr + (16 * c) * 33 + n;
        v4u o; o.x = pk4_fp8(s[0 * 33], s[1 * 33], s[2 * 33], s[3 * 33]); o.y = pk4_fp8(s[4 * 33], s[5 * 33], s[6 * 33], s[7 * 33]);
        o.z = pk4_fp8(s[8 * 33], s[9 * 33], s[10 * 33], s[11 * 33]); o.w = pk4_fp8(s[12 * 33], s[13 * 33], s[14 * 33], s[15 * 33]);
        *(GAS v4u*)(WT + (size_t)dest_row(mode, n0 + n) * Kdim + k0 + 16 * c) = o; }
    LDS_WAIT(); asm volatile("" ::: "memory");
}
__device__ __forceinline__ float log_sigmoid(float z) { return fminf(z, 0.f) - log1pf(expf(-fabsf(z))); }

__device__ __forceinline__ void p0_prologue(Frame& F) {
    const float* x = KARG->in[0]; const float* p = KARG->in[1]; const float* g_attn = KARG->in[3]; const float* w_in = KARG->in[4]; const float* b_f = KARG->in[5];
    const float* w_out = KARG->in[15]; const float* g_mlp = KARG->in[16]; const float* w_router = KARG->in[17]; const float* w1 = KARG->in[19]; const float* b1 = KARG->in[20];
    const float* w2 = KARG->in[21]; const float* w_pg = KARG->in[24]; const float* w_pp = KARG->in[25];
    unsigned char* ws = F.ws;
    const int gw = F.vcu * NWAVES + F.wave, NGW = F.G * NWAVES;
    const int gt = F.vcu * (NWAVES * 64) + F.tid, NGT = F.G * NWAVES * 64;
    { LAS float* wf = (LAS float*)(F.lds + RING_OFF);
      for (int k = F.tid; k < D; k += NWAVES * 64) {
          const f32x4 a = *(const f32x4*)(w_in + (size_t)k * INW + 1536), b = *(const f32x4*)(w_in + (size_t)k * INW + 1540); const float g = g_attn[k];
          LAS f32x4* dst = (LAS f32x4*)(wf + ((((k >> 8) * 4 + (k & 3)) * 128 + ((k & 255) >> 2)) * 4)); dst[0] = a * g; dst[64] = b * g; }
      __syncthreads();
      f32x4 gv[4];
#pragma unroll
      for (int j = 0; j < 4; ++j) gv[j] = *(const f32x4*)(g_attn + 256 * j + 4 * F.lane);
      bf16* A0 = (bf16*)(ws + WS_A0); float* LF = (float*)(ws + WS_LF);
      for (int m = gw; m < NTOK; m += NGW) {
          const GAS f32x4* xr = (const GAS f32x4*)(x + (size_t)m * D) + F.lane;
          f32x4 v[4]; float ss = 0.f;
#pragma unroll
          for (int j = 0; j < 4; ++j) { v[j] = __builtin_nontemporal_load(xr + 64 * j); ss += (v[j].x * v[j].x + v[j].y * v[j].y) + (v[j].z * v[j].z + v[j].w * v[j].w); }
          const float rs = 1.0f / sqrtf(wave_sum(ss) * (1.0f / D) + EPS);
          GAS unsigned long long* o8 = (GAS unsigned long long*)(A0 + (size_t)m * D) + F.lane;
          float fa[8];
#pragma unroll
          for (int h = 0; h < 8; ++h) fa[h] = 0.f;
#pragma unroll
          for (int j = 0; j < 4; ++j) {
              const f32x4 y = v[j] * gv[j] * rs;
              o8[64 * j] = (unsigned long long)pk2(y.x, y.y) | ((unsigned long long)pk2(y.z, y.w) << 32);
#pragma unroll
              for (int i = 0; i < 4; ++i) { const LAS f32x4* wp = (const LAS f32x4*)(wf + ((j * 4 + i) * 128 + F.lane) * 4); const f32x4 wa = wp[0], wb = wp[64]; const float xv = v[j][i];
                  fa[0] += xv * wa.x; fa[1] += xv * wa.y; fa[2] += xv * wa.z; fa[3] += xv * wa.w; fa[4] += xv * wb.x; fa[5] += xv * wb.y; fa[6] += xv * wb.z; fa[7] += xv * wb.w; }
          }
          float mine = 0.f;
#pragma unroll
          for (int h = 0; h < 8; ++h) { const float t = wave_sum(fa[h]); if (F.lane == h) mine = t; }
          if (F.lane < 8) LF[(size_t)m * 8 + F.lane] = log_sigmoid(mine * rs + b_f[F.lane]);
      }
      __syncthreads();
    }
    { bf16* wrH = (bf16*)(ws + WS_WRH); bf16* wrL = (bf16*)(ws + WS_WRL); float* b1p = (float*)(ws + WS_B1P);
      for (int i = gt; i < NE * D; i += NGT) { const int e = i >> 10, k = i & 1023; const float w = g_mlp[k] * w_router[(size_t)k * NE + e]; const unsigned hb = f2bf(w);
          wrH[i] = (bf16)hb; wrL[i] = (bf16)f2bf(w - __builtin_bit_cast(float, hb << 16)); }
      for (int i = gt; i < NE * 2048; i += NGT) { const int e = i >> 11, r = i & 2047, pn = r >> 8, rho = r & 255; const int o = 128 * pn + (rho & 127); b1p[i] = b1[(size_t)e * 2048 + 2 * o + (rho >> 7)] + (float)(rho >> 7); }
      bf16* PB = (bf16*)(ws + WS_PB);
      for (int i = gt; i < NTOK * PLE / 8; i += NGT) { const f32x4 a = *(const f32x4*)(p + (size_t)i * 8), b = *(const f32x4*)(p + (size_t)i * 8 + 4);
          v4u o; o.x = pk2(a.x, a.y); o.y = pk2(a.z, a.w); o.z = pk2(b.x, b.y); o.w = pk2(b.z, b.w); *(GAS v4u*)(PB + (size_t)i * 8) = o; }
    }
    { LAS float* scr = (LAS float*)(F.lds + RING_OFF + F.wave * 16384);
      constexpr int I_W1 = NE * 16 * 64, I_W2 = NE * 16 * 32, I_IN = 16 * 96, I_O = 16 * 32, I_G = 16 * 32, I_P = 4 * 32;
      constexpr int NITEMS = I_W1 + I_W2 + I_IN + I_O + I_G + I_P;
      for (int it = gw; it < NITEMS; it += NGW) {
          int r = it;
          if (r < I_W1) { const int e = r >> 10, q = r & 1023, kb = q >> 6, nb = q & 63;
              tr_item_f8(w1 + (size_t)e * D * 2048, 2048, 64 * kb, 32 * nb, 32 * nb, 2, ws + WS_W1 + (size_t)e * 2048 * D, D, scr, F.lane); continue; } r -= I_W1;
          if (r < I_W2) { const int e = r >> 9, q = r & 511, kb = q >> 5, nb = q & 31;
              tr_item_f8(w2 + (size_t)e * FF * D, D, 64 * kb, 32 * nb, 32 * nb, 3, ws + WS_W2 + (size_t)e * D * FF, FF, scr, F.lane); continue; } r -= I_W2;
          if (r < I_IN) { const int kb = r / 96, nb = r % 96; const int P0 = 32 * nb;
              tr_item(w_in, INW, 64 * kb, P0 + (P0 >= 1536 ? 8 : 0), P0, 1, (bf16*)(ws + WS_WIN), D, scr, F.lane); continue; } r -= I_IN;
          if (r < I_O) { const int kb = r >> 5, nb = r & 31; tr_item_f8(w_out, D, 64 * kb, 32 * nb, 32 * nb, 0, ws + WS_WOUT, D, scr, F.lane); continue; } r -= I_O;
          if (r < I_G) { const int kb = r >> 5, nb = r & 31; tr_item_f8(w_pg, D, 64 * kb, 32 * nb, 32 * nb, 0, ws + WS_WG, D, scr, F.lane); continue; } r -= I_G;
          { const int kb = r >> 5, nb = r & 31; tr_item(w_pp, D, 64 * kb, 32 * nb, 32 * nb, 0, (bf16*)(ws + WS_WP), PLE, scr, F.lane); }
      }
    }
}

__device__ __forceinline__ void p1_scan(Frame& F) {
    const float* LF = (const float*)(F.ws + WS_LF); float* CS = (float*)(F.ws + WS_CS);
    LAS float* sc = (LAS float*)(F.lds + RING_OFF);
    for (int seq = F.vcu; seq < BATCH * NFOX; seq += F.G) {
        const int b = seq >> 3, h = seq & 7;
        float v[4];
#pragma unroll
        for (int i = 0; i < 4; ++i) v[i] = LF[((size_t)b * SEQ + 4 * F.tid + i) * 8 + h];
        v[1] += v[0]; v[2] += v[1]; v[3] += v[2];
        float incl = v[3];
#pragma unroll
        for (int o = 1; o < 64; o <<= 1) { const float t = __shfl_up(incl, o); if (F.lane >= o) incl += t; }
        if (F.lane == 63) sc[F.wave] = incl;
        __syncthreads();
        float off = incl - v[3];
        for (int w = 0; w < F.wave; ++w) off += sc[w];
        f32x4 o; o.x = -(off + v[0]) * LOG2E; o.y = -(off + v[1]) * LOG2E; o.z = -(off + v[2]) * LOG2E; o.w = -(off + v[3]) * LOG2E;
        *(f32x4*)(CS + (size_t)seq * SEQ + 4 * F.tid) = o;
        __syncthreads();
    }
}

constexpr int CSL_OFF = 122880;
static_assert(CSL_OFF >= attn_body::LDS_ZERO + 16 && CSL_OFF + SEQ * 4 <= MISC_OFF, "FoX cs cache");
constexpr int DSTASH = 86016;
static_assert(DSTASH >= attn_body::L8_TAB + 2304 * 4 && DSTASH + 65536 <= MISC_OFF, "diff-attention stash");
__device__ __forceinline__ int t5_bucket(int n) {
    if (n < 16) return n;
    int b = 16;
    b += (n >= 19); b += (n >= 21); b += (n >= 24); b += (n >= 27); b += (n >= 31); b += (n >= 35); b += (n >= 40); b += (n >= 46);
    b += (n >= 52); b += (n >= 59); b += (n >= 67); b += (n >= 77); b += (n >= 87); b += (n >= 99); b += (n >= 113);
    return b;
}
__device__ __forceinline__ void p2_attention(Frame& F, char* shm) {
    const bf16* PROJ = (const bf16*)(F.ws + WS_PROJ); unsigned char* MIXED = F.ws + WS_MIXED;   const float* CS = (const float*)(F.ws + WS_CS);
    const float* rel_bias = KARG->in[2]; const float* g_subln = KARG->in[14];
    const int lane = F.lane, wid = F.wave;
    LAS float* tab = (LAS float*)(F.lds + attn_body::LDS_TAB);
    float skip_th;
    { const float gq = fabsf(KARG->in[6][lane]), gk = fabsf(KARG->in[7][lane]); float mq = gq, mk = gk;
#pragma unroll
      for (int o = 1; o < 64; o <<= 1) { mq = fmaxf(mq, __shfl_xor(mq, o)); mk = fmaxf(mk, __shfl_xor(mk, o)); }
      skip_th = 2.0f * (64.0f * C2) * mq * mk + 40.0f; }
    unsigned hpack;
    { const float bv = KARG->in[5][lane & 7]; int rk = 0;
#pragma unroll
      for (int j = 0; j < 8; ++j) { const float o = __shfl(bv, j); rk += (o < bv || (o == bv && j < (lane & 7))) ? 1 : 0; }
      hpack = 0u;
#pragma unroll
      for (int r = 0; r < 8; ++r) { const unsigned long long bal = __ballot(lane < 8 && rk == r); hpack |= (unsigned)__builtin_ctzll(bal) << (4 * r); }
      hpack = (unsigned)__builtin_amdgcn_readfirstlane((int)hpack); }
    for (int pi = F.vcu; pi < 128 * 4; pi += F.G) {
        const int bh = pi >> 2, s = (pi < 256) ? (pi & 3) : 3 - (pi & 3), b = bh >> 3, h = (hpack >> (4 * ((pi < 256) ? (bh & 7) : 7 - (bh & 7)))) & 7;
        LAS float* cs = (LAS float*)(F.lds + CSL_OFF);
        __syncthreads();
        { const float* csg = CS + (size_t)(b * 8 + h) * SEQ; for (int i = F.tid; i < SEQ / 4; i += NWAVES * 64) ((LAS f32x4*)cs)[i] = ((const f32x4*)csg)[i]; }
        __syncthreads();
        for (int half = 0; half < 2; ++half) {
            const int qb = half ? 7 - s : s, q0 = qb * 256, NTfull = 4 * qb + 4;
            int t0;
            { const float cq = cs[q0]; const int i = lane & 15; const bool ok = (2 * i <= NTfull - 4) && (i == 0 || cq - cs[128 * i - 1] > skip_th);
              const unsigned long long bal = __ballot(ok) & 0xffffull; t0 = 2 * (63 - __builtin_clzll(bal)); t0 = __builtin_amdgcn_readfirstlane(t0); }
            const int k0 = 64 * t0;
            __syncthreads();
            for (int i = F.tid; i < q0 + 256 - k0; i += NWAVES * 64) { unsigned h_, m_, l_; attn_body::split3(cs[k0 + i], h_, m_, l_);
                *(LAS v4u*)(F.lds + attn_body::LDS_TAB + 16 * i) = (v4u){h_ | (m_ << 16), l_ | 0x3F800000u, 0x3F803F80u, 0u}; }
            if (F.tid == 0) *(LAS v4u*)(F.lds + attn_body::LDS_ZERO) = (v4u){0u, 0u, 0u, 0u};
            __syncthreads();
            const bf16* base = PROJ + (size_t)b * SEQ * NPROJ;
            attn_body::attn_unit<8, 0, D>(q0, NTfull - t0, base + CQF + h * 64, base + (size_t)k0 * NPROJ + CKF + h * 64, base + (size_t)k0 * NPROJ + CVF + h * 64, (bf16*)(MIXED + (size_t)b * SEQ * D + h * 64), shm);
        }
    }
    float lam;
    { const float a = KARG->in[10][lane] * KARG->in[11][lane], c = KARG->in[12][lane] * KARG->in[13][lane]; lam = expf(wave_sum(a)) - expf(wave_sum(c)) + 0.2f; }
    for (int pi = F.vcu; pi < 64 * 4; pi += F.G) {
        const int bh = pi >> 2, s = pi & 3, b = bh >> 2, h = bh & 3;
        __syncthreads();
        LAS float* tab8 = (LAS float*)(F.lds + attn_body::L8_TAB);
        for (int i = F.tid; i < 2304; i += NWAVES * 64) { const int dist = 2047 - i; tab8[i] = (rel_bias[t5_bucket(dist > 0 ? dist : 0) * NDIFF + h] - rel_bias[31 * NDIFF + h]) * LOG2E; }
        __syncthreads();
        for (int half = 0; half < 2; ++half) {
            const int qb = half ? 7 - s : s, q0 = qb * 256;
            const bf16* base = PROJ + (size_t)b * SEQ * NPROJ;
            attn_body::attn_unit128<8, DSTASH>(q0, base + CQD + h * 128, base + CKD + h * 128, base + CVD + h * 128, shm);
            attn_body::attn_unit128<8, 0>(q0, base + CQD + h * 128 + 64, base + CKD + h * 128 + 64, base + CVD + h * 128, shm);
            int l2 = threadIdx.x & 63; asm volatile("" : "+v"(l2));
            const int cr = l2 >> 4, cc = (l2 & 15) * 8;
            const LAS bf16* s1 = (const LAS bf16*)(F.lds + DSTASH) + wid * 4096 + cr * 128 + cc; const LAS bf16* s2 = (const LAS bf16*)(F.lds) + wid * 4096 + cr * 128 + cc;
            unsigned char* mrow = MIXED + ((size_t)b * SEQ + q0 + 32 * wid + cr) * D + 512 + h * 128 + cc;
            v4u w1[8], w2[8];
#pragma unroll
            for (int it = 0; it < 8; ++it) { w1[it] = *(const LAS v4u*)(s1 + 4 * it * 128); w2[it] = *(const LAS v4u*)(s2 + 4 * it * 128); }
            f32x4 ga = *(const f32x4*)(g_subln + cc), gb = *(const f32x4*)(g_subln + cc + 4);
#pragma unroll
            for (int it = 0; it < 8; ++it) {
                const unsigned a1[4] = {w1[it].x, w1[it].y, w1[it].z, w1[it].w}, a2[4] = {w2[it].x, w2[it].y, w2[it].z, w2[it].w};
                float dv[8]; float ss = 0.f;
#pragma unroll
                for (int i = 0; i < 4; ++i) { dv[2 * i] = bflo(a1[i]) - lam * bflo(a2[i]); dv[2 * i + 1] = bfhi(a1[i]) - lam * bfhi(a2[i]); ss += dv[2 * i] * dv[2 * i] + dv[2 * i + 1] * dv[2 * i + 1]; }
                ss += __shfl_xor(ss, 1); ss += __shfl_xor(ss, 2); ss += __shfl_xor(ss, 4); ss += __shfl_xor(ss, 8);
                const float rq = 0.8f / sqrtf(ss * (1.0f / 128.0f) + EPS);
                u32x2v o; o.x = pk4_fp8(dv[0] * rq * ga.x, dv[1] * rq * ga.y, dv[2] * rq * ga.z, dv[3] * rq * ga.w); o.y = pk4_fp8(dv[4] * rq * gb.x, dv[5] * rq * gb.y, dv[6] * rq * gb.z, dv[7] * rq * gb.w);
                *(GAS u32x2v*)(mrow + (size_t)(4 * it) * D) = o;
            }
            __syncthreads();
        }
    }
}

__device__ __forceinline__ void p4_router(Frame& F) {
    const bf16* h1 = (const bf16*)(F.ws + WS_H1B); const float* g_mlp = KARG->in[16]; const float* b_router = KARG->in[18];
    const bf16* wrH = (const bf16*)(F.ws + WS_WRH); const bf16* wrL = (const bf16*)(F.ws + WS_WRL);
    unsigned char* A0 = F.ws + WS_A0;
    int* tokE = (int*)(F.ws + WS_TOKE); float* gateE = (float*)(F.ws + WS_GATEE); float* rsE = (float*)(F.ws + WS_RSE); int* tp = (int*)(F.ws + WS_TP);
    const int lane = F.lane, r16 = lane & 15, kq = lane >> 4;
    constexpr int WPITCH = 2064;
    LAS unsigned char* wH = F.lds; LAS unsigned char* wL = F.lds + 32 * WPITCH;
    for (int c = F.tid; c < 2 * 4096; c += NWAVES * 64) { const int mtx = c >> 12, cc = c & 4095, r = cc >> 7, q = cc & 127;
        *(LAS v4u*)((mtx ? wL : wH) + r * WPITCH + q * 16) = *(const v4u*)((mtx ? wrL : wrH) + (size_t)r * D + q * 8); }
    LAS float* lg = (LAS float*)(F.lds + 64 * WPITCH + F.wave * 2176);
    LAS unsigned* hist = (LAS unsigned*)(F.lds + EPI_OFF); LAS unsigned* baseL = hist + 32;
    static_assert(64 * WPITCH + NWAVES * 2176 <= TILEE_OFF, "router LDS map");
    __syncthreads();
    for (int g0 = F.vcu; g0 < NTOK / 128; g0 += F.G) {
        const int R0 = (g0 * NWAVES + F.wave) * 16; const int row = R0 + r16;
        if (F.tid < 32) hist[F.tid] = 0u;
        __syncthreads();
        f32x4 acc0 = {0.f, 0.f, 0.f, 0.f}, acc1 = {0.f, 0.f, 0.f, 0.f}; float ss = 0.f;
        const bf16* xr = h1 + (size_t)row * D + 16 * kq;
#pragma unroll 2
        for (int p = 0; p < 16; ++p) {
            const int k = 64 * p + 16 * kq;
            const v4u xw0 = *(const v4u*)(xr + 64 * p), xw1 = *(const v4u*)(xr + 64 * p + 8);
            const f32x4 g0 = *(const f32x4*)(g_mlp + k), g1 = *(const f32x4*)(g_mlp + k + 4), g2 = *(const f32x4*)(g_mlp + k + 8), g3 = *(const f32x4*)(g_mlp + k + 12);
            const float xv[16] = {bflo(xw0.x), bfhi(xw0.x), bflo(xw0.y), bfhi(xw0.y), bflo(xw0.z), bfhi(xw0.z), bflo(xw0.w), bfhi(xw0.w),
                                  bflo(xw1.x), bfhi(xw1.x), bflo(xw1.y), bfhi(xw1.y), bflo(xw1.z), bfhi(xw1.z), bflo(xw1.w), bfhi(xw1.w)};
#pragma unroll
            for (int j = 0; j < 16; ++j) ss += xv[j] * xv[j];
            { v4u o; o.x = pk4_fp8(xv[0] * g0.x, xv[1] * g0.y, xv[2] * g0.z, xv[3] * g0.w); o.y = pk4_fp8(xv[4] * g1.x, xv[5] * g1.y, xv[6] * g1.z, xv[7] * g1.w);
              o.z = pk4_fp8(xv[8] * g2.x, xv[9] * g2.y, xv[10] * g2.z, xv[11] * g2.w); o.w = pk4_fp8(xv[12] * g3.x, xv[13] * g3.y, xv[14] * g3.z, xv[15] * g3.w);
              *(GAS v4u*)(A0 + (size_t)row * D + k) = o; }
#pragma unroll
            for (int hf = 0; hf < 2; ++hf) {
                const bf16x8 Ah = __builtin_bit_cast(bf16x8, hf ? xw1 : xw0); const int kk = k + 8 * hf;
                const bf16x8 Bh0 = *(const LAS bf16x8*)(wH + r16 * WPITCH + 2 * kk), Bl0 = *(const LAS bf16x8*)(wL + r16 * WPITCH + 2 * kk);
                const bf16x8 Bh1 = *(const LAS bf16x8*)(wH + (16 + r16) * WPITCH + 2 * kk), Bl1 = *(const LAS bf16x8*)(wL + (16 + r16) * WPITCH + 2 * kk);
                acc0 = __builtin_amdgcn_mfma_f32_16x16x32_bf16(Ah, Bh0, acc0, 0, 0, 0); acc0 = __builtin_amdgcn_mfma_f32_16x16x32_bf16(Ah, Bl0, acc0, 0, 0, 0);
                acc1 = __builtin_amdgcn_mfma_f32_16x16x32_bf16(Ah, Bh1, acc1, 0, 0, 0); acc1 = __builtin_amdgcn_mfma_f32_16x16x32_bf16(Ah, Bl1, acc1, 0, 0, 0); }
        }
        ss += __shfl_xor(ss, 16); ss += __shfl_xor(ss, 32);
        const float rs = 1.0f / sqrtf(ss * (1.0f / D) + EPS);
#pragma unroll
        for (int i = 0; i < 4; ++i) { lg[(4 * kq + i) * 33 + r16] = acc0[i]; lg[(4 * kq + i) * 33 + 16 + r16] = acc1[i]; }
        if (kq == 0) lg[16 * 33 + r16] = rs;
        asm volatile("s_waitcnt lgkmcnt(0)" ::: "memory");
        int se[4] = {0, 0, 0, 0}; float sg[4] = {0.f, 0.f, 0.f, 0.f}; unsigned rk[4] = {0u, 0u, 0u, 0u}; float myrs = 0.f;
        if (lane < 16) {
            myrs = lg[16 * 33 + lane];
            float v[32];
#pragma unroll
            for (int e = 0; e < 32; ++e) v[e] = lg[lane * 33 + e] * myrs + b_router[e];
            float sv[4];
#pragma unroll
            for (int k = 0; k < 4; ++k) { float best = v[0]; int bi = 0;
#pragma unroll
                for (int e = 1; e < 32; ++e) { const bool gt = v[e] > best; best = gt ? v[e] : best; bi = gt ? e : bi; }
                sv[k] = best; se[k] = bi;
#pragma unroll
                for (int e = 0; e < 32; ++e) v[e] = (e == bi) ? -INFINITY : v[e]; }
            float den = 0.f;
#pragma unroll
            for (int k = 0; k < 4; ++k) { sg[k] = expf(sv[k] - sv[0]); den += sg[k]; }
            const float inv = 1.0f / den;
#pragma unroll
            for (int k = 0; k < 4; ++k) { sg[k] *= inv; rk[k] = __hip_atomic_fetch_add(hist + se[k], 1u, __ATOMIC_RELAXED, __HIP_MEMORY_SCOPE_WORKGROUP); }
        }
        __syncthreads();
        if (F.tid < 32) { const unsigned c = hist[F.tid]; baseL[F.tid] = c ? __hip_atomic_fetch_add((unsigned*)(F.ctl + CW_CNT + 64 * F.tid), c, __ATOMIC_RELAXED, __HIP_MEMORY_SCOPE_AGENT) : 0u; }
        __syncthreads();
        if (lane < 16) {
            const int trow = R0 + lane;
#pragma unroll
            for (int k = 0; k < 4; ++k) { const unsigned pos = baseL[se[k]] + rk[k]; const size_t ix = (size_t)se[k] * ECAP + pos;
                tokE[ix] = trow; gateE[ix] = sg[k]; rsE[ix] = myrs; tp[(size_t)trow * 4 + k] = se[k] * 32768 + (int)pos; }
        }
        __syncthreads();
    }
}
__device__ __forceinline__ int moe_tables(Frame& F) {
    LAS int* ts = lds_tstart(F.lds); LAS int* cn = lds_cnt(F.lds); LAS unsigned short* te = lds_tileE(F.lds);
    __syncthreads();
    if (F.tid < 64) {
        const int c = F.tid < 32 ? (int)__hip_atomic_load((unsigned*)(F.ctl + CW_CNT + 64 * F.tid), __ATOMIC_RELAXED, __HIP_MEMORY_SCOPE_AGENT) : 0;
        const int nt = (c + 255) >> 8; int incl = nt;
#pragma unroll
        for (int o = 1; o < 32; o <<= 1) { const int t = __shfl_up(incl, o); if (F.lane >= o) incl += t; }
        if (F.tid < 32) { cn[F.tid] = c; ts[F.tid] = incl - nt; if (F.tid == 31) ts[32] = incl; }
    }
    __syncthreads();
    const int total = ts[32];
    for (int t = F.tid; t < total; t += NWAVES * 64) { int e = 0;
#pragma unroll
        for (int j = 1; j < 32; ++j) e += (t >= ts[j]) ? 1 : 0;
        te[t] = (unsigned short)e; }
    __syncthreads();
    return total;
}
__device__ __forceinline__ void p7_combine(Frame& F) {
    const unsigned char* Y = F.ws + WS_Y; const int* tp = (const int*)(F.ws + WS_TP); unsigned char* A3 = F.ws + WS_A3; float* rs3 = (float*)(F.ws + WS_RS3);
    const float* g_ple = KARG->in[23]; const bf16* h1 = (const bf16*)(F.ws + WS_H1B); bf16* h2 = (bf16*)(F.ws + WS_H2B);
    LAS int* ts = lds_tstart(F.lds);
    const int gw = F.vcu * NWAVES + F.wave, NGW = F.G * NWAVES;
    f32x4 gv[4];
#pragma unroll
    for (int j = 0; j < 4; ++j) gv[j] = *(const f32x4*)(g_ple + 256 * j + 4 * F.lane);
    for (int m = gw; m < NTOK; m += NGW) {
        const GAS u32x2v* hr = (const GAS u32x2v*)(h1 + (size_t)m * D) + F.lane; GAS u32x2v* ho = (GAS u32x2v*)(h2 + (size_t)m * D) + F.lane;
        f32x4 v[4];
#pragma unroll
        for (int j = 0; j < 4; ++j) { const u32x2v w = hr[64 * j]; v[j] = (f32x4){bflo(w.x), bfhi(w.x), bflo(w.y), bfhi(w.y)}; }
#pragma unroll
        for (int k = 0; k < 4; ++k) { const int t = tp[(size_t)m * 4 + k]; const int e = t >> 15, pos = t & 32767; const size_t yr = (size_t)ts[e] * 256 + pos;
            const GAS unsigned* yp = (const GAS unsigned*)(Y + yr * D) + F.lane;
#pragma unroll
            for (int j = 0; j < 4; ++j) { const unsigned w = yp[64 * j]; const f32x2t a = __builtin_amdgcn_cvt_pk_f32_fp8((int)w, false), c = __builtin_amdgcn_cvt_pk_f32_fp8((int)w, true);
                v[j].x += a[0] * 0.0625f; v[j].y += a[1] * 0.0625f; v[j].z += c[0] * 0.0625f; v[j].w += c[1] * 0.0625f; } }
        float ss = 0.f;
        GAS unsigned* o4 = (GAS unsigned*)(A3 + (size_t)m * D) + F.lane;
#pragma unroll
        for (int j = 0; j < 4; ++j) { { u32x2v w; w.x = pk2(v[j].x, v[j].y); w.y = pk2(v[j].z, v[j].w); ho[64 * j] = w; } ss += (v[j].x * v[j].x + v[j].y * v[j].y) + (v[j].z * v[j].z + v[j].w * v[j].w);
            const f32x4 y = v[j] * gv[j]; o4[64 * j] = pk4_fp8(y.x, y.y, y.z, y.w); }
        ss = wave_sum(ss);
        if (F.lane == 0) rs3[m] = 1.0f / sqrtf(ss * (1.0f / D) + EPS);
    }
}

__global__ void __launch_bounds__(NWAVES * 64, 2) fwd_kernel(Args args) {
    extern __shared__ __attribute__((aligned(16))) unsigned char lds[];
    Frame F;
    F.lds = (LAS unsigned char*)lds;
    F.MISC = (volatile LAS unsigned*)(F.lds + MISC_OFF);
    FRESH(F);
    F.G = gridDim.x; { const int bx = blockIdx.x; F.vcu = (F.G % 8 == 0) ? (bx % 8) * (F.G / 8) + bx / 8 : bx; }
    F.ws = KARG->ws; F.ctl = (gu32*)(KARG->ws + WS_CTL); F.out = KARG->out;
    unsigned char* ws = KARG->ws;
    if (F.tid < 64) ((LAS unsigned*)(F.lds + MISC_OFF))[F.tid] = 0u;
    __syncthreads();
    XcdBarrier bar = xcd_barrier_post((unsigned*)(F.ctl + CW_BAR), F.MISC + 8);
    const int lo = KARG->ph_lo, hi = KARG->ph_hi;
#ifndef PHMASK
#define PHMASK 0x1ff
#endif
#define IN(k) (((PHMASK >> (k)) & 1) && lo <= (k) && (k) < hi)
#define BOTH(k) (IN(k) && IN((k) + 1))
#define GRID_BAR() xcd_barrier(bar)

    if (IN(0)) { FRESH(F); p0_prologue(F); if (BOTH(0)) GRID_BAR(); }

    if (IN(1)) {
        FRESH(F); p1_scan(F);
        { pg8::Gemm g{(const bf16*)(ws + WS_A0), D}; SchedC S{NTOK / 256, NPROJ / 256, F.G, (int)blockIdx.x, D, (const char*)(ws + WS_WIN)};
          EpiProj E{(bf16*)(ws + WS_PROJ), KARG->in[6], KARG->in[7], KARG->in[8], KARG->in[9]};
          pg8::gemm_phase<EpiProj, SchedC>(F.lds + RING_OFF, g, S, E); }
        if (BOTH(1)) GRID_BAR();
    }

    if (IN(2)) { FRESH(F); p2_attention(F, (char*)lds); if (BOTH(2)) GRID_BAR(); }

    if (IN(3)) {
        pg8::Gemm g{(const bf16*)(ws + WS_MIXED), D / 2}; SchedC S{NTOK / 256, D / 256, F.G, (int)blockIdx.x, D / 2, (const char*)(ws + WS_WOUT)};
        EpiRes E{KARG->in[0], (bf16*)(ws + WS_H1B)};
        pg8::gemm_phase<EpiRes, SchedC, true>(F.lds + RING_OFF, g, S, E);
        if (BOTH(3)) GRID_BAR();
    }

    if (IN(4)) { FRESH(F); p4_router(F); if (BOTH(4)) GRID_BAR(); }

    if (IN(5)) {
        FRESH(F); const int ntile = moe_tables(F);
        typedef SchedM<true, 8, 2048, 512> S1;
        S1 S{F.G, (int)blockIdx.x, (const char*)(ws + WS_W1), F.lds, ntile};
        { const int* tokE = (const int*)(ws + WS_TOKE); LAS int* tk = (LAS int*)(F.lds + TOKL_OFF); pg8::Unit u;
          for (int i = 0; i < 18 && S.next(i, u); ++i) if (F.tid < 256) { const int lr = u.lr0 + F.tid; tk[i * 256 + F.tid] = lr < lds_cnt(F.lds)[u.e] ? tokE[(size_t)u.e * ECAP + lr] : 0; }
          __syncthreads(); }
        pg8::Gemm g{(const bf16*)(ws + WS_A0), D / 2};
        EpiSwiglu E{ws + WS_HB, (const float*)(ws + WS_B1P), (const float*)(ws + WS_RSE), F.lds};
        pg8::gemm_phase<EpiSwiglu, S1, true>(F.lds + RING_OFF, g, S, E);
        { const int c = (int)blockIdx.x, rem = (8 * ntile) % F.G;
          if (rem && c >= rem && c - rem < NPPU) {
              pg8::Gemm g2{(const bf16*)(ws + WS_PB), PLE}; SchedC S2{NTOK / 256, D / 256, 1 << 20, c - rem, PLE, (const char*)(ws + WS_WP)};
              EpiBf16P E2{ws + WS_PP, D};
              pg8::gemm_phase<EpiBf16P, SchedC>(F.lds + RING_OFF, g2, S2, E2); } }
        if (BOTH(5)) GRID_BAR();
    }

    if (IN(6)) {
        FRESH(F); const int ntile = (lo <= 5) ? lds_tstart(F.lds)[32] : moe_tables(F);
        typedef SchedM<false, 4, 1024, 512> S2;
        S2 S{F.G, (int)blockIdx.x, (const char*)(ws + WS_W2), F.lds, ntile};
        pg8::Gemm g{(const bf16*)(ws + WS_HB), FF / 2};
        EpiY E{ws + WS_Y, KARG->in[22], (const float*)(ws + WS_GATEE), F.lds};
        pg8::gemm_phase<EpiY, S2, true>(F.lds + RING_OFF, g, S, E);
        { const int c = (int)blockIdx.x, rem5 = (8 * ntile) % F.G, n5 = rem5 ? min(F.G - rem5, NPPU) : 0, left = NPPU - n5;
          const int rem6 = (4 * ntile) % F.G, idle6 = rem6 ? F.G - rem6 : 0;
          const bool onidle = idle6 > 0 && left <= 3 * idle6;
          const int stride = onidle ? idle6 : F.G, j = onidle ? c - rem6 : c;
          if (j >= 0 && n5 + j < NPPU) {
              pg8::Gemm g2{(const bf16*)(ws + WS_PB), PLE}; SchedC S3{NTOK / 256, D / 256, stride, n5 + j, PLE, (const char*)(ws + WS_WP)};
              EpiBf16P E2{ws + WS_PP, D};
              pg8::gemm_phase<EpiBf16P, SchedC>(F.lds + RING_OFF, g2, S3, E2); } }
        if (BOTH(6)) GRID_BAR();
    }

    if (IN(7)) { FRESH(F); if (lo > 5) (void)moe_tables(F); p7_combine(F); if (BOTH(7)) GRID_BAR(); }

    if (IN(8)) {
        pg8::Gemm g{(const bf16*)(ws + WS_A3), D / 2}; SchedC S{NTOK / 256, D / 256, F.G, (int)blockIdx.x, D / 2, (const char*)(ws + WS_WG)};
        EpiFinal E{F.out, (const bf16*)(ws + WS_H2B), ws + WS_PP, (const float*)(ws + WS_RS3)};
        pg8::gemm_phase<EpiFinal, SchedC, true>(F.lds + RING_OFF, g, S, E);
    }
#undef IN
#undef BOTH
#undef GRID_BAR
}

#ifndef MK_N_LAUNCHES
#define MK_N_LAUNCHES 1
#endif
extern "C" void kernel_launch(void* const* d_in, const int* in_sizes, int n_in, void* d_out, int out_size, void* d_ws, size_t ws_size, hipStream_t stream) {
    static int grid = 0;
    if (grid == 0) {
        if (n_in != 26 || in_sizes[0] != NTOK * D || out_size != NTOK * D || ws_size < WS_END) {
            fprintf(stderr, "kernel_launch: unexpected shapes (n_in %d, in0 %d, out %d, ws %zu need %zu); nothing launched\n", n_in, n_in > 0 ? in_sizes[0] : -1, out_size, ws_size, (size_t)WS_END); grid = -1; return; }
        int dev = 0, cus = 0, per_cu = 0;
        if (hipGetDevice(&dev) != hipSuccess || hipDeviceGetAttribute(&cus, hipDeviceAttributeMultiprocessorCount, dev) != hipSuccess) { grid = -1; return; }
        if (hipFuncSetAttribute((const void*)fwd_kernel, hipFuncAttributeMaxDynamicSharedMemorySize, LDS_BYTES) != hipSuccess) { fprintf(stderr, "kernel_launch: hipFuncSetAttribute failed\n"); grid = -1; return; }
        if (hipOccupancyMaxActiveBlocksPerMultiprocessor(&per_cu, (const void*)fwd_kernel, NWAVES * 64, LDS_BYTES) != hipSuccess || per_cu < 1)
            fprintf(stderr, "kernel_launch: note: occupancy query reports %d workgroups per CU\n", per_cu);
        (void)hipGetLastError();
        grid = cus;
        if (grid != 256) fprintf(stderr, "kernel_launch: note: %d CUs (tuned for 256)\n", grid);
    }
    if (grid < 0) return;
    if (hipMemsetAsync((char*)d_ws + WS_CTL, 0, CTL_ZERO_BYTES, stream) != hipSuccess) { fprintf(stderr, "kernel_launch: memset failed\n"); return; }
    Args a{};
    for (int i = 0; i < 26; ++i) a.in[i] = (const float*)d_in[i];
    a.out = (float*)d_out; a.ws = (unsigned char*)d_ws;
#if MK_N_LAUNCHES == 1
    a.ph_lo = 0; a.ph_hi = 9;
    hipLaunchKernelGGL(fwd_kernel, dim3(grid), dim3(NWAVES * 64), LDS_BYTES, stream, a);
#else
    for (int ph = 0; ph < 9; ++ph) { a.ph_lo = ph; a.ph_hi = ph + 1; hipLaunchKernelGGL(fwd_kernel, dim3(grid), dim3(NWAVES * 64), LDS_BYTES, stream, a); }
#endif
    const hipError_t le = hipPeekAtLastError();
    if (le != hipSuccess) fprintf(stderr, "kernel_launch: launch failed: %s\n", hipGetErrorName(le));
}
```

```cpp
#include <hip/hip_runtime.h>
#include <cstdio>
#include <cstdint>

namespace pg8 {
#define PG8_LAS __attribute__((address_space(3)))
typedef unsigned short bf16_t;
typedef short bf16x8 __attribute__((ext_vector_type(8)));
typedef float f32x4 __attribute__((ext_vector_type(4)));
typedef float f32x2 __attribute__((ext_vector_type(2)));
typedef unsigned u32x4 __attribute__((ext_vector_type(4)));
typedef unsigned u32x2 __attribute__((ext_vector_type(2)));
constexpr int BM = 256, BK = 64, HALF = 128, HTB = HALF * BK * 2  , STAGE_BYTES = 8 * HTB, NXCD = 8, WGM = 8;

__host__ __device__ __forceinline__ int lds_byte(int r, int c) { const int st = (r >> 4) * 2 + (c >> 5), rr = r & 15, cc = c & 31, ob = rr * 64 + cc * 2; return st * 1024 + (ob ^ (((ob >> 9) & 1) << 5)); }
__host__ __device__ __forceinline__ void stage_rc(int b, int& R, int& C) { const int st = b / 1024, sb = b % 1024, swz = sb ^ (((sb >> 9) & 1) << 5); R = (st >> 1) * 16 + swz / 64; C = (st & 1) * 32 + (swz % 64) / 2; }
__host__ __device__ __forceinline__ int perm32(int rho) { const int n = rho >> 4, i = rho & 15; return 8 * (i >> 2) + 4 * n + (i & 3); }

struct Unit { int pm, pn, e, lr0, ui; };
struct Gemm { const bf16_t* A; int K; };

__device__ __forceinline__ bool order_tile(long L, int nM, int nN, int& pm, int& pn) {
    const int nwg = nM * nN; if (L >= nwg) return false;
    int wgid = (int)L; { const int q = nwg / NXCD, r = nwg % NXCD, xcd = wgid % NXCD, off = wgid / NXCD; wgid = (xcd < r ? xcd * (q + 1) : r * (q + 1) + (xcd - r) * q) + off; }
    const int nig = WGM * nN, gid = wgid / nig, fm = gid * WGM, gsz = (nM - fm) < WGM ? (nM - fm) : WGM;
    pm = fm + ((wgid % nig) % gsz); pn = (wgid % nig) / gsz; return true;
}

typedef float f32x2_t __attribute__((ext_vector_type(2))); typedef __bf16 bf16x2_t __attribute__((ext_vector_type(2)));
__device__ __forceinline__ unsigned cvt_pk_bf16(float lo, float hi) { f32x2_t v = {lo, hi}; bf16x2_t b = __builtin_convertvector(v, bf16x2_t); return __builtin_bit_cast(unsigned, b); }

typedef int v8i __attribute__((ext_vector_type(8))); typedef int v4i __attribute__((ext_vector_type(4)));
__device__ __forceinline__ v8i cat8(bf16x8 a, bf16x8 b) { return __builtin_shufflevector(__builtin_bit_cast(v4i, a), __builtin_bit_cast(v4i, b), 0, 1, 2, 3, 4, 5, 6, 7); }
template <class Epi, class Sched, bool F8 = false>
__device__ __forceinline__ void gemm_phase(PG8_LAS unsigned char* lds, const Gemm g, const Sched& S, const Epi& E) {
    int tid = threadIdx.x; asm volatile("" : "+v"(tid));
    const int wid = __builtin_amdgcn_readfirstlane(tid >> 6), lane = tid & 63, wr = wid >> 2, wc = wid & 3, fr = lane & 15, fq = lane >> 4;
    const int K = g.K, nt = K / BK;
    unsigned voffB[2]; int aR[2], aC[2];
#pragma unroll
    for (int i = 0; i < 2; ++i) { int R, C; stage_rc(tid * 16 + i * 8192, R, C); const int Rb = Epi::PERM ? ((R & ~31) + perm32(R & 31)) : R;
        aR[i] = R; aC[i] = C; voffB[i] = (unsigned)(Rb * K + C) * 2u; }
    const size_t kstep = (size_t)(BK * 2);
    const size_t hstep = (size_t)HALF * K * 2;
    const unsigned ldsw = (unsigned)wid * 1024u;
    const int aoff = lds_byte(wr * 64 + fr, fq * 8), boff = lds_byte(wc * 32 + fr, fq * 8);
#define PG8_SA(b, h) (((b) * 2 + (h)) * HTB)
#define PG8_SB(b, h) ((4 + (b) * 2 + (h)) * HTB)
#define PG8_STAGE(bufoff, gbase, voff) do { _Pragma("unroll") for (int _i = 0; _i < 2; ++_i) \
        __builtin_amdgcn_global_load_lds((const unsigned*)((const char*)(gbase) + (voff)[_i]), (PG8_LAS unsigned*)(lds + (bufoff) + ldsw + _i * 8192), 16, 0, 0); } while (0)
#define PG8_LDA(dst, b, h) do { if constexpr (F8) { _Pragma("unroll") for (int m = 0; m < 4; ++m) dst##8[m] = cat8(*(const PG8_LAS bf16x8*)(lds + PG8_SA(b, h) + aoff + m * 2048), *(const PG8_LAS bf16x8*)(lds + PG8_SA(b, h) + aoff + m * 2048 + 1024)); } \
        else { _Pragma("unroll") for (int m = 0; m < 4; ++m) _Pragma("unroll") for (int k = 0; k < 2; ++k) dst[m][k] = *(const PG8_LAS bf16x8*)(lds + PG8_SA(b, h) + aoff + m * 2048 + k * 1024); } } while (0)
#define PG8_LDB(dst, b, h) do { if constexpr (F8) { _Pragma("unroll") for (int n = 0; n < 2; ++n) dst##8[n] = cat8(*(const PG8_LAS bf16x8*)(lds + PG8_SB(b, h) + boff + n * 2048), *(const PG8_LAS bf16x8*)(lds + PG8_SB(b, h) + boff + n * 2048 + 1024)); } \
        else { _Pragma("unroll") for (int n = 0; n < 2; ++n) _Pragma("unroll") for (int k = 0; k < 2; ++k) dst[n][k] = *(const PG8_LAS bf16x8*)(lds + PG8_SB(b, h) + boff + n * 2048 + k * 1024); } } while (0)
#define PG8_MMA(ai, bj, At, Bt) do { __builtin_amdgcn_s_setprio(1); \
        if constexpr (F8) { _Pragma("unroll") for (int m = 0; m < 4; ++m) _Pragma("unroll") for (int n = 0; n < 2; ++n) \
            asm volatile("v_mfma_scale_f32_16x16x128_f8f6f4 %0, %1, %2, %0, %3, %4 op_sel_hi:[0,0,0]" : "+v"(acc[ai][bj][m][n]) : "v"(Bt##8[n]), "v"(At##8[m]), "v"(scW)  , "v"(scX)); } \
        else { _Pragma("unroll") for (int m = 0; m < 4; ++m) _Pragma("unroll") for (int n = 0; n < 2; ++n) _Pragma("unroll") for (int k = 0; k < 2; ++k) \
            acc[ai][bj][m][n] = __builtin_amdgcn_mfma_f32_16x16x32_bf16(Bt[n][k], At[m][k], acc[ai][bj][m][n], 0, 0, 0); } \
        __builtin_amdgcn_s_setprio(0); } while (0)
#define PG8_MMA_Z(ai, bj, At, Bt) do { __builtin_amdgcn_s_setprio(1); \
        if constexpr (F8) { _Pragma("unroll") for (int m = 0; m < 4; ++m) _Pragma("unroll") for (int n = 0; n < 2; ++n) \
            asm volatile("v_mfma_scale_f32_16x16x128_f8f6f4 %0, %1, %2, 0, %3, %4 op_sel_hi:[0,0,0]" : "=&v"(acc[ai][bj][m][n]) : "v"(Bt##8[n]), "v"(At##8[m]), "v"(scW), "v"(scX)); } \
        else { _Pragma("unroll") for (int m = 0; m < 4; ++m) _Pragma("unroll") for (int n = 0; n < 2; ++n) { \
            acc[ai][bj][m][n] = __builtin_amdgcn_mfma_f32_16x16x32_bf16(Bt[n][0], At[m][0], (f32x4){0.f, 0.f, 0.f, 0.f}, 0, 0, 0); \
            acc[ai][bj][m][n] = __builtin_amdgcn_mfma_f32_16x16x32_bf16(Bt[n][1], At[m][1], acc[ai][bj][m][n], 0, 0, 0); } } \
        __builtin_amdgcn_s_setprio(0); } while (0)
#define PG8_WAIT_V(n) asm volatile("s_waitcnt vmcnt(" #n ")" ::: "memory")
#define PG8_WAIT_L(n) asm volatile("s_waitcnt lgkmcnt(" #n ")" ::: "memory")
#define PG8_BAR __builtin_amdgcn_s_barrier()
#define PG8_SCHED __builtin_amdgcn_sched_barrier(0)
    Unit cur, nxt; int ui = 0;
    if (!S.next(0, cur)) return;
    f32x4 acc[2][2][4][2];
    const int scW = 0x7A7A7A7A, scX = 0x7F7F7F7F;
    bf16x8 At[4][2], B0[2][2], B1[2][2]; v8i At8[4], B08[2], B18[2];
    constexpr bool GA = Sched::GATHER;
    constexpr int H1 = GA ? 1 : 0;
    const size_t HS = GA ? (size_t)0 : hstep;
    const char* cA = GA ? (const char*)g.A : (const char*)g.A + S.aoff_uniform(cur);
    const char* cB = S.bptr(cur);
    unsigned aoC[2][2], aoN[2][2];
    if constexpr (GA) S.aoffs(cur, aR, aC, aoC);
    else {
#pragma unroll
        for (int i = 0; i < 2; ++i) aoC[0][i] = (unsigned)(aR[i] * K + aC[i]) * 2u; }
    PG8_STAGE(PG8_SB(0, 0), cB, voffB); PG8_STAGE(PG8_SB(0, 1), cB + hstep, voffB); PG8_STAGE(PG8_SA(0, 0), cA, aoC[0]); PG8_STAGE(PG8_SA(0, 1), cA + HS, aoC[H1]);
    if (wr == 1) PG8_BAR;
    PG8_WAIT_V(2); PG8_BAR;
    PG8_STAGE(PG8_SB(1, 0), cB + kstep, voffB); PG8_STAGE(PG8_SA(1, 0), cA + kstep, aoC[0]); PG8_STAGE(PG8_SB(1, 1), cB + hstep + kstep, voffB);
    PG8_WAIT_V(6); PG8_BAR;
    for (;;) {
        if constexpr (Epi::PREFETCH) E.prefetch(cur, lds + 152064 + (ui & 1) * 2048, wid, lane);
        const bool has_next = S.next(ui + 1, nxt);
        const char* nB = has_next ? S.bptr(nxt) : cB;
        const char* nA = GA ? cA : (has_next ? (const char*)g.A + S.aoff_uniform(nxt) : cA);
        if constexpr (GA) {
            if (has_next) S.aoffs(nxt, aR, aC, aoN);
            else {
#pragma unroll
                for (int h = 0; h < 2; ++h)
#pragma unroll
                    for (int i = 0; i < 2; ++i) aoN[h][i] = aoC[h][i]; } }
#define PG8_TRIP(t, last, MM) do { \
            const char* a1 = cA + (size_t)((t) + 1) * kstep;                                             \
            const char* a2 = (last) ? nA : cA + (size_t)((t) + 2) * kstep; const char* b2 = (last) ? nB : cB + (size_t)((t) + 2) * kstep;     \
            const char* a3 = a2 + kstep; const char* b3 = b2 + kstep;                                \
            unsigned ao2[2][2]; \
            if constexpr (GA) { _Pragma("unroll") for (int h = 0; h < 2; ++h) _Pragma("unroll") for (int i = 0; i < 2; ++i) ao2[h][i] = (last) ? aoN[h][i] : aoC[h][i]; } \
            else { _Pragma("unroll") for (int i = 0; i < 2; ++i) ao2[0][i] = aoC[0][i]; } \
              \
            PG8_LDB(B0, 0, 0); PG8_LDB(B1, 0, 1); PG8_SCHED; PG8_LDA(At, 0, 0); PG8_STAGE(PG8_SA(1, 1), a1 + HS, aoC[H1]); \
            PG8_WAIT_V(8); PG8_WAIT_L(0); PG8_BAR; MM(0, 0, At, B0); MM(0, 1, At, B1); PG8_BAR; PG8_SCHED; \
              \
            PG8_LDA(At, 0, 1); PG8_STAGE(PG8_SB(0, 0), b2, voffB); PG8_STAGE(PG8_SB(0, 1), b2 + hstep, voffB); PG8_STAGE(PG8_SA(0, 0), a2, ao2[0]); \
            PG8_WAIT_V(8); PG8_WAIT_L(0); PG8_BAR; MM(1, 0, At, B0); MM(1, 1, At, B1); PG8_BAR; PG8_SCHED; \
              \
            PG8_LDB(B0, 1, 0); PG8_LDB(B1, 1, 1); PG8_SCHED; PG8_LDA(At, 1, 0); PG8_STAGE(PG8_SA(0, 1), a2 + HS, ao2[H1]); \
            PG8_WAIT_V(8); PG8_WAIT_L(0); PG8_BAR; PG8_MMA(0, 0, At, B0); PG8_MMA(0, 1, At, B1); PG8_BAR; PG8_SCHED; \
              \
            PG8_LDA(At, 1, 1); PG8_STAGE(PG8_SB(1, 0), b3, voffB); PG8_STAGE(PG8_SB(1, 1), b3 + hstep, voffB); PG8_STAGE(PG8_SA(1, 0), a3, ao2[0]); \
            PG8_WAIT_V(8); PG8_WAIT_L(0); PG8_BAR; PG8_MMA(1, 0, At, B0); PG8_MMA(1, 1, At, B1); PG8_BAR; PG8_SCHED; \
        } while (0)
        if constexpr (F8) { PG8_TRIP(0, false, PG8_MMA_Z); }
        else {
#pragma unroll
            for (int a = 0; a < 2; ++a)
#pragma unroll
                for (int b = 0; b < 2; ++b)
#pragma unroll
                    for (int m = 0; m < 4; ++m)
#pragma unroll
                        for (int n = 0; n < 2; ++n) acc[a][b][m][n] = (f32x4){0.f, 0.f, 0.f, 0.f};
        }
#pragma unroll 1
        for (int t = F8 ? 2 : 0; t < nt; t += 2) PG8_TRIP(t, t == nt - 2, PG8_MMA);
#undef PG8_TRIP
        if (wr == 0) PG8_BAR;
        if constexpr (F8) asm volatile("s_nop 15\n\ts_nop 15" ::: "memory");
        { int l2 = lane; asm volatile("" : "+v"(l2)); if constexpr (Epi::PREFETCH) E(acc, cur, wr, wc, l2 & 15, l2 >> 4, lds + 152064 + (ui & 1) * 2048); else E(acc, cur, wr, wc, l2 & 15, l2 >> 4); }
        if (!has_next) break;
        cur = nxt; cB = nB; cA = nA; ++ui;
        if constexpr (GA) {
#pragma unroll
            for (int h = 0; h < 2; ++h)
#pragma unroll
                for (int i = 0; i < 2; ++i) aoC[h][i] = aoN[h][i]; }
        if (wr == 1) PG8_BAR;
    }
    PG8_WAIT_V(0);
    PG8_BAR;
#undef PG8_SA
#undef PG8_SB
#undef PG8_STAGE
#undef PG8_LDA
#undef PG8_LDB
#undef PG8_MMA
#undef PG8_MMA_Z
#undef PG8_WAIT_V
#undef PG8_WAIT_L
#undef PG8_BAR
#undef PG8_SCHED
}
}

constexpr int NWAVES = 8;
constexpr int BATCH = 16, SEQ = 2048, D = 1024, NTOK = BATCH * SEQ;
constexpr int INW = 3080, NPROJ = 3072;
constexpr int NE = 32, TOPK = 4, FF = 1024, PLE = 256;
constexpr int HD = 64, NFOX = 8, NDIFF = 4;
constexpr int CQF = 0, CKF = 512, CVF = 1024, CQD = 1536, CKD = 2048, CVD = 2560;
constexpr float EPS = 1e-6f;
constexpr float LOG2E = 1.4426950408889634f;
constexpr float C2 = 0.125f * LOG2E;
constexpr int MAXTILES = 544;
constexpr int ECAP = NTOK;

constexpr size_t MiB = 1u << 20;
constexpr size_t WS_CTL = 0, CTL_ZERO_BYTES = 1 * MiB;
constexpr size_t WS_WRH = 1 * MiB, WS_WRL = WS_WRH + 65536, WS_B1P = WS_WRL + 65536;
constexpr size_t WS_LF = 2 * MiB, WS_CS = 3 * MiB;
constexpr size_t WS_TP = 4 * MiB, WS_RS3 = 4 * MiB + 512 * 1024;
constexpr size_t WS_RD0 = 4 * MiB + 768 * 1024;
constexpr size_t WS_TOKE = 5 * MiB, WS_GATEE = 9 * MiB, WS_RSE = 13 * MiB;
constexpr size_t WS_WIN = 17 * MiB, WS_WOUT = 23 * MiB, WS_WG = 25 * MiB, WS_WP = 27 * MiB;
constexpr size_t WS_W1 = 28 * MiB, WS_W2 = 156 * MiB;
constexpr size_t WS_PB = 220 * MiB, WS_PP = 236 * MiB;
constexpr size_t WS_PROJ = 300 * MiB, WS_MIXED = 492 * MiB, WS_A0 = 556 * MiB;
constexpr size_t WS_Y = WS_PROJ;
constexpr size_t WS_HB = 620 * MiB;
constexpr size_t WS_A3 = WS_HB;
constexpr size_t WS_H1B = 756 * MiB, WS_H2B = 820 * MiB;
constexpr size_t WS_END = 892 * MiB;
constexpr int CW_TMO = 0, CW_BAR = 4096, CW_CNT = 8192;

constexpr int RING_OFF = 0, RING_BYTES = 131072;
constexpr int TOKL_OFF = RING_BYTES, TOKL_BYTES = 18 * 1024;
constexpr int TILEE_OFF = TOKL_OFF + TOKL_BYTES, TILEE_BYTES = 2304;
constexpr int MISC_OFF = TILEE_OFF + TILEE_BYTES;
constexpr int EPI_OFF = MISC_OFF + 256, EPI_BYTES = 4096;
constexpr int LDS_BYTES = EPI_OFF + EPI_BYTES;
static_assert(EPI_OFF == 152064, "gemm_phase addresses the epilogue prefetch buffers at this offset");
static_assert(LDS_BYTES <= 160 * 1024, "LDS");

#define GAS __attribute__((address_space(1)))
#define LAS __attribute__((address_space(3)))
typedef unsigned short bf16;
typedef unsigned v4u __attribute__((ext_vector_type(4)));
typedef float f32x4 __attribute__((ext_vector_type(4)));
typedef short bf16x8 __attribute__((ext_vector_type(8)));
typedef GAS unsigned gu32;
typedef GAS unsigned long long gu64;
#define RLX_AGENT __ATOMIC_RELAXED, __HIP_MEMORY_SCOPE_AGENT
#define LDS_WAIT() asm volatile("s_waitcnt lgkmcnt(0)" ::: "memory")
#define VM_WAIT() asm volatile("s_waitcnt vmcnt(0)" ::: "memory")
__device__ __forceinline__ unsigned long long rt() { return __builtin_amdgcn_s_memrealtime(); }
__device__ __forceinline__ unsigned f2bf(float f) { unsigned u = __builtin_bit_cast(unsigned, f); return (u + 0x7fffu + ((u >> 16) & 1u)) >> 16; }
__device__ __forceinline__ unsigned pk2(float lo, float hi) { return f2bf(lo) | (f2bf(hi) << 16); }
#define XB_TMO      128
#define XB_XCNT(j)  (256  + 64 * (j))
#define XB_XSUB(j)  (1280 + 64 * (j))
#define XB_XGEN(j)  (2304 + 64 * (j))
#define XB_TOP      3328
#define XB_TOPGEN   3392
#define XCD_BAR_WORDS 3456
#define XB_SPIN_CAP (1u << 18)

__device__ __forceinline__ unsigned xb_ld(unsigned* p)              { return __hip_atomic_load(p, __ATOMIC_RELAXED, __HIP_MEMORY_SCOPE_AGENT); }
__device__ __forceinline__ unsigned xb_add(unsigned* p, unsigned v) { return __hip_atomic_fetch_add(p, v, __ATOMIC_RELAXED, __HIP_MEMORY_SCOPE_AGENT); }
__device__ __forceinline__ unsigned xb_xcc_id() { return (unsigned)__builtin_amdgcn_s_getreg((3 << 11) | 20) & 0xFu; }
#define XB_SPIN(cond, bar) do { unsigned _sp = 0; while (cond) { __builtin_amdgcn_s_sleep(1); \
    if ((++_sp & 255u) == 0u) { if (xb_ld(&(bar)[XB_TMO])) break; if (_sp > XB_SPIN_CAP) { atomicAdd(&(bar)[XB_TMO], 1u); break; } } } } while (0)

struct XcdBarrier {
    unsigned* bar; unsigned x;
    volatile LAS unsigned* st;
};

__device__ __forceinline__ XcdBarrier xcd_barrier_post(unsigned* bar, volatile LAS unsigned* st) {
    XcdBarrier b; b.bar = bar; b.x = xb_xcc_id(); b.st = st;
    if (threadIdx.x == 0) (void)xb_add(&bar[XB_XCNT(b.x)], 1u);
    return b;
}
__device__ __forceinline__ void xcd_barrier_complete(unsigned* bar, unsigned x, unsigned& nloc, unsigned& nx) {
    const unsigned G = gridDim.x * gridDim.y * gridDim.z;
    unsigned sum, cnt, mine, sp = 0u;
    for (;;) {
        sum = 0u; cnt = 0u; mine = 0u;
#pragma unroll
        for (unsigned j = 0; j < 16; ++j) { const unsigned c = xb_ld(&bar[XB_XCNT(j)]); sum += c; cnt += (c > 0u) ? 1u : 0u; mine = (j == x) ? c : mine; }
        if (sum == G) break;
        __builtin_amdgcn_s_sleep(1);
        if ((++sp & 255u) == 0u) { if (xb_ld(&bar[XB_TMO])) break; if (sp > XB_SPIN_CAP) { atomicAdd(&bar[XB_TMO], 1u); break; } }
    }
    nloc = mine > 0u ? mine : 1u; nx = cnt > 0u ? cnt : 1u;
}

__device__ __forceinline__ void xcd_barrier(const XcdBarrier& b) {
    asm volatile("s_waitcnt vmcnt(0)" ::: "memory");
    __syncthreads();
    if (threadIdx.x == 0) {
        unsigned* bar = b.bar;
        __builtin_amdgcn_s_waitcnt(0);
        unsigned nloc = b.st[0], nx = b.st[1];
        if (nloc == 0u) { xcd_barrier_complete(bar, b.x, nloc, nx); b.st[0] = nloc; b.st[1] = nx; }
        const unsigned old = xb_add(&bar[XB_XSUB(b.x)], 1u);
        const unsigned gen = old / nloc;
        if (old + 1u == (gen + 1u) * nloc) {
            __builtin_amdgcn_fence(__ATOMIC_RELEASE, "agent");
            asm volatile("s_waitcnt vmcnt(0)" ::: "memory");
            const unsigned og = xb_add(&bar[XB_TOP], 1u);
            const unsigned tg = og / nx;
            if (og + 1u == (tg + 1u) * nx) xb_add(&bar[XB_TOPGEN], 1u);
            else XB_SPIN(xb_ld(&bar[XB_TOPGEN]) == tg, bar);
            __builtin_amdgcn_fence(__ATOMIC_ACQUIRE, "agent");
            xb_add(&bar[XB_XGEN(b.x)], 1u);
            asm volatile("s_waitcnt vmcnt(0)" ::: "memory");
        } else {
            XB_SPIN(xb_ld(&bar[XB_XGEN(b.x)]) == gen, bar);
            __builtin_amdgcn_fence(__ATOMIC_ACQUIRE, "agent");
            asm volatile("s_waitcnt vmcnt(0)" ::: "memory");
        }
    }
    __syncthreads();
}

namespace attn_body {
using bf16x8=__attribute__((ext_vector_type(8)))short;
using s16x4=__attribute__((ext_vector_type(4)))short;
using f32x16=__attribute__((ext_vector_type(16)))float;
using f32x4a=__attribute__((ext_vector_type(4)))float;
using u32x4=__attribute__((ext_vector_type(4)))unsigned;
constexpr int PQ=3072;
constexpr int NW=8,QBLK=32,QB=QBLK*NW,KVBLK=64;
__device__ __forceinline__ int crow(int r,int hi){return (r&3)+8*(r>>2)+4*hi;}
#define SBAR() __builtin_amdgcn_sched_barrier(0)
__device__ __forceinline__ void cmask(f32x16&p0,f32x16&p1,int jb,int qrel,int hi){
  const float NEG=-INFINITY; int kb=64*jb+4*hi;
  #pragma unroll
  for(int r=0;r<16;++r){int kv=kb+(r&3)+8*(r>>2); if(kv>qrel)p0[r]=NEG; if(kv+32>qrel)p1[r]=NEG;}
}
constexpr int NSLOT=3, SLOTB=8192;
constexpr int LDS_K=0, LDS_V=NSLOT*SLOTB, LDS_WS=2*NSLOT*SLOTB, LDS_OST=LDS_WS+NW*64*4, LDS_BYTES=LDS_OST+NW*4096;
constexpr int LDS_TAB=86016, LDS_ZERO=LDS_TAB+32768;
__device__ __forceinline__ void glds16(const void*gsrc,unsigned lds_dst){unsigned keep;
  asm volatile("s_mov_b32 %0, m0\n\ts_mov_b32 m0, %2\n\ts_nop 0\n\tglobal_load_lds_dwordx4 %1, off\n\ts_mov_b32 m0, %0":"=&s"(keep):"v"(gsrc),"s"(lds_dst):"memory");}
typedef float f32x2_t __attribute__((ext_vector_type(2))); typedef __bf16 bf16x2_t __attribute__((ext_vector_type(2)));
__device__ __forceinline__ unsigned cvtpk_s(float lo,float hi){f32x2_t v={lo,hi};bf16x2_t b=__builtin_convertvector(v,bf16x2_t);return __builtin_bit_cast(unsigned,b);}
#define WAIT_BAR(N) asm volatile("s_waitcnt vmcnt(" #N ") lgkmcnt(0)\n\ts_barrier":::"memory")
typedef __attribute__((address_space(3))) const char* lds_cptr;
typedef short v4i16_t __attribute__((ext_vector_type(4)));
__device__ __forceinline__ void kload8(bf16x8*kf,lds_cptr kp){
  kf[0]=*(const __attribute__((address_space(3))) bf16x8*)(kp);      kf[1]=*(const __attribute__((address_space(3))) bf16x8*)(kp+512);
  kf[2]=*(const __attribute__((address_space(3))) bf16x8*)(kp+2048); kf[3]=*(const __attribute__((address_space(3))) bf16x8*)(kp+2560);
  kf[4]=*(const __attribute__((address_space(3))) bf16x8*)(kp+4096); kf[5]=*(const __attribute__((address_space(3))) bf16x8*)(kp+4608);
  kf[6]=*(const __attribute__((address_space(3))) bf16x8*)(kp+6144); kf[7]=*(const __attribute__((address_space(3))) bf16x8*)(kp+6656);
}
__device__ __forceinline__ void kload2(bf16x8*kf,lds_cptr kp,int j){ kf[2*j]=*(const __attribute__((address_space(3))) bf16x8*)(kp+j*2048); kf[2*j+1]=*(const __attribute__((address_space(3))) bf16x8*)(kp+j*2048+512); }
__device__ __forceinline__ s16x4 vtr(lds_cptr p){ return __builtin_bit_cast(s16x4,__builtin_amdgcn_ds_read_tr16_b64_v4i16((__attribute__((address_space(3))) v4i16_t*)p)); }
__device__ __forceinline__ void pv(f32x16*o,int vb,bf16x8 pa0,bf16x8 pa1,bf16x8 pa2,bf16x8 pa3){
  #pragma unroll
  for(int d0=0;d0<2;++d0){s16x4 lo[4],hi[4];
    #pragma unroll
    for(int ks=0;ks<4;++ks){
      asm volatile("ds_read_b64_tr_b16 %0,%1 offset:%c2":"=&v"(lo[ks]):"v"(vb),"i"(d0*4096+ks*1024):"memory");
      asm volatile("ds_read_b64_tr_b16 %0,%1 offset:%c2":"=&v"(hi[ks]):"v"(vb),"i"(d0*4096+ks*1024+512):"memory");}
    asm volatile("s_waitcnt lgkmcnt(0)":::"memory");SBAR();
    #define PK(k) (bf16x8){lo[k][0],lo[k][1],lo[k][2],lo[k][3],hi[k][0],hi[k][1],hi[k][2],hi[k][3]}
    o[d0]=__builtin_amdgcn_mfma_f32_32x32x16_bf16(pa0,PK(0),o[d0],0,0,0);
    o[d0]=__builtin_amdgcn_mfma_f32_32x32x16_bf16(pa1,PK(1),o[d0],0,0,0);
    o[d0]=__builtin_amdgcn_mfma_f32_32x32x16_bf16(pa2,PK(2),o[d0],0,0,0);
    o[d0]=__builtin_amdgcn_mfma_f32_32x32x16_bf16(pa3,PK(3),o[d0],0,0,0);
    #undef PK
  }
}
typedef __attribute__((address_space(3))) const float* lds_fptr;
__device__ __forceinline__ void split3(float x,unsigned&h,unsigned&m,unsigned&l){ h=f2bf(x); const float r1=x-__builtin_bit_cast(float,h<<16); m=f2bf(r1); const float r2=r1-__builtin_bit_cast(float,m<<16); l=f2bf(r2); }
__device__ __forceinline__ bf16x8 mk_qm(float mhat,int hi){ unsigned h,m,l; split3(-mhat,h,m,l);
  u32x4 w; w[0]=0x3F803F80u; w[1]=0x3F80u|(h<<16); w[2]=m|(l<<16); w[3]=0u; if(hi){w[0]=0u;w[1]=0u;w[2]=0u;} return __builtin_bit_cast(bf16x8,w); }
__device__ __forceinline__ void bias_add(f32x16&X0,f32x16&X1,lds_fptr tb,int t){
  const lds_fptr p=tb+64*t;
  #pragma unroll
  for(int r=0;r<16;++r){ X0[r]+=p[(r&3)+8*(r>>2)]; X1[r]+=p[32+(r&3)+8*(r>>2)]; }
}
#ifndef ATTN_STORE16
#define ATTN_STORE16(p,v) (*(u32x4*)(p)=(v))
#endif
template<int THRL,int MODE,int PO,bool NOMAX> __device__ __forceinline__ void attn_unit(int q0,int NTp,const bf16*Q,const bf16*__restrict__ K,const bf16*__restrict__ V,bf16*O,char*shm,lds_fptr csq){
  int tid=threadIdx.x; asm volatile("":"+v"(tid));
  const int lane=tid&63,r32=lane&31,hi=lane>>5; const int wid=__builtin_amdgcn_readfirstlane(tid>>6);
  const bf16*Qw=Q+(long)(q0+wid*QBLK)*PQ;
  const unsigned lds0=(unsigned)(uintptr_t)shm;
  float*wsf=(float*)(shm+LDS_WS)+wid*64;
  const bf16*ksrc=K+(long)lane*PQ+wid*8;
  const bf16*vsrc=V+(long)(16*(wid&3)+(lane>>2))*PQ+(wid>>2)*32+(lane&3)*8;
  const unsigned kdst=lds0+LDS_K+wid*1024, vdst=lds0+LDS_V+wid*1024;
  #define DMA_K(t,slot) glds16(ksrc+(long)(t)*KVBLK*PQ,(unsigned)__builtin_amdgcn_readfirstlane(kdst+(slot)))
  #define DMA_V(t,slot) glds16(vsrc+(long)(t)*KVBLK*PQ,(unsigned)__builtin_amdgcn_readfirstlane(vdst+(slot)))
  const int vb0=(int)(lds0+LDS_V)+((lane>>4)&1)*32+(lane&3)*8+(4*hi+((lane&15)>>2))*64;
  bf16x8 kf[8];
  const lds_cptr shm3=(lds_cptr)shm; const lds_cptr kp0=shm3+LDS_K+hi*1024+r32*16; const lds_cptr vp0=shm3+LDS_V+((lane>>4)&1)*32+(lane&3)*8+(4*hi+((lane&15)>>2))*64;
  const int qrel=wid*QBLK+r32;
  const lds_fptr tb=(lds_fptr)(shm3+LDS_TAB)+(2047-(q0+qrel))+4*hi;
  const lds_cptr kbp=hi?(shm3+LDS_ZERO-16*64*0):(shm3+LDS_TAB+16*r32);
  const int kbs=hi?0:1024;
  bf16x8 kb0,kb1;
  { u32x4 w; w[0]=0u; w[1]=hi?0u:0x3F800000u; w[2]=hi?0u:0x3F803F80u; w[3]=0u; kb0=__builtin_bit_cast(bf16x8,w); kb1=kb0; }
  #define KBLD(t) do{ if(MODE==0){ kb0=*(const __attribute__((address_space(3))) bf16x8*)(kbp+(t)*kbs); kb1=*(const __attribute__((address_space(3))) bf16x8*)(kbp+(t)*kbs+(hi?0:512)); } }while(0)
  bf16x8 qm=mk_qm(0.f,hi);
  const int NT=NTp;
  DMA_K(0,0);DMA_V(0,0);DMA_K(1,SLOTB);
  bf16x8 qr[4];
  #pragma unroll
  for(int d0=0;d0<4;++d0)qr[d0]=*reinterpret_cast<const bf16x8*>(&Qw[(long)r32*PQ+d0*16+hi*8]);
  float mhat=0.f,l_reg=0.f;f32x16 o[2];o[0]=f32x16{};o[1]=f32x16{};
  #define CMASK(P0,P1,t) do{int jb_=(t)-(NT-4); if(jb_>=0&&64*jb_+63>wid*QBLK)cmask(P0,P1,jb_,qrel,hi);}while(0)
  bool resc=false;
  #define RESC() do{ if(resc){ asm volatile("s_waitcnt lgkmcnt(0)":::"memory"); \
      _Pragma("unroll") for(int d_=0;d_<2;++d_) _Pragma("unroll") for(int r=0;r<16;++r)o[d_][r]*=wsf[crow(r,hi)]; } }while(0)
  f32x16 pA0,pA1,pB0,pB1;
  int sl_prev=0,sl_cur=0,sl_next=SLOTB;
  #define ROT() do{sl_prev=sl_cur;sl_cur=sl_next;sl_next=(sl_next==(NSLOT-1)*SLOTB)?0:sl_next+SLOTB;}while(0)
  DMA_K(2,2*SLOTB);
  KBLD(0);
  WAIT_BAR(3);
  { const lds_cptr kb=kp0; const f32x16 z16=f32x16{};
    pA0=__builtin_amdgcn_mfma_f32_32x32x16_bf16(kb0,qm,z16,0,0,0); pA1=__builtin_amdgcn_mfma_f32_32x32x16_bf16(kb1,qm,z16,0,0,0);
    #pragma unroll
    for(int d0=0;d0<4;++d0){ const bf16x8 b0=*(const __attribute__((address_space(3))) bf16x8*)(kb+d0*2048), b1=*(const __attribute__((address_space(3))) bf16x8*)(kb+d0*2048+512);
      pA0=__builtin_amdgcn_mfma_f32_32x32x16_bf16(b0,qr[d0],pA0,0,0,0); pA1=__builtin_amdgcn_mfma_f32_32x32x16_bf16(b1,qr[d0],pA1,0,0,0); } }
  if(MODE==1&&NT<=6)bias_add(pA0,pA1,tb,0);
  CMASK(pA0,pA1,0);
  { float rm=fmaxf(pA0[0],pA1[0]);
    #pragma unroll
    for(int r=1;r<16;++r)rm=fmaxf(rm,fmaxf(pA0[r],pA1[r]));
    { auto rr=__builtin_amdgcn_permlane32_swap(__float_as_uint(rm),__float_as_uint(rm),false,false); rm=fmaxf(__uint_as_float(rr[0]),__uint_as_float(rr[1])); }
    if(MODE==0)rm=fmaxf(rm,csq[qrel]);
    mhat=rm;
    #pragma unroll
    for(int r=0;r<16;++r){pA0[r]=__builtin_amdgcn_exp2f(pA0[r]-rm);pA1[r]=__builtin_amdgcn_exp2f(pA1[r]-rm);} }
  qm=mk_qm(mhat,hi); KBLD(1);
  WAIT_BAR(0);
  DMA_K(3,0);DMA_V(1,SLOTB);
  ROT();
  kload8(kf,kp0+sl_cur);
  WAIT_BAR(2);
  s16x4 vlo[8],vhi[8]; u32x4 pw0,pw1,pw2,pw3;
  #define PKW(P,B) cvtpk_s(P[B],P[B+1])
  #define PAF(k) __builtin_bit_cast(bf16x8,pw##k)
  #define VFR(i) (bf16x8){vlo[i][0],vlo[i][1],vlo[i][2],vlo[i][3],vhi[i][0],vhi[i][1],vhi[i][2],vhi[i][3]}
  #define PIN(x) asm volatile("":"+v"(x))
  #define MX3(a,b,c) __builtin_fmaxf(__builtin_fmaxf((a),(b)),(c))
  #define GAPA(MF,A0,A1,A2,A3,W0,W1,PW) do{ MF; sacc+=A0; sacc+=A1; sacc+=A2; sacc+=A3; PIN(sacc); W0; W1; PIN(PW); SBAR(); }while(0)
  #define EX(v) __builtin_amdgcn_exp2f(v)
  #define GAPB(MF,X,B) do{ MF; X[B]=EX(X[B]); X[B+1]=EX(X[B+1]); X[B+2]=EX(X[B+2]); X[B+3]=EX(X[B+3]); PIN(X); SBAR(); }while(0)
  #define VRD(i) do{ vlo[i]=vtr(vp_+(((i)>>2)*4096+((i)&3)*1024)); vhi[i]=vtr(vp_+(((i)>>2)*4096+((i)&3)*1024+512)); }while(0)
  #define KRD(G,j) do{ if(G){ kload2(kf,kp0+sl_next,j); SBAR(); } }while(0)
  #define STEP(C0,C1,P0,P1,t,GK,GV,GL,GB) do{ SBAR(); \
    const lds_cptr vp_=vp0+sl_prev; \
    C0=__builtin_amdgcn_mfma_f32_32x32x16_bf16(kb0,qm,f32x16{},0,0,0); C1=__builtin_amdgcn_mfma_f32_32x32x16_bf16(kb1,qm,f32x16{},0,0,0); SBAR(); \
    VRD(0); SBAR(); float sacc=(P0[0]+P0[1]); \
    GAPA(C0=__builtin_amdgcn_mfma_f32_32x32x16_bf16(kf[0],qr[0],C0,0,0,0), P0[2],P0[3],P0[4],P0[5],     pw0[0]=PKW(P0,0), pw0[1]=PKW(P0,2), pw0); \
    VRD(4); SBAR(); GAPA(C1=__builtin_amdgcn_mfma_f32_32x32x16_bf16(kf[1],qr[0],C1,0,0,0), P0[6],P0[7],P0[8],P0[9],     pw0[2]=PKW(P0,4), pw0[3]=PKW(P0,6), pw0); \
    VRD(1); SBAR(); GAPA(C0=__builtin_amdgcn_mfma_f32_32x32x16_bf16(kf[2],qr[1],C0,0,0,0),   P0[10],P0[11],P0[12],P0[13], pw1[0]=PKW(P0,8), pw1[1]=PKW(P0,10), pw1); \
    VRD(5); SBAR(); GAPA(C1=__builtin_amdgcn_mfma_f32_32x32x16_bf16(kf[3],qr[1],C1,0,0,0),   P0[14],P0[15],P1[0],P1[1],   pw1[2]=PKW(P0,12),pw1[3]=PKW(P0,14), pw1); \
    VRD(2); SBAR(); GAPA(C0=__builtin_amdgcn_mfma_f32_32x32x16_bf16(kf[4],qr[2],C0,0,0,0),   P1[2],P1[3],P1[4],P1[5],     pw2[0]=PKW(P1,0), pw2[1]=PKW(P1,2), pw2); \
    VRD(6); SBAR(); GAPA(C1=__builtin_amdgcn_mfma_f32_32x32x16_bf16(kf[5],qr[2],C1,0,0,0),   P1[6],P1[7],P1[8],P1[9],     pw2[2]=PKW(P1,4), pw2[3]=PKW(P1,6), pw2); \
    VRD(3); SBAR(); GAPA(C0=__builtin_amdgcn_mfma_f32_32x32x16_bf16(kf[6],qr[3],C0,0,0,0),   P1[10],P1[11],P1[12],P1[13], pw3[0]=PKW(P1,8), pw3[1]=PKW(P1,10), pw3); \
    VRD(7); SBAR(); GAPA(C1=__builtin_amdgcn_mfma_f32_32x32x16_bf16(kf[7],qr[3],C1,0,0,0),   P1[14],P1[15],0.f,0.f,       pw3[2]=PKW(P1,12),pw3[3]=PKW(P1,14), pw3); \
    l_reg+=sacc; \
    if(GK){DMA_K((t)+3,sl_cur);} if(GV){DMA_V((t)+1,sl_next);} \
    BADD(C0,C1,t); CMASK(C0,C1,t); \
    if constexpr(!NOMAX){ float a=MX3(C0[0],C0[1],C1[0]),b=MX3(C0[2],C0[3],C1[1]); a=MX3(a,C1[2],C1[3]); \
      _Pragma("unroll") for(int r=4;r<16;r+=4){a=MX3(a,C0[r],C0[r+1]);b=MX3(b,C0[r+2],C0[r+3]);a=MX3(a,C1[r],C1[r+1]);b=MX3(b,C1[r+2],C1[r+3]);} \
      float rm=__builtin_fmaxf(a,b); { auto rr=__builtin_amdgcn_permlane32_swap(__float_as_uint(rm),__float_as_uint(rm),false,false); rm=__builtin_fmaxf(__uint_as_float(rr[0]),__uint_as_float(rr[1])); } \
      resc=false; \
      if(__builtin_expect(__any(rm>(float)THRL),0)){ const float dl=__builtin_fmaxf(rm,0.f); mhat+=dl; \
        _Pragma("unroll") for(int r=0;r<16;++r){C0[r]-=dl;C1[r]-=dl;} \
        qm=mk_qm(mhat,hi); \
        const float f=__builtin_amdgcn_exp2f(-dl); l_reg*=f; if(hi==0)wsf[r32]=f; resc=true; } } \
    SBAR(); \
    GAPB(o[0]=__builtin_amdgcn_mfma_f32_32x32x16_bf16(PAF(0),VFR(0),o[0],0,0,0), C0,0); \
    GAPB(o[1]=__builtin_amdgcn_mfma_f32_32x32x16_bf16(PAF(0),VFR(4),o[1],0,0,0), C0,4); \
    if(GL){KBLD((t)+1);} KRD(GL,0); GAPB(o[0]=__builtin_amdgcn_mfma_f32_32x32x16_bf16(PAF(1),VFR(1),o[0],0,0,0), C0,8); \
    KRD(GL,1); GAPB(o[1]=__builtin_amdgcn_mfma_f32_32x32x16_bf16(PAF(1),VFR(5),o[1],0,0,0), C0,12); \
    KRD(GL,2); GAPB(o[0]=__builtin_amdgcn_mfma_f32_32x32x16_bf16(PAF(2),VFR(2),o[0],0,0,0), C1,0); \
    KRD(GL,3); GAPB(o[1]=__builtin_amdgcn_mfma_f32_32x32x16_bf16(PAF(2),VFR(6),o[1],0,0,0), C1,4); \
    GAPB(o[0]=__builtin_amdgcn_mfma_f32_32x32x16_bf16(PAF(3),VFR(3),o[0],0,0,0), C1,8); \
    GAPB(o[1]=__builtin_amdgcn_mfma_f32_32x32x16_bf16(PAF(3),VFR(7),o[1],0,0,0), C1,12); \
    }while(0)
  int t=1;
  #undef CMASK
  #define CMASK(P0,P1,t) do{}while(0)
  #define BADD(P0,P1,t) do{}while(0)
  for(;t+(MODE==1?7:5)<NT;t+=2){
    STEP(pB0,pB1,pA0,pA1,t,true,true,true,true);     WAIT_BAR(2); RESC(); ROT();
    STEP(pA0,pA1,pB0,pB1,t+1,true,true,true,true);   WAIT_BAR(2); RESC(); ROT();
  }
  #undef CMASK
  #undef BADD
  #define CMASK(P0,P1,t) do{int jb_=(t)-(NT-4); if(jb_>=0&&64*jb_+63>wid*QBLK)cmask(P0,P1,jb_,qrel,hi);}while(0)
  #define BADD(P0,P1,t) do{ if(MODE==1&&(t)>=NT-6)bias_add(P0,P1,tb,t); }while(0)
  #define ENDW(tt) do{ if((tt)+3<NT){WAIT_BAR(2);} else if((tt)+2<NT){WAIT_BAR(1);} else {WAIT_BAR(0);} }while(0)
  for(;t+1<NT;t+=2){
    STEP(pB0,pB1,pA0,pA1,t,(t+3<NT),(t+1<NT),(t+1<NT),(t+1<NT));       ENDW(t);   RESC(); ROT();
    STEP(pA0,pA1,pB0,pB1,t+1,(t+4<NT),(t+2<NT),(t+2<NT),(t+2<NT));     ENDW(t+1); RESC(); ROT();
  }
  STEP(pB0,pB1,pA0,pA1,NT-1,false,false,false,false); RESC();
  { float sacc=pB0[0]+pB0[1]; _Pragma("unroll") for(int r=2;r<16;++r)sacc+=pB0[r]; _Pragma("unroll") for(int r=0;r<16;++r)sacc+=pB1[r]; l_reg+=sacc;
    pw0=(u32x4){PKW(pB0,0),PKW(pB0,2),PKW(pB0,4),PKW(pB0,6)};pw1=(u32x4){PKW(pB0,8),PKW(pB0,10),PKW(pB0,12),PKW(pB0,14)};pw2=(u32x4){PKW(pB1,0),PKW(pB1,2),PKW(pB1,4),PKW(pB1,6)};pw3=(u32x4){PKW(pB1,8),PKW(pB1,10),PKW(pB1,12),PKW(pB1,14)};
    SBAR(); pv(o,vb0+sl_cur,PAF(0),PAF(1),PAF(2),PAF(3)); }
  #undef PKW
  #undef PAF
  #undef VFR
  #undef PIN
  #undef MX3
  #undef GAPA
  #undef GAPB
  #undef EX
  #undef VRD
  #undef KRD
  #undef BADD
  #undef STEP
  #undef ENDW
  {auto rr=__builtin_amdgcn_permlane32_swap(__float_as_uint(l_reg),__float_as_uint(l_reg),false,false);l_reg=__uint_as_float(rr[0])+__uint_as_float(rr[1]);}
  if(hi==0)wsf[32+r32]=l_reg;asm volatile("s_waitcnt lgkmcnt(0)":::"memory");
  float rli[16];
  #pragma unroll
  for(int r=0;r<16;++r)rli[r]=__builtin_amdgcn_rcpf(wsf[32+crow(r,hi)]);
  bf16*Ow=O+(long)(q0+wid*QBLK)*PO;
  { bf16*stg=(bf16*)(shm+LDS_OST)+wid*2048;
    #pragma unroll
    for(int r=0;r<16;++r){const int orow=crow(r,hi);
      { const unsigned w_=cvtpk_s(o[0][r]*rli[r],o[1][r]*rli[r]); stg[orow*64+r32]=(bf16)(w_&0xffffu); stg[orow*64+32+r32]=(bf16)(w_>>16); } }
    asm volatile("s_waitcnt lgkmcnt(0)":::"memory");
    unsigned char*Ow8=(unsigned char*)O+(long)(q0+wid*QBLK)*PO;
    (void)Ow;
    #pragma unroll
    for(int i=0;i<4;++i){const int row=i*8+(lane>>3),ch=lane&7; const u32x4 v=*(const u32x4*)(stg+row*64+ch*8);
      typedef unsigned u32x2o __attribute__((ext_vector_type(2))); u32x2o w8;
      #define F8LO(x) __builtin_bit_cast(float,(x)<<16)
      #define F8HI(x) __builtin_bit_cast(float,(x)&0xffff0000u)
      { int t_=__builtin_amdgcn_cvt_pk_fp8_f32(F8LO(v[0]),F8HI(v[0]),0,false); t_=__builtin_amdgcn_cvt_pk_fp8_f32(F8LO(v[1]),F8HI(v[1]),t_,true); w8[0]=(unsigned)t_; }
      { int t_=__builtin_amdgcn_cvt_pk_fp8_f32(F8LO(v[2]),F8HI(v[2]),0,false); t_=__builtin_amdgcn_cvt_pk_fp8_f32(F8LO(v[3]),F8HI(v[3]),t_,true); w8[1]=(unsigned)t_; }
      #undef F8LO
      #undef F8HI
      *(u32x2o*)(Ow8+(long)row*PO+ch*8)=w8;} }
  asm volatile("s_waitcnt lgkmcnt(0)\n\ts_barrier":::"memory");
  #undef DMA_K
  #undef DMA_V
  #undef CMASK
  #undef RESC
  #undef ROT
}
__device__ __forceinline__ void pv128(f32x16*o,int vb,bf16x8 pa0,bf16x8 pa1,bf16x8 pa2,bf16x8 pa3){
  #pragma unroll
  for(int d0=0;d0<4;++d0){s16x4 lo[4],hi[4];
    #pragma unroll
    for(int ks=0;ks<4;++ks){
      asm volatile("ds_read_b64_tr_b16 %0,%1 offset:%c2":"=&v"(lo[ks]):"v"(vb),"i"(d0*4096+ks*1024):"memory");
      asm volatile("ds_read_b64_tr_b16 %0,%1 offset:%c2":"=&v"(hi[ks]):"v"(vb),"i"(d0*4096+ks*1024+512):"memory");}
    asm volatile("s_waitcnt lgkmcnt(0)":::"memory");SBAR();
    #define PK(k) (bf16x8){lo[k][0],lo[k][1],lo[k][2],lo[k][3],hi[k][0],hi[k][1],hi[k][2],hi[k][3]}
    o[d0]=__builtin_amdgcn_mfma_f32_32x32x16_bf16(pa0,PK(0),o[d0],0,0,0);
    o[d0]=__builtin_amdgcn_mfma_f32_32x32x16_bf16(pa1,PK(1),o[d0],0,0,0);
    o[d0]=__builtin_amdgcn_mfma_f32_32x32x16_bf16(pa2,PK(2),o[d0],0,0,0);
    o[d0]=__builtin_amdgcn_mfma_f32_32x32x16_bf16(pa3,PK(3),o[d0],0,0,0);
    #undef PK
  }
}
constexpr int L8_K=0, L8_V=24576, L8_WS=73728, L8_TAB=75776, SLOTBV=16384;
template<int THRL,bool NOMAX,int PRIME> __device__ __forceinline__ void attn_unit128(int q0,const bf16*Q,const bf16*__restrict__ K,const bf16*__restrict__ V,char*shm,const int STG_OFF){
  int tid=threadIdx.x; asm volatile("":"+v"(tid));
  const int lane=tid&63,r32=lane&31,hi=lane>>5; const int wid=__builtin_amdgcn_readfirstlane(tid>>6);
  const bf16*Qw=Q+(long)(q0+wid*QBLK)*PQ;
  const unsigned lds0=(unsigned)(uintptr_t)shm;
  float*wsf=(float*)(shm+L8_WS)+wid*64;
  const bf16*ksrc=K+(long)lane*PQ+wid*8;
  const bf16*vsrc=V+(long)(16*(wid&3)+(lane>>2))*PQ+(wid>>2)*32+(lane&3)*8;
  const unsigned kdst=lds0+L8_K+wid*1024, vdst=lds0+L8_V+wid*1024;
  #define DMA_K(t,slot) glds16(ksrc+(long)(t)*KVBLK*PQ,(unsigned)__builtin_amdgcn_readfirstlane(kdst+(slot)))
  #define DMA_V(t,slot) do{ glds16(vsrc+(long)(t)*KVBLK*PQ,(unsigned)__builtin_amdgcn_readfirstlane(vdst+2*(slot))); glds16(vsrc+64+(long)(t)*KVBLK*PQ,(unsigned)__builtin_amdgcn_readfirstlane(vdst+2*(slot)+8192)); }while(0)
  const int vb0=(int)(lds0+L8_V)+((lane>>4)&1)*32+(lane&3)*8+(4*hi+((lane&15)>>2))*64;
  bf16x8 kf[8];
  const lds_cptr shm3=(lds_cptr)shm; const lds_cptr kp0=shm3+L8_K+hi*1024+r32*16; const lds_cptr vp0=shm3+L8_V+((lane>>4)&1)*32+(lane&3)*8+(4*hi+((lane&15)>>2))*64;
  const int qrel=wid*QBLK+r32;
  const lds_fptr tb=(lds_fptr)(shm3+L8_TAB)+(2047-(q0+qrel))+4*hi;
  const lds_cptr kbp=hi?(shm3+L8_TAB-16*64*0):(shm3+L8_TAB+16*r32);
  const int kbs=hi?0:1024;
  bf16x8 kb0,kb1;
  { u32x4 w; w[0]=0u; w[1]=hi?0u:0x3F800000u; w[2]=hi?0u:0x3F803F80u; w[3]=0u; kb0=__builtin_bit_cast(bf16x8,w); kb1=kb0; }
  #define KBLD(t) do{ if(false){ kb0=*(const __attribute__((address_space(3))) bf16x8*)(kbp+(t)*kbs); kb1=*(const __attribute__((address_space(3))) bf16x8*)(kbp+(t)*kbs+(hi?0:512)); } }while(0)
  bf16x8 qm=mk_qm(0.f,hi);
  const int NT=(q0+QB)/KVBLK;
  if constexpr(PRIME!=2){ DMA_K(0,0);DMA_V(0,0);DMA_K(1,SLOTB); }
  bf16x8 qr[4];
  #pragma unroll
  for(int d0=0;d0<4;++d0)qr[d0]=*reinterpret_cast<const bf16x8*>(&Qw[(long)r32*PQ+d0*16+hi*8]);
  float mhat=0.f,l_reg=0.f;f32x16 o[4];o[0]=f32x16{};o[1]=f32x16{};o[2]=f32x16{};o[3]=f32x16{};
  #define CMASK(P0,P1,t) do{int jb_=(t)-(NT-4); if(jb_>=0&&64*jb_+63>wid*QBLK)cmask(P0,P1,jb_,qrel,hi);}while(0)
  bool resc=false;
  #define RESC() do{ if(resc){ asm volatile("s_waitcnt lgkmcnt(0)":::"memory"); \
      _Pragma("unroll") for(int d_=0;d_<4;++d_) _Pragma("unroll") for(int r=0;r<16;++r)o[d_][r]*=wsf[crow(r,hi)]; } }while(0)
  f32x16 pA0,pA1,pB0,pB1;
  int sl_prev=0,sl_cur=0,sl_next=SLOTB;
  #define ROT() do{sl_prev=sl_cur;sl_cur=sl_next;sl_next=(sl_next==(NSLOT-1)*SLOTB)?0:sl_next+SLOTB;}while(0)
  if constexpr(PRIME!=2){ DMA_K(2,2*SLOTB); }
  KBLD(0);
  WAIT_BAR(4);
  { const lds_cptr kb=kp0; const f32x16 z16=f32x16{};
    pA0=__builtin_amdgcn_mfma_f32_32x32x16_bf16(kb0,qm,z16,0,0,0); pA1=__builtin_amdgcn_mfma_f32_32x32x16_bf16(kb0,qm,z16,0,0,0);
    #pragma unroll
    for(int d0=0;d0<4;++d0){ const bf16x8 b0=*(const __attribute__((address_space(3))) bf16x8*)(kb+d0*2048), b1=*(const __attribute__((address_space(3))) bf16x8*)(kb+d0*2048+512);
      pA0=__builtin_amdgcn_mfma_f32_32x32x16_bf16(b0,qr[d0],pA0,0,0,0); pA1=__builtin_amdgcn_mfma_f32_32x32x16_bf16(b1,qr[d0],pA1,0,0,0); } }
  if(NT<=6)bias_add(pA0,pA1,tb,0);
  CMASK(pA0,pA1,0);
  { float rm=fmaxf(pA0[0],pA1[0]);
    #pragma unroll
    for(int r=1;r<16;++r)rm=fmaxf(rm,fmaxf(pA0[r],pA1[r]));
    { auto rr=__builtin_amdgcn_permlane32_swap(__float_as_uint(rm),__float_as_uint(rm),false,false); rm=fmaxf(__uint_as_float(rr[0]),__uint_as_float(rr[1])); }
    if(NOMAX)rm=0.f;
    mhat=rm;
    #pragma unroll
    for(int r=0;r<16;++r){pA0[r]=__builtin_amdgcn_exp2f(pA0[r]-rm);pA1[r]=__builtin_amdgcn_exp2f(pA1[r]-rm);} }
  qm=mk_qm(mhat,hi); KBLD(1);
  WAIT_BAR(0);
  DMA_K(3,0);DMA_V(1,SLOTB);
  ROT();
  kload8(kf,kp0+sl_cur);
  WAIT_BAR(3);
  s16x4 V0lo,V0hi,V1lo,V1hi,V2lo,V2hi; u32x4 pw0,pw1,pw2,pw3;
  #define PKW(P,B) cvtpk_s(P[B],P[B+1])
  #define PAF(k) __builtin_bit_cast(bf16x8,pw##k)
  #define PIN(x) asm volatile("":"+v"(x))
  #define MX3(a,b,c) __builtin_fmaxf(__builtin_fmaxf((a),(b)),(c))
  #define GAPA(MF,A0,A1,A2,A3,W0,W1,PW) do{ MF; sacc+=A0; sacc+=A1; sacc+=A2; sacc+=A3; PIN(sacc); W0; W1; PIN(PW); SBAR(); }while(0)
  #define EX(v) __builtin_amdgcn_exp2f(v)
  #define VRDX(S,f) do{ S##lo=vtr(vp_+(((f)>>2)*4096+((f)&3)*1024)); S##hi=vtr(vp_+(((f)>>2)*4096+((f)&3)*1024+512)); }while(0)
  #define VFX(S) (bf16x8){S##lo[0],S##lo[1],S##lo[2],S##lo[3],S##hi[0],S##hi[1],S##hi[2],S##hi[3]}
  #define GAPB(D,KS,SU,SL,FL,X,B) do{ o[D]=__builtin_amdgcn_mfma_f32_32x32x16_bf16(PAF(KS),VFX(SU),o[D],0,0,0); VRDX(SL,FL); X[B]=EX(X[B]); X[B+1]=EX(X[B+1]); PIN(X); SBAR(); }while(0)
  #define GAPBL(D,KS,SU,X,B) do{ o[D]=__builtin_amdgcn_mfma_f32_32x32x16_bf16(PAF(KS),VFX(SU),o[D],0,0,0); X[B]=EX(X[B]); X[B+1]=EX(X[B+1]); PIN(X); SBAR(); }while(0)
  #define KRD(G,j) do{ if(G){ kload2(kf,kp0+sl_next,j); SBAR(); } }while(0)
  #define STEP(C0,C1,P0,P1,t,GK,GV,GL,GB) do{ SBAR(); \
    const lds_cptr vp_=vp0+2*sl_prev; \
    if constexpr(!NOMAX){ C0=__builtin_amdgcn_mfma_f32_32x32x16_bf16(kb0,qm,f32x16{},0,0,0); C1=__builtin_amdgcn_mfma_f32_32x32x16_bf16(kb0,qm,f32x16{},0,0,0); } SBAR(); \
    float sacc=(P0[0]+P0[1]); \
    GAPA(C0=__builtin_amdgcn_mfma_f32_32x32x16_bf16(kf[0],qr[0],NOMAX?f32x16{}:C0,0,0,0), P0[2],P0[3],P0[4],P0[5],     pw0[0]=PKW(P0,0), pw0[1]=PKW(P0,2), pw0); \
    GAPA(C1=__builtin_amdgcn_mfma_f32_32x32x16_bf16(kf[1],qr[0],NOMAX?f32x16{}:C1,0,0,0), P0[6],P0[7],P0[8],P0[9],     pw0[2]=PKW(P0,4), pw0[3]=PKW(P0,6), pw0); \
    KRD(GL,0); GAPA(C0=__builtin_amdgcn_mfma_f32_32x32x16_bf16(kf[2],qr[1],C0,0,0,0),   P0[10],P0[11],P0[12],P0[13], pw1[0]=PKW(P0,8), pw1[1]=PKW(P0,10), pw1); \
    GAPA(C1=__builtin_amdgcn_mfma_f32_32x32x16_bf16(kf[3],qr[1],C1,0,0,0),   P0[14],P0[15],P1[0],P1[1],   pw1[2]=PKW(P0,12),pw1[3]=PKW(P0,14), pw1); \
    KRD(GL,1); GAPA(C0=__builtin_amdgcn_mfma_f32_32x32x16_bf16(kf[4],qr[2],C0,0,0,0),   P1[2],P1[3],P1[4],P1[5],     pw2[0]=PKW(P1,0), pw2[1]=PKW(P1,2), pw2); \
    GAPA(C1=__builtin_amdgcn_mfma_f32_32x32x16_bf16(kf[5],qr[2],C1,0,0,0),   P1[6],P1[7],P1[8],P1[9],     pw2[2]=PKW(P1,4), pw2[3]=PKW(P1,6), pw2); \
    KRD(GL,2); GAPA(C0=__builtin_amdgcn_mfma_f32_32x32x16_bf16(kf[6],qr[3],C0,0,0,0),   P1[10],P1[11],P1[12],P1[13], pw3[0]=PKW(P1,8), pw3[1]=PKW(P1,10), pw3); \
    GAPA(C1=__builtin_amdgcn_mfma_f32_32x32x16_bf16(kf[7],qr[3],C1,0,0,0),   P1[14],P1[15],0.f,0.f,       pw3[2]=PKW(P1,12),pw3[3]=PKW(P1,14), pw3); \
    KRD(GL,3); VRDX(V0,0); VRDX(V1,4); SBAR(); \
    l_reg+=sacc; \
    if(GK){DMA_K((t)+3,sl_cur);} if(GV){DMA_V((t)+1,sl_next);} \
    BADD(C0,C1,t); CMASK(C0,C1,t); \
    if constexpr(!NOMAX){ float a=MX3(C0[0],C0[1],C1[0]),b=MX3(C0[2],C0[3],C1[1]); a=MX3(a,C1[2],C1[3]); \
      _Pragma("unroll") for(int r=4;r<16;r+=4){a=MX3(a,C0[r],C0[r+1]);b=MX3(b,C0[r+2],C0[r+3]);a=MX3(a,C1[r],C1[r+1]);b=MX3(b,C1[r+2],C1[r+3]);} \
      float rm=__builtin_fmaxf(a,b); { auto rr=__builtin_amdgcn_permlane32_swap(__float_as_uint(rm),__float_as_uint(rm),false,false); rm=__builtin_fmaxf(__uint_as_float(rr[0]),__uint_as_float(rr[1])); } \
      resc=false; \
      if(__builtin_expect(__any(rm>(float)THRL),0)){ const float dl=__builtin_fmaxf(rm,0.f); mhat+=dl; \
        _Pragma("unroll") for(int r=0;r<16;++r){C0[r]-=dl;C1[r]-=dl;} \
        qm=mk_qm(mhat,hi); \
        const float f=__builtin_amdgcn_exp2f(-dl); l_reg*=f; if(hi==0)wsf[r32]=f; resc=true; } } \
    SBAR(); \
    GAPB(0,0,V0,V2,8, C0,0);  GAPB(1,0,V1,V0,12,C0,2);  GAPB(2,0,V2,V1,1, C0,4);  GAPB(3,0,V0,V2,5, C0,6); \
    GAPB(0,1,V1,V0,9, C0,8);  GAPB(1,1,V2,V1,13,C0,10); GAPB(2,1,V0,V2,2, C0,12); GAPB(3,1,V1,V0,6, C0,14); \
    GAPB(0,2,V2,V1,10,C1,0);  GAPB(1,2,V0,V2,14,C1,2);  GAPB(2,2,V1,V0,3, C1,4);  GAPB(3,2,V2,V1,7, C1,6); \
    GAPB(0,3,V0,V2,11,C1,8);  GAPB(1,3,V1,V0,15,C1,10); GAPBL(2,3,V2,C1,12);      GAPBL(3,3,V0,C1,14); \
    }while(0)
  int t=1;
  #undef CMASK
  #define CMASK(P0,P1,t) do{}while(0)
  #define BADD(P0,P1,t) do{}while(0)
  for(;t+(7)<NT;t+=2){
    STEP(pB0,pB1,pA0,pA1,t,true,true,true,true);     WAIT_BAR(3); RESC(); ROT();
    STEP(pA0,pA1,pB0,pB1,t+1,true,true,true,true);   WAIT_BAR(3); RESC(); ROT();
  }
  #undef CMASK
  #undef BADD
  #define CMASK(P0,P1,t) do{int jb_=(t)-(NT-4); if(jb_>=0&&64*jb_+63>wid*QBLK)cmask(P0,P1,jb_,qrel,hi);}while(0)
  #define BADD(P0,P1,t) do{ if((t)>=NT-6 && 64*(t)+63>=q0+32*wid-112 && 64*(t)<=q0+32*wid+31)bias_add(P0,P1,tb,t); }while(0)
  #define ENDW(tt) do{ if((tt)+3<NT){WAIT_BAR(3);} else if((tt)+2<NT){WAIT_BAR(2);} else {WAIT_BAR(0);} }while(0)
  for(;t+1<NT;t+=2){
    STEP(pB0,pB1,pA0,pA1,t,(t+3<NT),(t+1<NT),(t+1<NT),(t+1<NT));       ENDW(t);   RESC(); ROT();
    STEP(pA0,pA1,pB0,pB1,t+1,(t+4<NT),(t+2<NT),(t+2<NT),(t+2<NT));     ENDW(t+1); RESC(); ROT();
  }
  STEP(pB0,pB1,pA0,pA1,NT-1,false,false,false,false); RESC();
  { float sacc=pB0[0]+pB0[1]; _Pragma("unroll") for(int r=2;r<16;++r)sacc+=pB0[r]; _Pragma("unroll") for(int r=0;r<16;++r)sacc+=pB1[r]; l_reg+=sacc;
    pw0=(u32x4){PKW(pB0,0),PKW(pB0,2),PKW(pB0,4),PKW(pB0,6)};pw1=(u32x4){PKW(pB0,8),PKW(pB0,10),PKW(pB0,12),PKW(pB0,14)};pw2=(u32x4){PKW(pB1,0),PKW(pB1,2),PKW(pB1,4),PKW(pB1,6)};pw3=(u32x4){PKW(pB1,8),PKW(pB1,10),PKW(pB1,12),PKW(pB1,14)};
    SBAR(); pv128(o,vb0+2*sl_cur,PAF(0),PAF(1),PAF(2),PAF(3)); }
  #undef PKW
  #undef PAF
  #undef VFX
  #undef VRDX
  #undef GAPBL
  #undef PIN
  #undef MX3
  #undef GAPA
  #undef GAPB
  #undef EX
  #undef KRD
  #undef BADD
  #undef STEP
  #undef ENDW
  {auto rr=__builtin_amdgcn_permlane32_swap(__float_as_uint(l_reg),__float_as_uint(l_reg),false,false);l_reg=__uint_as_float(rr[0])+__uint_as_float(rr[1]);}
  if(hi==0)wsf[32+r32]=l_reg;asm volatile("s_waitcnt lgkmcnt(0)":::"memory");
  float rli[16];
  #pragma unroll
  for(int r=0;r<16;++r)rli[r]=__builtin_amdgcn_rcpf(wsf[32+crow(r,hi)]);
  asm volatile("s_waitcnt lgkmcnt(0)\n\ts_barrier":::"memory");
  if constexpr(PRIME==1){ const bf16*ksrcN=ksrc+64;
    glds16(ksrcN,(unsigned)__builtin_amdgcn_readfirstlane(kdst)); DMA_V(0,0); glds16(ksrcN+(long)KVBLK*PQ,(unsigned)__builtin_amdgcn_readfirstlane(kdst+SLOTB)); glds16(ksrcN+(long)2*KVBLK*PQ,(unsigned)__builtin_amdgcn_readfirstlane(kdst+2*SLOTB)); }
  { bf16*stg=(bf16*)(shm+STG_OFF)+wid*4096;
    #pragma unroll
    for(int r=0;r<16;++r){const int orow=crow(r,hi);
      #pragma unroll
      for(int d0=0;d0<4;d0+=2){ const unsigned w_=cvtpk_s(o[d0][r]*rli[r],o[d0+1][r]*rli[r]); stg[orow*128+d0*32+r32]=(bf16)(w_&0xffffu); stg[orow*128+(d0+1)*32+r32]=(bf16)(w_>>16); } } }
  asm volatile("s_waitcnt lgkmcnt(0)\n\ts_barrier":::"memory");
  #undef DMA_K
  #undef DMA_V
  #undef CMASK
  #undef RESC
  #undef ROT
}
#undef SBAR
#undef WAIT_BAR
}

typedef float f32x16 __attribute__((ext_vector_type(16)));
typedef short s16x4 __attribute__((ext_vector_type(4)));
typedef unsigned u32x2v __attribute__((ext_vector_type(2)));
typedef float f32x2t __attribute__((ext_vector_type(2)));
struct Args { const float* in[26]; float* out; unsigned char* ws; int ph_lo, ph_hi; };
#define KARG ((const __attribute__((address_space(4))) Args*)__builtin_amdgcn_kernarg_segment_ptr())
#define FRESH(F) do { int t_ = threadIdx.x; asm volatile("" : "+v"(t_)); (F).tid = t_; (F).lane = t_ & 63; (F).wave = __builtin_amdgcn_readfirstlane(t_ >> 6); } while (0)
struct Frame {
    LAS unsigned char* lds;
    volatile LAS unsigned* MISC;
    gu32* ctl;
    int tid, lane, wave;
    int vcu, G;
    unsigned char* ws;
    float* out;
};
__device__ __forceinline__ float wave_sum(float v) {
#pragma unroll
    for (int o = 1; o < 64; o <<= 1) v += __shfl_xor(v, o);
    return v;
}
__device__ __forceinline__ float bf2f(unsigned short b) { return __builtin_bit_cast(float, (unsigned)b << 16); }
__device__ __forceinline__ float bflo(unsigned w) { return __builtin_bit_cast(float, w << 16); }
__device__ __forceinline__ float bfhi(unsigned w) { return __builtin_bit_cast(float, w & 0xffff0000u); }
__device__ __forceinline__ int crow(int r, int hi) { return (r & 3) + 8 * (r >> 2) + 4 * hi; }
__device__ __forceinline__ unsigned pk4_fp8_nc(float a, float b, float c, float d) { int w = __builtin_amdgcn_cvt_pk_fp8_f32(a, b, 0, false); w = __builtin_amdgcn_cvt_pk_fp8_f32(c, d, w, true); return (unsigned)w; }
__device__ __forceinline__ unsigned pk4_fp8(float a, float b, float c, float d) {
    a = __builtin_amdgcn_fmed3f(a, -448.f, 448.f); b = __builtin_amdgcn_fmed3f(b, -448.f, 448.f); c = __builtin_amdgcn_fmed3f(c, -448.f, 448.f); d = __builtin_amdgcn_fmed3f(d, -448.f, 448.f);
    int w = __builtin_amdgcn_cvt_pk_fp8_f32(a, b, 0, false); w = __builtin_amdgcn_cvt_pk_fp8_f32(c, d, w, true); return (unsigned)w; }

constexpr int NPPU = (NTOK / 256) * (D / 256);
struct SchedC {
    static constexpr bool GATHER = false;
    int nM, nN, G, c, K; const char* Bt;
    __device__ __forceinline__ size_t aoff_uniform(const pg8::Unit& u) const { return (size_t)u.pm * 256 * K * 2; }
    __device__ __forceinline__ bool next(int i, pg8::Unit& u) const { u.e = 0; u.lr0 = 0; u.ui = i; return pg8::order_tile((long)i * G + c, nM, nN, u.pm, u.pn); }
    __device__ __forceinline__ const char* bptr(const pg8::Unit& u) const { return Bt + (size_t)u.pn * 256 * K * 2; }
    __device__ __forceinline__ void aoffs(const pg8::Unit& u, const int (&aR)[2], const int (&aC)[2], unsigned (&ao)[2][2]) const {
#pragma unroll
        for (int h = 0; h < 2; ++h)
#pragma unroll
            for (int i = 0; i < 2; ++i) ao[h][i] = (unsigned)((u.pm * 256 + h * 128 + aR[i]) * K + aC[i]) * 2u; }
};
__device__ __forceinline__ LAS unsigned short* lds_tileE(LAS unsigned char* lds) { return (LAS unsigned short*)(lds + TILEE_OFF); }
__device__ __forceinline__ LAS int* lds_tstart(LAS unsigned char* lds) { return (LAS int*)(lds + TILEE_OFF + 1152); }
__device__ __forceinline__ LAS int* lds_cnt(LAS unsigned char* lds) { return (LAS int*)(lds + TILEE_OFF + 1152 + 144); }
template <bool GATHER_, int NN, int NROWS_B  , int KU  >
struct SchedM {
    static constexpr bool GATHER = GATHER_;
    __device__ __forceinline__ size_t aoff_uniform(const pg8::Unit& u) const { return (size_t)u.pm * 256 * KU * 2; }
    int G, c; const char* Bt; LAS unsigned char* lds; int ntile;
    __device__ __forceinline__ bool next(int i, pg8::Unit& u) const {
        if (GATHER && i >= 18) return false;
        if (!pg8::order_tile((long)i * G + c, ntile, NN, u.pm, u.pn)) return false;
        u.e = __builtin_amdgcn_readfirstlane((int)lds_tileE(lds)[u.pm]); u.lr0 = (u.pm - __builtin_amdgcn_readfirstlane(lds_tstart(lds)[u.e])) * 256; u.ui = i; return true; }
    __device__ __forceinline__ const char* bptr(const pg8::Unit& u) const { return Bt + ((size_t)u.e * NROWS_B + (size_t)u.pn * 256) * KU * 2; }
    __device__ __forceinline__ void aoffs(const pg8::Unit& u, const int (&aR)[2], const int (&aC)[2], unsigned (&ao)[2][2]) const {
        const LAS int* tk = (const LAS int*)(lds + TOKL_OFF) + u.ui * 256;
#pragma unroll
        for (int h = 0; h < 2; ++h)
#pragma unroll
            for (int i = 0; i < 2; ++i) {
                if (GATHER) ao[h][i] = (unsigned)(tk[h * 128 + aR[i]] * KU + aC[i]) * 2u;
                else ao[h][i] = (unsigned)((u.pm * 256 + h * 128 + aR[i]) * KU + aC[i]) * 2u; }
    }
};

using pg8::Unit; using pg8::cvt_pk_bf16; using pg8::HALF; using pg8::BM;
struct EpiBf16P {
    static constexpr bool PERM = true, PREFETCH = false;
    unsigned char* O; int ldc;
    __device__ __forceinline__ void operator()(const f32x4 (&acc)[2][2][4][2], const Unit& u, int wr, int wc, int fr, int fq) const {
        const int row0 = u.pm * BM + wr * 64 + fr, col0 = u.pn * BM + wc * 32 + 8 * fq;
#pragma unroll
        for (int ai = 0; ai < 2; ++ai)
#pragma unroll
            for (int m = 0; m < 4; ++m) { unsigned char* rowp = O + (size_t)(row0 + ai * HALF + m * 16) * ldc + col0;
#pragma unroll
                for (int bj = 0; bj < 2; ++bj) { const f32x4 v0 = acc[ai][bj][m][0], v1 = acc[ai][bj][m][1];
                    u32x2v w; w.x = pk4_fp8(v0[0], v0[1], v0[2], v0[3]); w.y = pk4_fp8(v1[0], v1[1], v1[2], v1[3]);
                    *(u32x2v*)(rowp + bj * HALF) = w; }
                __builtin_amdgcn_sched_barrier(0); }
    }
};
struct EpiProj {
    static constexpr bool PERM = true, PREFETCH = false;
    bf16* O; const float *gqf, *gkf, *gqd, *gkd;
    __device__ __forceinline__ void operator()(const f32x4 (&acc)[2][2][4][2], const Unit& u, int wr, int wc, int fr, int fq) const {
        const int seg = u.pn >> 1;
        const float* g = seg == 0 ? gqf : seg == 1 ? gkf : seg == 3 ? gqd : seg == 4 ? gkd : nullptr;
        const float sc = (seg == 0 || seg == 3) ? C2 : 1.0f;
        f32x4 gv[2][2];
#pragma unroll
        for (int bj = 0; bj < 2; ++bj)
#pragma unroll
            for (int n = 0; n < 2; ++n) gv[bj][n] = g ? *(const f32x4*)(g + 32 * bj + 8 * fq + 4 * n) : (f32x4){1.f, 1.f, 1.f, 1.f};
        const int row0 = u.pm * BM + wr * 64 + fr, col0 = u.pn * BM + 64 * wc + 8 * fq;
#pragma unroll
        for (int ai = 0; ai < 2; ++ai)
#pragma unroll
            for (int m = 0; m < 4; ++m) {
                float r = 1.0f;
                if (g) { float ss = 0.f;
#pragma unroll
                    for (int bj = 0; bj < 2; ++bj)
#pragma unroll
                        for (int n = 0; n < 2; ++n) { const f32x4 x = acc[ai][bj][m][n]; ss += (x[0] * x[0] + x[1] * x[1]) + (x[2] * x[2] + x[3] * x[3]); }
                    ss += __shfl_xor(ss, 16); ss += __shfl_xor(ss, 32);
                    r = __builtin_amdgcn_rsqf(ss * (1.0f / 64.0f) + EPS) * sc; }
                bf16* rowp = O + (size_t)(row0 + ai * HALF + m * 16) * NPROJ + col0;
#pragma unroll
                for (int bj = 0; bj < 2; ++bj) { const f32x4 v0 = acc[ai][bj][m][0] * gv[bj][0] * r, v1 = acc[ai][bj][m][1] * gv[bj][1] * r;
                    v4u w; w.x = cvt_pk_bf16(v0[0], v0[1]); w.y = cvt_pk_bf16(v0[2], v0[3]); w.z = cvt_pk_bf16(v1[0], v1[1]); w.w = cvt_pk_bf16(v1[2], v1[3]);
                    *(v4u*)(rowp + 32 * bj) = w; }
                __builtin_amdgcn_sched_barrier(0); }
    }
};
struct EpiRes {
    static constexpr bool PERM = true, PREFETCH = false; static constexpr int NST = 16;
    const bf16* a0; const float* rd0; const float* g; bf16* out;
    __device__ __forceinline__ void operator()(const f32x4 (&acc)[2][2][4][2], const Unit& u, int wr, int wc, int fr, int fq) const {
        const int row0 = u.pm * BM + wr * 64 + fr, col0 = u.pn * BM + wc * 32 + 8 * fq;
        f32x4 ig[2][2];
#pragma unroll
        for (int bj = 0; bj < 2; ++bj)
#pragma unroll
            for (int n = 0; n < 2; ++n) { const f32x4 gg = *(const f32x4*)(g + col0 + bj * HALF + 4 * n); ig[bj][n] = (f32x4){1.0f / gg[0], 1.0f / gg[1], 1.0f / gg[2], 1.0f / gg[3]}; }
#pragma unroll
        for (int ai = 0; ai < 2; ++ai) {
            v4u xw[4][2]; float rd[4];
#pragma unroll
            for (int m = 0; m < 4; ++m) { const int row = row0 + ai * HALF + m * 16; const size_t off = (size_t)row * D + col0; rd[m] = rd0[row];
#pragma unroll
                for (int bj = 0; bj < 2; ++bj) xw[m][bj] = __builtin_nontemporal_load((const v4u*)(a0 + off + bj * HALF)); }
#pragma unroll
            for (int m = 0; m < 4; ++m) { const size_t off = (size_t)(row0 + ai * HALF + m * 16) * D + col0;
#pragma unroll
                for (int bj = 0; bj < 2; ++bj) { const v4u x_ = xw[m][bj];
                    const f32x4 x0 = (f32x4){bflo(x_.x), bfhi(x_.x), bflo(x_.y), bfhi(x_.y)} * ig[bj][0] * rd[m], x1 = (f32x4){bflo(x_.z), bfhi(x_.z), bflo(x_.w), bfhi(x_.w)} * ig[bj][1] * rd[m];
                    const f32x4 v0 = x0 + acc[ai][bj][m][0], v1 = x1 + acc[ai][bj][m][1];
                    v4u w; w.x = cvt_pk_bf16(v0[0], v0[1]); w.y = cvt_pk_bf16(v0[2], v0[3]); w.z = cvt_pk_bf16(v1[0], v1[1]); w.w = cvt_pk_bf16(v1[2], v1[3]);
                    *(v4u*)(out + off + bj * HALF) = w; } }
            __builtin_amdgcn_sched_barrier(0); }
    }
};
struct EpiSwiglu {
    static constexpr bool PERM = true, PREFETCH = true;
    unsigned char* HB; const float* b1p; const float* rsE; LAS unsigned char* lds;
    __device__ __forceinline__ void prefetch(const Unit& u, LAS unsigned char* buf, int wid, int lane) const {
        if (wid == 0) __builtin_amdgcn_global_load_lds((const unsigned*)(b1p + (size_t)u.e * 2048 + u.pn * 256 + 4 * lane), (LAS unsigned*)buf, 16, 0, 0);
        else if (wid == 1) __builtin_amdgcn_global_load_lds((const unsigned*)(rsE + (size_t)u.e * ECAP + u.lr0 + 4 * lane), (LAS unsigned*)(buf + 1024), 16, 0, 0);
    }
    __device__ __forceinline__ void operator()(const f32x4 (&acc)[2][2][4][2], const Unit& u, int wr, int wc, int fr, int fq, LAS unsigned char* buf) const {
        const int cnt = __builtin_amdgcn_readfirstlane(lds_cnt(lds)[u.e]);
        const LAS float* bp = (const LAS float*)buf + wc * 32 + 8 * fq; const LAS float* rp = (const LAS float*)(buf + 1024);
        f32x4 bv[2][2];
#pragma unroll
        for (int bj = 0; bj < 2; ++bj)
#pragma unroll
            for (int n = 0; n < 2; ++n) bv[bj][n] = *(const LAS f32x4*)(bp + bj * HALF + 4 * n);
        const int col0 = u.pn * 128 + wc * 32 + 8 * fq;
#pragma unroll
        for (int ai = 0; ai < 2; ++ai)
#pragma unroll
            for (int m = 0; m < 4; ++m) { const int lrow = ai * HALF + wr * 64 + m * 16 + fr; const int lr = u.lr0 + lrow;
                const float rsv = rp[lrow]; const float rs = lr < cnt ? rsv : 0.f;
                float o[8]; const f32x2t rs2 = {rs, rs};
#pragma unroll
                for (int n = 0; n < 2; ++n)
#pragma unroll
                    for (int i = 0; i < 4; i += 2) {
                        f32x2t gl = (f32x2t){acc[ai][0][m][n][i], acc[ai][0][m][n][i + 1]} * rs2 + (f32x2t){bv[0][n][i], bv[0][n][i + 1]};
                        f32x2t li = (f32x2t){acc[ai][1][m][n][i], acc[ai][1][m][n][i + 1]} * rs2 + (f32x2t){bv[1][n][i], bv[1][n][i + 1]};
                        gl[0] = fminf(gl[0], 7.0f); gl[1] = fminf(gl[1], 7.0f); li[0] = __builtin_amdgcn_fmed3f(li[0], -6.0f, 8.0f); li[1] = __builtin_amdgcn_fmed3f(li[1], -6.0f, 8.0f);
                        const f32x2t t = gl * (-1.702f * LOG2E); f32x2t e; e[0] = __builtin_amdgcn_exp2f(t[0]); e[1] = __builtin_amdgcn_exp2f(t[1]);
                        const f32x2t d = e + 1.0f; f32x2t sg; sg[0] = __builtin_amdgcn_rcpf(d[0]); sg[1] = __builtin_amdgcn_rcpf(d[1]);
                        const f32x2t r = (gl * sg) * li; o[4 * n + i] = r[0]; o[4 * n + i + 1] = r[1]; }
                u32x2v w; w.x = pk4_fp8_nc(o[0], o[1], o[2], o[3]); w.y = pk4_fp8_nc(o[4], o[5], o[6], o[7]);
                *(u32x2v*)(HB + (size_t)(u.pm * 256 + lrow) * FF + col0) = w; }
    }
};
struct EpiY {
    static constexpr bool PERM = true, PREFETCH = true;
    unsigned char* Y; const float* b2; const float* gateE; LAS unsigned char* lds;
    __device__ __forceinline__ void prefetch(const Unit& u, LAS unsigned char* buf, int wid, int lane) const {
        if (wid == 0) __builtin_amdgcn_global_load_lds((const unsigned*)(b2 + (size_t)u.e * D + u.pn * 256 + 4 * lane), (LAS unsigned*)buf, 16, 0, 0);
        else if (wid == 1) __builtin_amdgcn_global_load_lds((const unsigned*)(gateE + (size_t)u.e * ECAP + u.lr0 + 4 * lane), (LAS unsigned*)(buf + 1024), 16, 0, 0);
    }
    __device__ __forceinline__ void operator()(const f32x4 (&acc)[2][2][4][2], const Unit& u, int wr, int wc, int fr, int fq, LAS unsigned char* buf) const {
        const int cnt = __builtin_amdgcn_readfirstlane(lds_cnt(lds)[u.e]);
        const int colt = wc * 64 + 16 * fq, col0 = u.pn * 256 + colt;
        const LAS float* bp = (const LAS float*)buf + colt; const LAS float* gp = (const LAS float*)(buf + 1024);
        f32x4 bv[2][2];
#pragma unroll
        for (int bj = 0; bj < 2; ++bj)
#pragma unroll
            for (int n = 0; n < 2; ++n) bv[bj][n] = *(const LAS f32x4*)(bp + 8 * bj + 4 * n);
#pragma unroll
        for (int ai = 0; ai < 2; ++ai)
#pragma unroll
            for (int m = 0; m < 4; ++m) { const int lrow = ai * HALF + wr * 64 + m * 16 + fr; const int lr = u.lr0 + lrow;
                const float gv_ = gp[lrow]; const float gt = lr < cnt ? gv_ * 16.0f : 0.f;
                v4u w;
                { const f32x4 v0 = (acc[ai][0][m][0] + bv[0][0]) * gt, v1 = (acc[ai][0][m][1] + bv[0][1]) * gt; w.x = pk4_fp8(v0[0], v0[1], v0[2], v0[3]); w.y = pk4_fp8(v1[0], v1[1], v1[2], v1[3]); }
                { const f32x4 v0 = (acc[ai][1][m][0] + bv[1][0]) * gt, v1 = (acc[ai][1][m][1] + bv[1][1]) * gt; w.z = pk4_fp8(v0[0], v0[1], v0[2], v0[3]); w.w = pk4_fp8(v1[0], v1[1], v1[2], v1[3]); }
                *(v4u*)(Y + (size_t)(u.pm * 256 + lrow) * D + col0) = w;
                __builtin_amdgcn_sched_barrier(0); }
    }
};
struct EpiFinal {
    static constexpr bool PERM = true, PREFETCH = false;
    float* out; const bf16* H2; const unsigned char* PP; const float* rs3;
    __device__ __forceinline__ void operator()(const f32x4 (&acc)[2][2][4][2], const Unit& u, int wr, int wc, int fr, int fq) const {
        const int row0 = u.pm * BM + wr * 64 + fr, col0 = u.pn * BM + wc * 32 + 8 * fq;
#pragma unroll
        for (int ai = 0; ai < 2; ++ai) {
            v4u hw[4][2]; u32x2v pw[4][2]; float rs[4];
#pragma unroll
            for (int m = 0; m < 4; ++m) { const int row = row0 + ai * HALF + m * 16; const size_t off = (size_t)row * D + col0; rs[m] = rs3[row];
#pragma unroll
                for (int bj = 0; bj < 2; ++bj) { hw[m][bj] = *(const v4u*)(H2 + off + bj * HALF); pw[m][bj] = *(const u32x2v*)(PP + off + bj * HALF); } }
#pragma unroll
            for (int m = 0; m < 4; ++m) { const int row = row0 + ai * HALF + m * 16; const size_t off = (size_t)row * D + col0;
#pragma unroll
                for (int bj = 0; bj < 2; ++bj) { const v4u h_ = hw[m][bj]; const u32x2v p_ = pw[m][bj];
                    const float hv[8] = {bflo(h_.x), bfhi(h_.x), bflo(h_.y), bfhi(h_.y), bflo(h_.z), bfhi(h_.z), bflo(h_.w), bfhi(h_.w)};
                    const f32x2t p0 = __builtin_amdgcn_cvt_pk_f32_fp8((int)p_.x, false), p1 = __builtin_amdgcn_cvt_pk_f32_fp8((int)p_.x, true), p2 = __builtin_amdgcn_cvt_pk_f32_fp8((int)p_.y, false), p3 = __builtin_amdgcn_cvt_pk_f32_fp8((int)p_.y, true);
                    const float pv[8] = {p0[0], p0[1], p1[0], p1[1], p2[0], p2[1], p3[0], p3[1]};
#pragma unroll
                    for (int n = 0; n < 2; ++n) { const f32x4 a = acc[ai][bj][m][n] * rs[m]; f32x4 o;
#pragma unroll
                        for (int i = 0; i < 4; ++i) o[i] = hv[4 * n + i] + __builtin_amdgcn_rcpf(1.0f + __builtin_amdgcn_exp2f(-LOG2E * a[i])) * pv[4 * n + i];
                        *(f32x4*)(out + off + bj * HALF + 4 * n) = o; } } }
            __builtin_amdgcn_sched_barrier(0); }
    }
};

__device__ __forceinline__ int dest_row(int mode, int nn) {
    if (mode == 1) { const int c = nn & 255; return (nn & ~255) + 128 * ((c >> 5) & 1) + 32 * (c >> 6) + (c & 31); }
    if (mode == 2) { const int o = nn >> 1; return 256 * (o >> 7) + (o & 127) + 128 * (nn & 1); }
    if (mode == 3) { const int c = nn & 255; return (nn & ~255) + 128 * ((c >> 3) & 1) + 32 * (c >> 6) + 8 * ((c >> 4) & 3) + (c & 7); }
    return nn;
}
__device__ __forceinline__ void tr_item(const float* W, int ldw, int k0, int n0src, int n0, int mode, bf16* WT, int Kdim, LAS float* scr, int lane) {
    float v[32];
#pragma unroll
    for (int i = 0; i < 32; ++i) { const int kk = 2 * i + (lane >> 5); v[i] = __builtin_nontemporal_load(W + (size_t)(k0 + kk) * ldw + n0src + (lane & 31)); }
#pragma unroll
    for (int i = 0; i < 32; ++i) { const int kk = 2 * i + (lane >> 5); scr[kk * 33 + (lane & 31)] = v[i]; }
    LDS_WAIT(); asm volatile("" ::: "memory");
    const int c = lane & 7;
#pragma unroll
    for (int j = 0; j < 4; ++j) { const int n = (lane >> 3) + 8 * j; const LAS float* s = scr + (8 * c) * 33 + n;
        v4u o; o.x = pk2(s[0 * 33], s[1 * 33]); o.y = pk2(s[2 * 33], s[3 * 33]); o.z = pk2(s[4 * 33], s[5 * 33]); o.w = pk2(s[6 * 33], s[7 * 33]);
        *(GAS v4u*)(WT + (size_t)dest_row(mode, n0 + n) * Kdim + k0 + 8 * c) = o; }
    LDS_WAIT(); asm volatile("" ::: "memory");
}
__device__ __forceinline__ void tr_item_f8(const float* W, int ldw, int k0, int n0src, int n0, int mode, unsigned char* WT, int Kdim, LAS float* scr, int lane) {
    float v[32];
#pragma unroll
    for (int i = 0; i < 32; ++i) { const int kk = 2 * i + (lane >> 5); v[i] = __builtin_nontemporal_load(W + (size_t)(k0 + kk) * ldw + n0src + (lane & 31)); }
#pragma unroll
    for (int i = 0; i < 32; ++i) { const int kk = 2 * i + (lane >> 5); scr[kk * 33 + (lane & 31)] = v[i] * 32.0f; }
    LDS_WAIT(); asm volatile("" ::: "memory");
    const int c = lane & 3;
#pragma unroll
    for (int j = 0; j < 2; ++j) { const int n = (lane >> 2) + 16 * j; const LAS float* s = scr + (16 * c) * 33 + n;
        v4u o; o.x = pk4_fp8(s[0 * 33], s[1 * 33], s[2 * 33], s[3 * 33]); o.y = pk4_fp8(s[4 * 33], s[5 * 33], s[6 * 33], s[7 * 33]);
        o.z = pk4_fp8(s[8 * 33], s[9 * 33], s[10 * 33], s[11 * 33]); o.w = pk4_fp8(s[12 * 33], s[13 * 33], s[14 * 33], s[15 * 33]);
        *(GAS v4u*)(WT + (size_t)dest_row(mode, n0 + n) * Kdim + k0 + 16 * c) = o; }
    LDS_WAIT(); asm volatile("" ::: "memory");
}
__device__ __forceinline__ float log_sigmoid(float z) { return fminf(z, 0.f) - log1pf(expf(-fabsf(z))); }

__device__ __forceinline__ void p0_prologue(Frame& F) {
    const float* x = KARG->in[0]; const float* p = KARG->in[1]; const float* g_attn = KARG->in[3]; const float* w_in = KARG->in[4]; const float* b_f = KARG->in[5];
    const float* w_out = KARG->in[15]; const float* g_mlp = KARG->in[16]; const float* w_router = KARG->in[17]; const float* w1 = KARG->in[19]; const float* b1 = KARG->in[20];
    const float* w2 = KARG->in[21]; const float* w_pg = KARG->in[24]; const float* w_pp = KARG->in[25];
    unsigned char* ws = F.ws;
    const int gw = F.vcu * NWAVES + F.wave, NGW = F.G * NWAVES;
    const int gt = F.vcu * (NWAVES * 64) + F.tid, NGT = F.G * NWAVES * 64;
    { LAS float* wf = (LAS float*)(F.lds + RING_OFF);
      for (int k = F.tid; k < D; k += NWAVES * 64) {
          const f32x4 a = *(const f32x4*)(w_in + (size_t)k * INW + 1536), b = *(const f32x4*)(w_in + (size_t)k * INW + 1540); const float g = g_attn[k];
          LAS f32x4* dst = (LAS f32x4*)(wf + ((((k >> 8) * 4 + (k & 3)) * 128 + ((k & 255) >> 2)) * 4)); dst[0] = a * g; dst[64] = b * g; }
      __syncthreads();
      f32x4 gv[4];
#pragma unroll
      for (int j = 0; j < 4; ++j) gv[j] = *(const f32x4*)(g_attn + 256 * j + 4 * F.lane);
      bf16* A0 = (bf16*)(ws + WS_A0); float* LF = (float*)(ws + WS_LF); float* RD0 = (float*)(ws + WS_RD0);
      for (int m = gw; m < NTOK; m += NGW) {
          const GAS f32x4* xr = (const GAS f32x4*)(x + (size_t)m * D) + F.lane;
          f32x4 v[4]; float ss = 0.f;
#pragma unroll
          for (int j = 0; j < 4; ++j) { v[j] = __builtin_nontemporal_load(xr + 64 * j); ss += (v[j].x * v[j].x + v[j].y * v[j].y) + (v[j].z * v[j].z + v[j].w * v[j].w); }
          const float rd = sqrtf(wave_sum(ss) * (1.0f / D) + EPS), rs = 1.0f / rd;
          if (F.lane == 0) RD0[m] = rd;
          GAS unsigned long long* o8 = (GAS unsigned long long*)(A0 + (size_t)m * D) + F.lane;
          float fa[8];
#pragma unroll
          for (int h = 0; h < 8; ++h) fa[h] = 0.f;
#pragma unroll
          for (int j = 0; j < 4; ++j) {
              const f32x4 y = v[j] * gv[j] * rs;
              o8[64 * j] = (unsigned long long)pk2(y.x, y.y) | ((unsigned long long)pk2(y.z, y.w) << 32);
#pragma unroll
              for (int i = 0; i < 4; ++i) { const LAS f32x4* wp = (const LAS f32x4*)(wf + ((j * 4 + i) * 128 + F.lane) * 4); const f32x4 wa = wp[0], wb = wp[64]; const float xv = v[j][i];
                  fa[0] += xv * wa.x; fa[1] += xv * wa.y; fa[2] += xv * wa.z; fa[3] += xv * wa.w; fa[4] += xv * wb.x; fa[5] += xv * wb.y; fa[6] += xv * wb.z; fa[7] += xv * wb.w; }
          }
          float mine = 0.f;
#pragma unroll
          for (int h = 0; h < 8; ++h) { const float t = wave_sum(fa[h]); if (F.lane == h) mine = t; }
          if (F.lane < 8) LF[(size_t)m * 8 + F.lane] = log_sigmoid(mine * rs + b_f[F.lane]);
      }
      __syncthreads();
    }
    { bf16* wrH = (bf16*)(ws + WS_WRH); bf16* wrL = (bf16*)(ws + WS_WRL); float* b1p = (float*)(ws + WS_B1P);
      for (int i = gt; i < NE * D; i += NGT) { const int e = i >> 10, k = i & 1023; const float w = g_mlp[k] * w_router[(size_t)k * NE + e]; const unsigned hb = f2bf(w);
          wrH[i] = (bf16)hb; wrL[i] = (bf16)f2bf(w - __builtin_bit_cast(float, hb << 16)); }
      for (int i = gt; i < NE * 2048; i += NGT) { const int e = i >> 11, r = i & 2047, pn = r >> 8, rho = r & 255; const int o = 128 * pn + (rho & 127); b1p[i] = b1[(size_t)e * 2048 + 2 * o + (rho >> 7)] + (float)(rho >> 7); }
      bf16* PB = (bf16*)(ws + WS_PB);
      for (int i = gt; i < NTOK * PLE / 8; i += NGT) { const f32x4 a = *(const f32x4*)(p + (size_t)i * 8), b = *(const f32x4*)(p + (size_t)i * 8 + 4);
          v4u o; o.x = pk2(a.x, a.y); o.y = pk2(a.z, a.w); o.z = pk2(b.x, b.y); o.w = pk2(b.z, b.w); *(GAS v4u*)(PB + (size_t)i * 8) = o; }
    }
    { LAS float* scr = (LAS float*)(F.lds + RING_OFF + F.wave * 16384);
      constexpr int I_W1 = NE * 16 * 64, I_W2 = NE * 16 * 32, I_IN = 16 * 96, I_O = 16 * 32, I_G = 16 * 32, I_P = 4 * 32;
      constexpr int NITEMS = I_W1 + I_W2 + I_IN + I_O + I_G + I_P;
      for (int it = gw; it < NITEMS; it += NGW) {
          int r = it;
          if (r < I_W1) { const int e = r >> 10, q = r & 1023, kb = q >> 6, nb = q & 63;
              tr_item_f8(w1 + (size_t)e * D * 2048, 2048, 64 * kb, 32 * nb, 32 * nb, 2, ws + WS_W1 + (size_t)e * 2048 * D, D, scr, F.lane); continue; } r -= I_W1;
          if (r < I_W2) { const int e = r >> 9, q = r & 511, kb = q >> 5, nb = q & 31;
              tr_item_f8(w2 + (size_t)e * FF * D, D, 64 * kb, 32 * nb, 32 * nb, 3, ws + WS_W2 + (size_t)e * D * FF, FF, scr, F.lane); continue; } r -= I_W2;
          if (r < I_IN) { const int kb = r / 96, nb = r % 96; const int P0 = 32 * nb;
              tr_item(w_in, INW, 64 * kb, P0 + (P0 >= 1536 ? 8 : 0), P0, 1, (bf16*)(ws + WS_WIN), D, scr, F.lane); continue; } r -= I_IN;
          if (r < I_O) { const int kb = r >> 5, nb = r & 31; tr_item_f8(w_out, D, 64 * kb, 32 * nb, 32 * nb, 0, ws + WS_WOUT, D, scr, F.lane); continue; } r -= I_O;
          if (r < I_G) { const int kb = r >> 5, nb = r & 31; tr_item_f8(w_pg, D, 64 * kb, 32 * nb, 32 * nb, 0, ws + WS_WG, D, scr, F.lane); continue; } r -= I_G;
          { const int kb = r >> 5, nb = r & 31; tr_item(w_pp, D, 64 * kb, 32 * nb, 32 * nb, 0, (bf16*)(ws + WS_WP), PLE, scr, F.lane); }
      }
    }
}

__device__ __forceinline__ void p1_scan(Frame& F) {
    const float* LF = (const float*)(F.ws + WS_LF); float* CS = (float*)(F.ws + WS_CS);
    LAS float* sc = (LAS float*)(F.lds + RING_OFF);
    for (int seq = F.vcu; seq < BATCH * NFOX; seq += F.G) {
        const int b = seq >> 3, h = seq & 7;
        float v[4];
#pragma unroll
        for (int i = 0; i < 4; ++i) v[i] = LF[((size_t)b * SEQ + 4 * F.tid + i) * 8 + h];
        v[1] += v[0]; v[2] += v[1]; v[3] += v[2];
        float incl = v[3];
#pragma unroll
        for (int o = 1; o < 64; o <<= 1) { const float t = __shfl_up(incl, o); if (F.lane >= o) incl += t; }
        if (F.lane == 63) sc[F.wave] = incl;
        __syncthreads();
        float off = incl - v[3];
        for (int w = 0; w < F.wave; ++w) off += sc[w];
        f32x4 o; o.x = -(off + v[0]) * LOG2E; o.y = -(off + v[1]) * LOG2E; o.z = -(off + v[2]) * LOG2E; o.w = -(off + v[3]) * LOG2E;
        *(f32x4*)(CS + (size_t)seq * SEQ + 4 * F.tid) = o;
        __syncthreads();
    }
}

constexpr int CSL_OFF = 122880;
static_assert(CSL_OFF >= attn_body::LDS_ZERO + 16 && CSL_OFF + SEQ * 4 <= MISC_OFF, "FoX cs cache");
constexpr int DSTASH = 86016;
static_assert(DSTASH >= attn_body::L8_TAB + 2304 * 4 && DSTASH + 65536 <= MISC_OFF, "diff-attention stash");
__device__ __forceinline__ int t5_bucket(int n) {
    if (n < 16) return n;
    int b = 16;
    b += (n >= 19); b += (n >= 21); b += (n >= 24); b += (n >= 27); b += (n >= 31); b += (n >= 35); b += (n >= 40); b += (n >= 46);
    b += (n >= 52); b += (n >= 59); b += (n >= 67); b += (n >= 77); b += (n >= 87); b += (n >= 99); b += (n >= 113);
    return b;
}
__device__ __forceinline__ void p2_attention(Frame& F, char* shm) {
    const bf16* PROJ = (const bf16*)(F.ws + WS_PROJ); unsigned char* MIXED = F.ws + WS_MIXED;   const float* CS = (const float*)(F.ws + WS_CS);
    const float* rel_bias = KARG->in[2]; const float* g_subln = KARG->in[14];
    const int lane = F.lane, wid = F.wave;
    LAS float* tab = (LAS float*)(F.lds + attn_body::LDS_TAB);
    float skip_th;
    { const float gq = fabsf(KARG->in[6][lane]), gk = fabsf(KARG->in[7][lane]); float mq = gq, mk = gk;
#pragma unroll
      for (int o = 1; o < 64; o <<= 1) { mq = fmaxf(mq, __shfl_xor(mq, o)); mk = fmaxf(mk, __shfl_xor(mk, o)); }
      skip_th = 2.0f * (64.0f * C2) * mq * mk + 24.0f; }
    unsigned hpack;
    { const float bv = KARG->in[5][lane & 7]; int rk = 0;
#pragma unroll
      for (int j = 0; j < 8; ++j) { const float o = __shfl(bv, j); rk += (o < bv || (o == bv && j < (lane & 7))) ? 1 : 0; }
      hpack = 0u;
#pragma unroll
      for (int r = 0; r < 8; ++r) { const unsigned long long bal = __ballot(lane < 8 && rk == r); hpack |= (unsigned)__builtin_ctzll(bal) << (4 * r); }
      hpack = (unsigned)__builtin_amdgcn_readfirstlane((int)hpack); }
    for (int pi = F.vcu; pi < 128 * 4; pi += F.G) {
        const int bh = pi >> 2, s = (pi < 256) ? (pi & 3) : 3 - (pi & 3), b = bh >> 3, h = (hpack >> (4 * ((pi < 256) ? (bh & 7) : 7 - (bh & 7)))) & 7;
        LAS float* cs = (LAS float*)(F.lds + CSL_OFF);
        __syncthreads();
        { const float* csg = CS + (size_t)(b * 8 + h) * SEQ; for (int i = F.tid; i < SEQ / 4; i += NWAVES * 64) ((LAS f32x4*)cs)[i] = ((const f32x4*)csg)[i]; }
        __syncthreads();
        for (int half = 0; half < 2; ++half) {
            const int qb = half ? 7 - s : s, q0 = qb * 256, NTfull = 4 * qb + 4;
            int t0;
            { const float cq = cs[q0]; const int i = lane & 15; const bool ok = (2 * i <= NTfull - 4) && (i == 0 || cq - cs[128 * i - 1] > skip_th);
              const unsigned long long bal = __ballot(ok) & 0xffffull; t0 = 2 * (63 - __builtin_clzll(bal)); t0 = __builtin_amdgcn_readfirstlane(t0); }
            const int k0 = 64 * t0;
            __syncthreads();
            for (int i = F.tid; i < q0 + 256 - k0; i += NWAVES * 64) { unsigned h_, m_, l_; attn_body::split3(cs[k0 + i], h_, m_, l_);
                *(LAS v4u*)(F.lds + attn_body::LDS_TAB + 16 * i) = (v4u){h_ | (m_ << 16), l_ | 0x3F800000u, 0x3F803F80u, 0u}; }
            if (F.tid == 0) *(LAS v4u*)(F.lds + attn_body::LDS_ZERO) = (v4u){0u, 0u, 0u, 0u};
            __syncthreads();
            const bf16* base = PROJ + (size_t)b * SEQ * NPROJ;
            if (__builtin_bit_cast(float, __builtin_amdgcn_readfirstlane(__builtin_bit_cast(int, skip_th))) <= 24.0f + 120.0f) attn_body::attn_unit<8, 0, D, true>(q0, NTfull - t0, base + CQF + h * 64, base + (size_t)k0 * NPROJ + CKF + h * 64, base + (size_t)k0 * NPROJ + CVF + h * 64, (bf16*)(MIXED + (size_t)b * SEQ * D + h * 64), shm, (attn_body::lds_fptr)(cs + q0));
            else attn_body::attn_unit<8, 0, D, false>(q0, NTfull - t0, base + CQF + h * 64, base + (size_t)k0 * NPROJ + CKF + h * 64, base + (size_t)k0 * NPROJ + CVF + h * 64, (bf16*)(MIXED + (size_t)b * SEQ * D + h * 64), shm, (attn_body::lds_fptr)(cs + q0));
        }
    }
    float lam;
    { const float a = KARG->in[10][lane] * KARG->in[11][lane], c = KARG->in[12][lane] * KARG->in[13][lane]; lam = expf(wave_sum(a)) - expf(wave_sum(c)) + 0.2f; }
    float dsb;
    { float mq = fabsf(KARG->in[8][lane]), mk = fabsf(KARG->in[9][lane]);
#pragma unroll
      for (int o = 1; o < 64; o <<= 1) { mq = fmaxf(mq, __shfl_xor(mq, o)); mk = fmaxf(mk, __shfl_xor(mk, o)); }
      dsb = __builtin_bit_cast(float, __builtin_amdgcn_readfirstlane(__builtin_bit_cast(int, (64.0f * C2) * mq * mk))); }
    for (int pi = F.vcu; pi < 64 * 4; pi += F.G) {
        const int bh = pi >> 2, s = pi & 3, b = bh >> 2, h = bh & 3;
        bool dnomax;
        { int l3 = threadIdx.x & 31; asm volatile("" : "+v"(l3)); float bm = fabsf(rel_bias[l3 * NDIFF + h] - rel_bias[31 * NDIFF + h]) * LOG2E;
#pragma unroll
          for (int o = 1; o < 64; o <<= 1) bm = fmaxf(bm, __shfl_xor(bm, o));
          dnomax = dsb + __builtin_bit_cast(float, __builtin_amdgcn_readfirstlane(__builtin_bit_cast(int, bm))) <= 60.0f; }
        __syncthreads();
        LAS float* tab8 = (LAS float*)(F.lds + attn_body::L8_TAB);
        for (int i = F.tid; i < 2304; i += NWAVES * 64) { const int dist = 2047 - i; tab8[i] = (rel_bias[t5_bucket(dist > 0 ? dist : 0) * NDIFF + h] - rel_bias[31 * NDIFF + h]) * LOG2E; }
        __syncthreads();
        for (int half = 0; half < 2; ++half) {
            const int qb = half ? 7 - s : s, q0 = qb * 256;
            const bf16* base = PROJ + (size_t)b * SEQ * NPROJ;
            if (dnomax) {
                attn_body::attn_unit128<8, true, 1>(q0, base + CQD + h * 128, base + CKD + h * 128, base + CVD + h * 128, shm, DSTASH);
                attn_body::attn_unit128<8, true, 2>(q0, base + CQD + h * 128 + 64, base + CKD + h * 128 + 64, base + CVD + h * 128, shm, 0);
            } else {
#pragma unroll 1
                for (int br = 0; br < 2; ++br) attn_body::attn_unit128<8, false, 0>(q0, base + CQD + h * 128 + br * 64, base + CKD + h * 128 + br * 64, base + CVD + h * 128, shm, br ? 0 : DSTASH);
            }
            int l2 = threadIdx.x & 63; asm volatile("" : "+v"(l2));
            const int cr = l2 >> 4, cc = (l2 & 15) * 8;
            const LAS bf16* s1 = (const LAS bf16*)(F.lds + DSTASH) + wid * 4096 + cr * 128 + cc; const LAS bf16* s2 = (const LAS bf16*)(F.lds) + wid * 4096 + cr * 128 + cc;
            unsigned char* mrow = MIXED + ((size_t)b * SEQ + q0 + 32 * wid + cr) * D + 512 + h * 128 + cc;
            v4u w1[8], w2[8];
#pragma unroll
            for (int it = 0; it < 8; ++it) { w1[it] = *(const LAS v4u*)(s1 + 4 * it * 128); w2[it] = *(const LAS v4u*)(s2 + 4 * it * 128); }
            f32x4 ga = *(const f32x4*)(g_subln + cc), gb = *(const f32x4*)(g_subln + cc + 4);
#pragma unroll
            for (int it = 0; it < 8; ++it) {
                const unsigned a1[4] = {w1[it].x, w1[it].y, w1[it].z, w1[it].w}, a2[4] = {w2[it].x, w2[it].y, w2[it].z, w2[it].w};
                float dv[8]; float ss = 0.f;
#pragma unroll
                for (int i = 0; i < 4; ++i) { dv[2 * i] = bflo(a1[i]) - lam * bflo(a2[i]); dv[2 * i + 1] = bfhi(a1[i]) - lam * bfhi(a2[i]); ss += dv[2 * i] * dv[2 * i] + dv[2 * i + 1] * dv[2 * i + 1]; }
                ss += __shfl_xor(ss, 1); ss += __shfl_xor(ss, 2); ss += __shfl_xor(ss, 4); ss += __shfl_xor(ss, 8);
                const float rq = 0.8f / sqrtf(ss * (1.0f / 128.0f) + EPS);
                u32x2v o; o.x = pk4_fp8(dv[0] * rq * ga.x, dv[1] * rq * ga.y, dv[2] * rq * ga.z, dv[3] * rq * ga.w); o.y = pk4_fp8(dv[4] * rq * gb.x, dv[5] * rq * gb.y, dv[6] * rq * gb.z, dv[7] * rq * gb.w);
                *(GAS u32x2v*)(mrow + (size_t)(4 * it) * D) = o;
            }
            __syncthreads();
        }
    }
}

__device__ __forceinline__ void p4_router(Frame& F) {
    const bf16* h1 = (const bf16*)(F.ws + WS_H1B); const float* g_mlp = KARG->in[16]; const float* b_router = KARG->in[18];
    const bf16* wrH = (const bf16*)(F.ws + WS_WRH); const bf16* wrL = (const bf16*)(F.ws + WS_WRL);
    unsigned char* A0 = F.ws + WS_A0;
    int* tokE = (int*)(F.ws + WS_TOKE); float* gateE = (float*)(F.ws + WS_GATEE); float* rsE = (float*)(F.ws + WS_RSE); int* tp = (int*)(F.ws + WS_TP);
    const int lane = F.lane, r16 = lane & 15, kq = lane >> 4;
    constexpr int WPITCH = 2064;
    LAS unsigned char* wH = F.lds; LAS unsigned char* wL = F.lds + 32 * WPITCH;
    { v4u t[16];
#pragma unroll
      for (int i = 0; i < 16; ++i) { const int c = F.tid + i * (NWAVES * 64), mtx = c >> 12, cc = c & 4095, r = cc >> 7, q = cc & 127; t[i] = *(const GAS v4u*)((mtx ? wrL : wrH) + (size_t)r * D + q * 8); }
#pragma unroll
      for (int i = 0; i < 16; ++i) { const int c = F.tid + i * (NWAVES * 64), mtx = c >> 12, cc = c & 4095, r = cc >> 7, q = cc & 127; *(LAS v4u*)((mtx ? wL : wH) + r * WPITCH + q * 16) = t[i]; } }
    LAS float* lg = (LAS float*)(F.lds + 64 * WPITCH + F.wave * 2176);
    LAS unsigned* hist = (LAS unsigned*)(F.lds + EPI_OFF); LAS unsigned* baseL = hist + 32;
    static_assert(64 * WPITCH + NWAVES * 2176 <= TILEE_OFF, "router LDS map");
    __syncthreads();
    for (int g0 = F.vcu; g0 < NTOK / 128; g0 += F.G) {
        const int R0 = (g0 * NWAVES + F.wave) * 16; const int row = R0 + r16;
        if (F.tid < 32) hist[F.tid] = 0u;
        __syncthreads();
        f32x4 acc0 = {0.f, 0.f, 0.f, 0.f}, acc1 = {0.f, 0.f, 0.f, 0.f}; float ss = 0.f;
        const bf16* xr = h1 + (size_t)row * D + 16 * kq;
#pragma unroll 2
        for (int p = 0; p < 16; ++p) {
            const int k = 64 * p + 16 * kq;
            const v4u xw0 = *(const v4u*)(xr + 64 * p), xw1 = *(const v4u*)(xr + 64 * p + 8);
            const f32x4 g0 = *(const f32x4*)(g_mlp + k), g1 = *(const f32x4*)(g_mlp + k + 4), g2 = *(const f32x4*)(g_mlp + k + 8), g3 = *(const f32x4*)(g_mlp + k + 12);
            const float xv[16] = {bflo(xw0.x), bfhi(xw0.x), bflo(xw0.y), bfhi(xw0.y), bflo(xw0.z), bfhi(xw0.z), bflo(xw0.w), bfhi(xw0.w),
                                  bflo(xw1.x), bfhi(xw1.x), bflo(xw1.y), bfhi(xw1.y), bflo(xw1.z), bfhi(xw1.z), bflo(xw1.w), bfhi(xw1.w)};
#pragma unroll
            for (int j = 0; j < 16; ++j) ss += xv[j] * xv[j];
            { v4u o; o.x = pk4_fp8(xv[0] * g0.x, xv[1] * g0.y, xv[2] * g0.z, xv[3] * g0.w); o.y = pk4_fp8(xv[4] * g1.x, xv[5] * g1.y, xv[6] * g1.z, xv[7] * g1.w);
              o.z = pk4_fp8(xv[8] * g2.x, xv[9] * g2.y, xv[10] * g2.z, xv[11] * g2.w); o.w = pk4_fp8(xv[12] * g3.x, xv[13] * g3.y, xv[14] * g3.z, xv[15] * g3.w);
              *(GAS v4u*)(A0 + (size_t)row * D + k) = o; }
#pragma unroll
            for (int hf = 0; hf < 2; ++hf) {
                const bf16x8 Ah = __builtin_bit_cast(bf16x8, hf ? xw1 : xw0); const int kk = k + 8 * hf;
                const bf16x8 Bh0 = *(const LAS bf16x8*)(wH + r16 * WPITCH + 2 * kk), Bl0 = *(const LAS bf16x8*)(wL + r16 * WPITCH + 2 * kk);
                const bf16x8 Bh1 = *(const LAS bf16x8*)(wH + (16 + r16) * WPITCH + 2 * kk), Bl1 = *(const LAS bf16x8*)(wL + (16 + r16) * WPITCH + 2 * kk);
                acc0 = __builtin_amdgcn_mfma_f32_16x16x32_bf16(Ah, Bh0, acc0, 0, 0, 0); acc0 = __builtin_amdgcn_mfma_f32_16x16x32_bf16(Ah, Bl0, acc0, 0, 0, 0);
                acc1 = __builtin_amdgcn_mfma_f32_16x16x32_bf16(Ah, Bh1, acc1, 0, 0, 0); acc1 = __builtin_amdgcn_mfma_f32_16x16x32_bf16(Ah, Bl1, acc1, 0, 0, 0); }
        }
        ss += __shfl_xor(ss, 16); ss += __shfl_xor(ss, 32);
        const float rs = 1.0f / sqrtf(ss * (1.0f / D) + EPS);
#pragma unroll
        for (int i = 0; i < 4; ++i) { lg[(4 * kq + i) * 33 + r16] = acc0[i]; lg[(4 * kq + i) * 33 + 16 + r16] = acc1[i]; }
        if (kq == 0) lg[16 * 33 + r16] = rs;
        asm volatile("s_waitcnt lgkmcnt(0)" ::: "memory");
        int se[4] = {0, 0, 0, 0}; float sg[4] = {0.f, 0.f, 0.f, 0.f}; unsigned rk[4] = {0u, 0u, 0u, 0u}; float myrs = 0.f;
        if (lane < 16) {
            myrs = lg[16 * 33 + lane];
            float v[32];
#pragma unroll
            for (int e = 0; e < 32; ++e) v[e] = lg[lane * 33 + e] * myrs + b_router[e];
            float sv[4];
#pragma unroll
            for (int k = 0; k < 4; ++k) { float best = v[0]; int bi = 0;
#pragma unroll
                for (int e = 1; e < 32; ++e) { const bool gt = v[e] > best; best = gt ? v[e] : best; bi = gt ? e : bi; }
                sv[k] = best; se[k] = bi;
#pragma unroll
                for (int e = 0; e < 32; ++e) v[e] = (e == bi) ? -INFINITY : v[e]; }
            float den = 0.f;
#pragma unroll
            for (int k = 0; k < 4; ++k) { sg[k] = expf(sv[k] - sv[0]); den += sg[k]; }
            const float inv = 1.0f / den;
#pragma unroll
            for (int k = 0; k < 4; ++k) { sg[k] *= inv; rk[k] = __hip_atomic_fetch_add(hist + se[k], 1u, __ATOMIC_RELAXED, __HIP_MEMORY_SCOPE_WORKGROUP); }
        }
        __syncthreads();
        if (F.tid < 32) { const unsigned c = hist[F.tid]; baseL[F.tid] = c ? __hip_atomic_fetch_add((unsigned*)(F.ctl + CW_CNT + 64 * F.tid), c, __ATOMIC_RELAXED, __HIP_MEMORY_SCOPE_AGENT) : 0u; }
        __syncthreads();
        if (lane < 16) {
            const int trow = R0 + lane;
#pragma unroll
            for (int k = 0; k < 4; ++k) { const unsigned pos = baseL[se[k]] + rk[k]; const size_t ix = (size_t)se[k] * ECAP + pos;
                tokE[ix] = trow; gateE[ix] = sg[k]; rsE[ix] = myrs; tp[(size_t)trow * 4 + k] = se[k] * 32768 + (int)pos; }
        }
        __syncthreads();
    }
}
__device__ __forceinline__ int moe_tables(Frame& F) {
    LAS int* ts = lds_tstart(F.lds); LAS int* cn = lds_cnt(F.lds); LAS unsigned short* te = lds_tileE(F.lds);
    __syncthreads();
    if (F.tid < 64) {
        const int c = F.tid < 32 ? (int)__hip_atomic_load((unsigned*)(F.ctl + CW_CNT + 64 * F.tid), __ATOMIC_RELAXED, __HIP_MEMORY_SCOPE_AGENT) : 0;
        const int nt = (c + 255) >> 8; int incl = nt;
#pragma unroll
        for (int o = 1; o < 32; o <<= 1) { const int t = __shfl_up(incl, o); if (F.lane >= o) incl += t; }
        if (F.tid < 32) { cn[F.tid] = c; ts[F.tid] = incl - nt; if (F.tid == 31) ts[32] = incl; }
    }
    __syncthreads();
    const int total = ts[32];
    for (int t = F.tid; t < total; t += NWAVES * 64) { int e = 0;
#pragma unroll
        for (int j = 1; j < 32; ++j) e += (t >= ts[j]) ? 1 : 0;
        te[t] = (unsigned short)e; }
    __syncthreads();
    return total;
}
__device__ __forceinline__ void p7_combine(Frame& F) {
    const unsigned char* Y = F.ws + WS_Y; const int* tp = (const int*)(F.ws + WS_TP); unsigned char* A3 = F.ws + WS_A3; float* rs3 = (float*)(F.ws + WS_RS3);
    const float* g_ple = KARG->in[23]; const bf16* h1 = (const bf16*)(F.ws + WS_H1B); bf16* h2 = (bf16*)(F.ws + WS_H2B);
    LAS int* ts = lds_tstart(F.lds);
    const int gw = F.vcu * NWAVES + F.wave, NGW = F.G * NWAVES;
    f32x4 gv[4];
#pragma unroll
    for (int j = 0; j < 4; ++j) gv[j] = *(const f32x4*)(g_ple + 256 * j + 4 * F.lane);
    for (int m = gw; m < NTOK; m += NGW) {
        const GAS u32x2v* hr = (const GAS u32x2v*)(h1 + (size_t)m * D) + F.lane; GAS u32x2v* ho = (GAS u32x2v*)(h2 + (size_t)m * D) + F.lane;
        f32x4 v[4];
#pragma unroll
        for (int j = 0; j < 4; ++j) { const u32x2v w = hr[64 * j]; v[j] = (f32x4){bflo(w.x), bfhi(w.x), bflo(w.y), bfhi(w.y)}; }
#pragma unroll
        for (int k = 0; k < 4; ++k) { const int t = tp[(size_t)m * 4 + k]; const int e = t >> 15, pos = t & 32767; const size_t yr = (size_t)ts[e] * 256 + pos;
            const GAS unsigned* yp = (const GAS unsigned*)(Y + yr * D) + F.lane;
#pragma unroll
            for (int j = 0; j < 4; ++j) { const unsigned w = yp[64 * j]; const f32x2t a = __builtin_amdgcn_cvt_pk_f32_fp8((int)w, false), c = __builtin_amdgcn_cvt_pk_f32_fp8((int)w, true);
                v[j].x += a[0] * 0.0625f; v[j].y += a[1] * 0.0625f; v[j].z += c[0] * 0.0625f; v[j].w += c[1] * 0.0625f; } }
        float ss = 0.f;
        GAS unsigned* o4 = (GAS unsigned*)(A3 + (size_t)m * D) + F.lane;
#pragma unroll
        for (int j = 0; j < 4; ++j) { { u32x2v w; w.x = pk2(v[j].x, v[j].y); w.y = pk2(v[j].z, v[j].w); ho[64 * j] = w; } ss += (v[j].x * v[j].x + v[j].y * v[j].y) + (v[j].z * v[j].z + v[j].w * v[j].w);
            const f32x4 y = v[j] * gv[j]; o4[64 * j] = pk4_fp8(y.x, y.y, y.z, y.w); }
        ss = wave_sum(ss);
        if (F.lane == 0) rs3[m] = 1.0f / sqrtf(ss * (1.0f / D) + EPS);
    }
}

__global__ void __launch_bounds__(NWAVES * 64, 2) fwd_kernel(Args args) {
    extern __shared__ __attribute__((aligned(16))) unsigned char lds[];
    Frame F;
    F.lds = (LAS unsigned char*)lds;
    F.MISC = (volatile LAS unsigned*)(F.lds + MISC_OFF);
    FRESH(F);
    F.G = gridDim.x; { const int bx = blockIdx.x; F.vcu = (F.G % 8 == 0) ? (bx % 8) * (F.G / 8) + bx / 8 : bx; }
    F.ws = KARG->ws; F.ctl = (gu32*)(KARG->ws + WS_CTL); F.out = KARG->out;
    unsigned char* ws = KARG->ws;
    if (F.tid < 64) ((LAS unsigned*)(F.lds + MISC_OFF))[F.tid] = 0u;
    __syncthreads();
    XcdBarrier bar = xcd_barrier_post((unsigned*)(F.ctl + CW_BAR), F.MISC + 8);
    const int lo = KARG->ph_lo, hi = KARG->ph_hi;
#ifndef PHMASK
#define PHMASK 0x1ff
#endif
#define IN(k) (((PHMASK >> (k)) & 1) && lo <= (k) && (k) < hi)
#define BOTH(k) (IN(k) && IN((k) + 1))
#define GRID_BAR() xcd_barrier(bar)

    if (IN(0)) { FRESH(F); p0_prologue(F); if (BOTH(0)) GRID_BAR(); }

    if (IN(1)) {
        FRESH(F); p1_scan(F);
        { pg8::Gemm g{(const bf16*)(ws + WS_A0), D}; SchedC S{NTOK / 256, NPROJ / 256, F.G, (int)blockIdx.x, D, (const char*)(ws + WS_WIN)};
          EpiProj E{(bf16*)(ws + WS_PROJ), KARG->in[6], KARG->in[7], KARG->in[8], KARG->in[9]};
          pg8::gemm_phase<EpiProj, SchedC>(F.lds + RING_OFF, g, S, E); }
        if (BOTH(1)) GRID_BAR();
    }

    if (IN(2)) { FRESH(F); p2_attention(F, (char*)lds); if (BOTH(2)) GRID_BAR(); }

    if (IN(3)) {
        pg8::Gemm g{(const bf16*)(ws + WS_MIXED), D / 2}; SchedC S{NTOK / 256, D / 256, F.G, (int)blockIdx.x, D / 2, (const char*)(ws + WS_WOUT)};
        EpiRes E{(const bf16*)(ws + WS_A0), (const float*)(ws + WS_RD0), KARG->in[3], (bf16*)(ws + WS_H1B)};
        pg8::gemm_phase<EpiRes, SchedC, true>(F.lds + RING_OFF, g, S, E);
        if (BOTH(3)) GRID_BAR();
    }

    if (IN(4)) { FRESH(F); p4_router(F); if (BOTH(4)) GRID_BAR(); }

    if (IN(5)) {
        FRESH(F); const int ntile = moe_tables(F);
        typedef SchedM<true, 8, 2048, 512> S1;
        S1 S{F.G, (int)blockIdx.x, (const char*)(ws + WS_W1), F.lds, ntile};
        { const int* tokE = (const int*)(ws + WS_TOKE); LAS int* tk = (LAS int*)(F.lds + TOKL_OFF); pg8::Unit u;
          int tv[9];
#pragma unroll
          for (int j = 0; j < 9; ++j) { const int i = 2 * j + (F.tid >> 8); tv[j] = 0;
              if (S.next(i, u)) { const int lr = u.lr0 + (F.tid & 255); if (lr < lds_cnt(F.lds)[u.e]) tv[j] = tokE[(size_t)u.e * ECAP + lr]; } }
#pragma unroll
          for (int j = 0; j < 9; ++j) tk[(2 * j + (F.tid >> 8)) * 256 + (F.tid & 255)] = tv[j];
          __syncthreads(); }
        pg8::Gemm g{(const bf16*)(ws + WS_A0), D / 2};
        EpiSwiglu E{ws + WS_HB, (const float*)(ws + WS_B1P), (const float*)(ws + WS_RSE), F.lds};
        pg8::gemm_phase<EpiSwiglu, S1, true>(F.lds + RING_OFF, g, S, E);
        { const int c = (int)blockIdx.x, rem = (8 * ntile) % F.G;
          if (rem && c >= rem && c - rem < NPPU) {
              pg8::Gemm g2{(const bf16*)(ws + WS_PB), PLE}; SchedC S2{NTOK / 256, D / 256, 1 << 20, c - rem, PLE, (const char*)(ws + WS_WP)};
              EpiBf16P E2{ws + WS_PP, D};
              pg8::gemm_phase<EpiBf16P, SchedC>(F.lds + RING_OFF, g2, S2, E2); } }
        if (BOTH(5)) GRID_BAR();
    }

    if (IN(6)) {
        FRESH(F); const int ntile = (lo <= 5) ? lds_tstart(F.lds)[32] : moe_tables(F);
        typedef SchedM<false, 4, 1024, 512> S2;
        S2 S{F.G, (int)blockIdx.x, (const char*)(ws + WS_W2), F.lds, ntile};
        pg8::Gemm g{(const bf16*)(ws + WS_HB), FF / 2};
        EpiY E{ws + WS_Y, KARG->in[22], (const float*)(ws + WS_GATEE), F.lds};
        pg8::gemm_phase<EpiY, S2, true>(F.lds + RING_OFF, g, S, E);
        { const int c = (int)blockIdx.x, rem5 = (8 * ntile) % F.G, n5 = rem5 ? min(F.G - rem5, NPPU) : 0, left = NPPU - n5;
          const int rem6 = (4 * ntile) % F.G, idle6 = rem6 ? F.G - rem6 : 0;
          const bool onidle = idle6 > 0 && left <= 3 * idle6;
          const int stride = onidle ? idle6 : F.G, j = onidle ? c - rem6 : c;
          if (j >= 0 && n5 + j < NPPU) {
              pg8::Gemm g2{(const bf16*)(ws + WS_PB), PLE}; SchedC S3{NTOK / 256, D / 256, stride, n5 + j, PLE, (const char*)(ws + WS_WP)};
              EpiBf16P E2{ws + WS_PP, D};
              pg8::gemm_phase<EpiBf16P, SchedC>(F.lds + RING_OFF, g2, S3, E2); } }
        if (BOTH(6)) GRID_BAR();
    }

    if (IN(7)) { FRESH(F); if (lo > 5) (void)moe_tables(F); p7_combine(F); if (BOTH(7)) GRID_BAR(); }

    if (IN(8)) {
        pg8::Gemm g{(const bf16*)(ws + WS_A3), D / 2}; SchedC S{NTOK / 256, D / 256, F.G, (int)blockIdx.x, D / 2, (const char*)(ws + WS_WG)};
        EpiFinal E{F.out, (const bf16*)(ws + WS_H2B), ws + WS_PP, (const float*)(ws + WS_RS3)};
        pg8::gemm_phase<EpiFinal, SchedC, true>(F.lds + RING_OFF, g, S, E);
    }
#undef IN
#undef BOTH
#undef GRID_BAR
}

#ifndef MK_N_LAUNCHES
#define MK_N_LAUNCHES 1
#endif
extern "C" void kernel_launch(void* const* d_in, const int* in_sizes, int n_in, void* d_out, int out_size, void* d_ws, size_t ws_size, hipStream_t stream) {
    static int grid = 0;
    if (grid == 0) {
        if (n_in != 26 || in_sizes[0] != NTOK * D || out_size != NTOK * D || ws_size < WS_END) {
            fprintf(stderr, "kernel_launch: unexpected shapes (n_in %d, in0 %d, out %d, ws %zu need %zu); nothing launched\n", n_in, n_in > 0 ? in_sizes[0] : -1, out_size, ws_size, (size_t)WS_END); grid = -1; return; }
        int dev = 0, cus = 0, per_cu = 0;
        if (hipGetDevice(&dev) != hipSuccess || hipDeviceGetAttribute(&cus, hipDeviceAttributeMultiprocessorCount, dev) != hipSuccess) { grid = -1; return; }
        if (hipFuncSetAttribute((const void*)fwd_kernel, hipFuncAttributeMaxDynamicSharedMemorySize, LDS_BYTES) != hipSuccess) { fprintf(stderr, "kernel_launch: hipFuncSetAttribute failed\n"); grid = -1; return; }
        if (hipOccupancyMaxActiveBlocksPerMultiprocessor(&per_cu, (const void*)fwd_kernel, NWAVES * 64, LDS_BYTES) != hipSuccess || per_cu < 1)
            fprintf(stderr, "kernel_launch: note: occupancy query reports %d workgroups per CU\n", per_cu);
        (void)hipGetLastError();
        grid = cus;
        if (grid != 256) fprintf(stderr, "kernel_launch: note: %d CUs (tuned for 256)\n", grid);
    }
    if (grid < 0) return;
    if (hipMemsetAsync((char*)d_ws + WS_CTL, 0, CTL_ZERO_BYTES, stream) != hipSuccess) { fprintf(stderr, "kernel_launch: memset failed\n"); return; }
    Args a{};
    for (int i = 0; i < 26; ++i) a.in[i] = (const float*)d_in[i];
    a.out = (float*)d_out; a.ws = (unsigned char*)d_ws;
#if MK_N_LAUNCHES == 1
    a.ph_lo = 0; a.ph_hi = 9;
    hipLaunchKernelGGL(fwd_kernel, dim3(grid), dim3(NWAVES * 64), LDS_BYTES, stream, a);
#else
    for (int ph = 0; ph < 9; ++ph) { a.ph_lo = ph; a.ph_hi = ph + 1; hipLaunchKernelGGL(fwd_kernel, dim3(grid), dim3(NWAVES * 64), LDS_BYTES, stream, a); }
#endif
    const hipError_t le = hipPeekAtLastError();
    if (le != hipSuccess) fprintf(stderr, "kernel_launch: launch failed: %s\n", hipGetErrorName(le));
}
```
